# Optimizing an MI355X kernel written in HIP

```python
import jax, jax.numpy as jnp
from jax import lax
import numpy as np

D_MODEL = 1024
BATCH = 8
SEQ = 2048
DEPTH = 2
DEC_BATCH = 32
DEC_SEQ = 8
PAST_LEN = 16384
PAGE_SIZE = 128

MLA_HEADS = 8
QK_NOPE = 64
QK_ROPE = 32
V_HEAD = 64
Q_LORA = 384
KV_LORA = 256
D_MLA = MLA_HEADS * V_HEAD
ROPE_THETA = 10000.0
ATTN_SCALE = (QK_NOPE + QK_ROPE) ** -0.5
Q_BLOCK = 128
D_CONV = 256
CONV_W = 3
R_HEADS = 4
R_HEAD = 64
D_R = R_HEADS * R_HEAD
W_LORA = 64
A_LORA = 64
SHIFT_W = 3 * D_R + W_LORA + A_LORA
GN_EPS = 64e-5
RMS_EPS = 1e-6
N_BRANCH = 3
SPLITS = (Q_LORA, KV_LORA, QK_ROPE, D_MLA,
          D_CONV, D_CONV, D_CONV, D_CONV,
          SHIFT_W, D_R,
          N_BRANCH * D_MODEL)
PROJ_W = Q_LORA + KV_LORA + QK_ROPE + D_MLA + 4 * D_CONV + SHIFT_W + D_R + N_BRANCH * D_MODEL

kernel_name = 'hybrid_mla_shortconv_rwkv7_step'


def rms_norm(x, g):
    xf = x.astype(jnp.float32)
    y = xf * lax.rsqrt(jnp.mean(xf * xf, axis=-1, keepdims=True) + RMS_EPS)
    return (y * g.astype(jnp.float32)).astype(x.dtype)


def split_cols(proj):
    out, idx = [], 0
    for s in SPLITS:
        out.append(proj[..., idx:idx + s])
        idx += s
    return out


def rope(x, pos):
    half = QK_ROPE // 2
    inv = ROPE_THETA ** (-jnp.arange(half, dtype=jnp.float32) / half)
    ang = pos.astype(jnp.float32)[:, None] * inv[None, :]
    cos = jnp.cos(ang)[None, :, None, :]
    sin = jnp.sin(ang)[None, :, None, :]
    xf = x.astype(jnp.float32)
    x1, x2 = xf[..., :half], xf[..., half:]
    return jnp.concatenate([x1 * cos - x2 * sin, x2 * cos + x1 * sin], axis=-1).astype(x.dtype)


def mla_attend(q_lat, q_pe, ckv, kpe, q_pos, k_pos):
    s = (jnp.einsum('bqhc,bkc->bhqk', q_lat, ckv).astype(jnp.float32)
         + jnp.einsum('bqhr,bkr->bhqk', q_pe, kpe).astype(jnp.float32)) * ATTN_SCALE
    mask = k_pos[None, :] <= q_pos[:, None]
    s = jnp.where(mask[None, None], s, -jnp.inf)
    p = jax.nn.softmax(s, axis=-1).astype(ckv.dtype)
    return jnp.einsum('bhqk,bkc->bqhc', p, ckv)


def mla_attend_blocked(q_lat, q_pe, ckv, kpe, q_pos, k_pos):
    B, Q, H, C = q_lat.shape
    nb = Q // Q_BLOCK
    ql = q_lat.reshape(B, nb, Q_BLOCK, H, C).swapaxes(0, 1)
    qp = q_pe.reshape(B, nb, Q_BLOCK, H, QK_ROPE).swapaxes(0, 1)
    qpos = q_pos.reshape(nb, Q_BLOCK)

    def one_block(args):
        a, b, c = args
        return mla_attend(a, b, ckv, kpe, c, k_pos)

    out = lax.map(one_block, (ql, qp, qpos))
    return out.swapaxes(0, 1).reshape(B, Q, H, C)


def causal_conv(u, prev, w):
    full = jnp.concatenate([prev, u], axis=1)
    T = u.shape[1]
    y = full[:, 0:T] * w[0]
    for j in range(1, CONV_W):
        y = y + full[:, j:j + T] * w[j]
    return y, full[:, T:]


def token_shift(f, prev, mu):
    f_prev = jnp.concatenate([prev[:, None], f[:, :-1]], axis=1)
    return f + mu * (f_prev - f), f[:, -1]


def rwkv7_scan(r, w, k, v, kk, a, S0):
    def step(S, inp):
        r_t, w_t, k_t, v_t, kk_t, a_t = inp
        sa = jnp.einsum('bhij,bhj->bhi', S, -kk_t)
        S = (S * w_t[:, :, None, :] + sa[..., None] * (kk_t * a_t)[:, :, None, :]
             + v_t[..., None] * k_t[:, :, None, :])
        y = jnp.einsum('bhij,bhj->bhi', S, r_t)
        return S, y

    xs = tuple(jnp.moveaxis(t.astype(jnp.float32), 1, 0) for t in (r, w, k, v, kk, a))
    S, ys = lax.scan(step, S0.astype(jnp.float32), xs)
    return jnp.moveaxis(ys, 0, 1), S


def hybrid_layer(x, c, pos, ckv_past, kpe_past, conv_prev, shift_prev, S0, p):
    B, T, _ = x.shape
    dt = x.dtype
    mod = jax.nn.silu(c) @ p['w_ada'] + p['b_ada']
    shift, scale, gate = mod[:, :D_MODEL], mod[:, D_MODEL:2 * D_MODEL], mod[:, 2 * D_MODEL:]
    u = rms_norm(x, p['norm_g']) * (1.0 + scale[:, None]) + shift[:, None]
    proj = u @ p['w_in']
    q_a, kv_a, k_rope, z_mla, cb, cc, cx, z_conv, rw, z_rw, g_merge = split_cols(proj)

    c_q = rms_norm(q_a, p['q_norm_g'])
    q = (c_q @ p['w_q_b']).reshape(B, T, MLA_HEADS, QK_NOPE + QK_ROPE)
    q_nope = q[..., :QK_NOPE]
    q_pe = rope(q[..., QK_NOPE:], pos)
    ckv = rms_norm(kv_a, p['kv_norm_g'])
    kpe = rope(k_rope[:, :, None, :], pos)[:, :, 0]
    q_lat = jnp.einsum('bthn,chn->bthc', q_nope, p['w_uk'])
    if ckv_past is None:
        o_lat = mla_attend_blocked(q_lat, q_pe, ckv, kpe, pos, pos)
    else:
        P = ckv_past.shape[1]
        keys_ckv = jnp.concatenate([ckv_past, ckv], axis=1)
        keys_kpe = jnp.concatenate([kpe_past, kpe], axis=1)
        k_pos = jnp.arange(P + T, dtype=jnp.int32)
        o_lat = mla_attend(q_lat, q_pe, keys_ckv, keys_kpe, pos, k_pos)
    o_mla = jnp.einsum('bthc,chv->bthv', o_lat, p['w_uv']).reshape(B, T, D_MLA)
    y_mla = (o_mla * jax.nn.silu(z_mla)) @ p['w_mla_out']

    conv_out, conv_state = causal_conv(cc * cx, conv_prev, p['conv_w'])
    y_conv = (jax.nn.silu(z_conv) * cb * conv_out) @ p['w_conv_out']

    rw_s, shift_state = token_shift(rw, shift_prev, p['rwkv_mu'])
    r = rw_s[..., :D_R]
    k = rw_s[..., D_R:2 * D_R]
    v = rw_s[..., 2 * D_R:3 * D_R]
    w_in = rw_s[..., 3 * D_R:3 * D_R + W_LORA]
    a_in = rw_s[..., 3 * D_R + W_LORA:]
    w_log = -jax.nn.softplus(-(p['rwkv_w0'] + jnp.tanh(w_in) @ p['rwkv_w2'])) - 0.5
    decay = jnp.exp(-jnp.exp(w_log.astype(jnp.float32)))
    a = jax.nn.sigmoid(p['rwkv_a0'] + a_in @ p['rwkv_a2'])
    hd = lambda t: t.reshape(B, T, R_HEADS, R_HEAD)
    kk = hd(k * p['rwkv_k_k']).astype(jnp.float32)
    kk = kk / jnp.maximum(jnp.sqrt(jnp.sum(kk * kk, axis=-1, keepdims=True)), 1e-12)
    k = k * (1.0 + (a - 1.0) * p['rwkv_k_a'])
    rh, kh, vh, ah, wh = hd(r), hd(k), hd(v), hd(a), hd(decay)
    y_r, S_new = rwkv7_scan(rh, wh, kh, vh, kk, ah, S0)
    mu = jnp.mean(y_r, axis=-1, keepdims=True)
    var = jnp.mean((y_r - mu) ** 2, axis=-1, keepdims=True)
    yn = ((y_r - mu) * lax.rsqrt(var + GN_EPS)).reshape(B, T, D_R)
    yn = yn * p['rwkv_gn_g'].astype(jnp.float32) + p['rwkv_gn_b'].astype(jnp.float32)
    bonus = (jnp.sum((rh * kh * p['rwkv_r_k']).astype(jnp.float32), axis=-1, keepdims=True)
             * vh.astype(jnp.float32)).reshape(B, T, D_R)
    o_rw = (yn + bonus).astype(dt)
    y_rw = (o_rw * jax.nn.silu(z_rw)) @ p['w_rwkv_out']

    gm = jax.nn.sigmoid(g_merge)
    merged = (gm[..., :D_MODEL] * y_mla + gm[..., D_MODEL:2 * D_MODEL] * y_conv
              + gm[..., 2 * D_MODEL:] * y_rw)
    x = x + gate[:, None] * (merged @ p['w_out'])
    return x, ckv, kpe, conv_state, shift_state, S_new.astype(dt)


def setup_inputs(seed: int = 0) -> dict:
    key = jax.random.key(seed)
    ks = iter(jax.random.split(key, 48))
    nrm = lambda shape, s=1.0: s * jax.random.normal(next(ks), shape, jnp.float32)
    n_pages = PAST_LEN // PAGE_SIZE
    n_used = DEC_BATCH * n_pages
    n_pool = n_used + n_used // 4
    page_table = jax.random.permutation(next(ks), n_pool)[:n_used].reshape(DEC_BATCH, n_pages).astype(jnp.int32)
    L = DEPTH
    return {
        'x_prompt': nrm((BATCH, SEQ, D_MODEL)),
        'x_sample': nrm((DEC_BATCH, DEC_SEQ, D_MODEL)),
        'cache_mla_ckv': nrm((L, n_pool, PAGE_SIZE, KV_LORA)),
        'cache_mla_kpe': nrm((L, n_pool, PAGE_SIZE, QK_ROPE)),
        'state_conv': nrm((L, DEC_BATCH, CONV_W - 1, D_CONV)),
        'state_rwkv_shift': nrm((L, DEC_BATCH, SHIFT_W)),
        'state_rwkv': nrm((L, DEC_BATCH, R_HEADS, R_HEAD, R_HEAD), 0.5),
        'page_table': page_table,
        'c_prompt': nrm((BATCH, D_MODEL)),
        'c_sample': nrm((DEC_BATCH, D_MODEL)),
        'norm_g': 1.0 + nrm((L, D_MODEL), 0.02),
        'w_ada': nrm((L, D_MODEL, 3 * D_MODEL), 0.3 * D_MODEL ** -0.5),
        'b_ada': nrm((L, 3 * D_MODEL), 0.02),
        'w_in': nrm((L, D_MODEL, PROJ_W), D_MODEL ** -0.5),
        'q_norm_g': 1.0 + nrm((L, Q_LORA), 0.02),
        'w_q_b': nrm((L, Q_LORA, MLA_HEADS * (QK_NOPE + QK_ROPE)), Q_LORA ** -0.5),
        'kv_norm_g': 1.0 + nrm((L, KV_LORA), 0.02),
        'w_uk': nrm((L, KV_LORA, MLA_HEADS, QK_NOPE), KV_LORA ** -0.5),
        'w_uv': nrm((L, KV_LORA, MLA_HEADS, V_HEAD), KV_LORA ** -0.5),
        'w_mla_out': nrm((L, D_MLA, D_MODEL), D_MLA ** -0.5),
        'conv_w': nrm((L, CONV_W, D_CONV), CONV_W ** -0.5),
        'w_conv_out': nrm((L, D_CONV, D_MODEL), D_CONV ** -0.5),
        'rwkv_mu': jax.random.uniform(next(ks), (L, SHIFT_W), jnp.float32),
        'rwkv_w0': nrm((L, D_R), 0.5),
        'rwkv_w2': nrm((L, W_LORA, D_R), W_LORA ** -0.5),
        'rwkv_a0': nrm((L, D_R), 0.5),
        'rwkv_a2': nrm((L, A_LORA, D_R), A_LORA ** -0.5),
        'rwkv_k_k': 0.85 + nrm((L, D_R), 0.05),
        'rwkv_k_a': 1.0 + nrm((L, D_R), 0.05),
        'rwkv_r_k': nrm((L, R_HEADS, R_HEAD), 0.1),
        'rwkv_gn_g': 1.0 + nrm((L, D_R), 0.02),
        'rwkv_gn_b': nrm((L, D_R), 0.02),
        'w_rwkv_out': nrm((L, D_R, D_MODEL), D_R ** -0.5),
        'w_out': nrm((L, D_MODEL, D_MODEL), D_MODEL ** -0.5),
        'final_norm_g': 1.0 + nrm((D_MODEL,), 0.02),
    }


def reference(x_prompt, x_sample, cache_mla_ckv, cache_mla_kpe, state_conv, state_rwkv_shift,
              state_rwkv, page_table, c_prompt, c_sample, norm_g, w_ada, b_ada, w_in, q_norm_g,
              w_q_b, kv_norm_g, w_uk, w_uv, w_mla_out, conv_w, w_conv_out, rwkv_mu, rwkv_w0,
              rwkv_w2, rwkv_a0, rwkv_a2, rwkv_k_k, rwkv_k_a, rwkv_r_k, rwkv_gn_g, rwkv_gn_b,
              w_rwkv_out, w_out, final_norm_g):
    bp, tp = x_prompt.shape[0], x_prompt.shape[1]
    bs, ts = x_sample.shape[0], x_sample.shape[1]
    past = page_table.shape[1] * PAGE_SIZE
    pos_p = jnp.arange(tp, dtype=jnp.int32)
    pos_s = past + jnp.arange(ts, dtype=jnp.int32)
    dt = x_prompt.dtype
    xp, xs = x_prompt, x_sample
    st_p = ([], [], [], [], [])
    st_s = ([], [], [], [], [])
    for l in range(DEPTH):
        p = {'norm_g': norm_g[l], 'w_ada': w_ada[l], 'b_ada': b_ada[l], 'w_in': w_in[l],
             'q_norm_g': q_norm_g[l], 'w_q_b': w_q_b[l], 'kv_norm_g': kv_norm_g[l],
             'w_uk': w_uk[l], 'w_uv': w_uv[l], 'w_mla_out': w_mla_out[l], 'conv_w': conv_w[l],
             'w_conv_out': w_conv_out[l], 'rwkv_mu': rwkv_mu[l], 'rwkv_w0': rwkv_w0[l],
             'rwkv_w2': rwkv_w2[l], 'rwkv_a0': rwkv_a0[l], 'rwkv_a2': rwkv_a2[l],
             'rwkv_k_k': rwkv_k_k[l], 'rwkv_k_a': rwkv_k_a[l], 'rwkv_r_k': rwkv_r_k[l],
             'rwkv_gn_g': rwkv_gn_g[l], 'rwkv_gn_b': rwkv_gn_b[l], 'w_rwkv_out': w_rwkv_out[l],
             'w_out': w_out[l]}
        xp, ckv, kpe, cst, sst, rst = hybrid_layer(
            xp, c_prompt, pos_p, None, None,
            jnp.zeros((bp, CONV_W - 1, D_CONV), dt), jnp.zeros((bp, SHIFT_W), dt),
            jnp.zeros((bp, R_HEADS, R_HEAD, R_HEAD), dt), p)
        for lst, val in zip(st_p, (ckv, kpe, cst, sst, rst)):
            lst.append(val)
        ckv_past = cache_mla_ckv[l][page_table].reshape(bs, past, KV_LORA)
        kpe_past = cache_mla_kpe[l][page_table].reshape(bs, past, QK_ROPE)
        xs, ckv, kpe, cst, sst, rst = hybrid_layer(
            xs, c_sample, pos_s, ckv_past, kpe_past,
            state_conv[l], state_rwkv_shift[l], state_rwkv[l], p)
        for lst, val in zip(st_s, (ckv, kpe, cst, sst, rst)):
            lst.append(val)
    y_prompt = rms_norm(xp, final_norm_g)
    y_sample = rms_norm(xs, final_norm_g)
    return (y_prompt, y_sample,
            jnp.stack(st_p[0]), jnp.stack(st_p[1]), jnp.stack(st_p[2]), jnp.stack(st_p[3]), jnp.stack(st_p[4]),
            jnp.stack(st_s[0]), jnp.stack(st_s[1]), jnp.stack(st_s[2]), jnp.stack(st_s[3]), jnp.stack(st_s[4]))
```

```cpp
#include <hip/hip_runtime.h>
#include <cstdio>
#include <cstdint>
namespace pg8 {
#define PG8_LAS __attribute__((address_space(3)))
typedef unsigned short bf16_t;
typedef short bf16x8 __attribute__((ext_vector_type(8)));
typedef float f32x4 __attribute__((ext_vector_type(4)));
typedef unsigned u32x4 __attribute__((ext_vector_type(4)));
constexpr int BM = 256, BK = 64, HALF = 128, HTB = HALF * BK * 2  , STAGE_BYTES = 8 * HTB, NXCD = 8, WGM = 8;

__host__ __device__ __forceinline__ int lds_byte(int r, int c) { const int st = (r >> 4) * 2 + (c >> 5), rr = r & 15, cc = c & 31, ob = rr * 64 + cc * 2; return st * 1024 + (ob ^ (((ob >> 9) & 1) << 5)); }
__host__ __device__ __forceinline__ void stage_rc(int b, int& R, int& C) { const int st = b / 1024, sb = b % 1024, swz = sb ^ (((sb >> 9) & 1) << 5); R = (st >> 1) * 16 + swz / 64; C = (st & 1) * 32 + (swz % 64) / 2; }
__host__ __device__ __forceinline__ int perm32(int rho) { const int n = rho >> 4, i = rho & 15; return 8 * (i >> 2) + 4 * n + (i & 3); }

struct Unit { int pm, pn; };
struct Gemm { const bf16_t* A; const bf16_t* Bt; int M, N, K; };

struct StaticOrder {
    int nM, nN, nwg, G, c;
    __host__ __device__ void init(int M, int N, int G_, int c_) { nM = M / BM; nN = N / BM; nwg = nM * nN; G = G_; c = c_; }
    __host__ __device__ bool next(int i, Unit& u) const {
        const long L = (long)i * G + c; if (L >= nwg) return false;
        int wgid = (int)L; { const int q = nwg / NXCD, r = nwg % NXCD, xcd = wgid % NXCD, off = wgid / NXCD; wgid = (xcd < r ? xcd * (q + 1) : r * (q + 1) + (xcd - r) * q) + off; }
        const int nig = WGM * nN, gid = wgid / nig, fm = gid * WGM, gsz = (nM - fm) < WGM ? (nM - fm) : WGM;
        u.pm = fm + ((wgid % nig) % gsz); u.pn = (wgid % nig) / gsz; return true;
    }
    __device__ __forceinline__ void a_ready(const Unit&) const {}
    __device__ __forceinline__ void done(const Unit&) const {}
    __device__ __forceinline__ bool keep(const Unit&) const { return false; }
};
__device__ __forceinline__ unsigned cvt_pk_bf16(float lo, float hi) { unsigned r; asm volatile("v_cvt_pk_bf16_f32 %0, %1, %2" : "=v"(r) : "v"(lo), "v"(hi)); return r; }
typedef float f32x2 __attribute__((ext_vector_type(2)));
template <class Epi, class Sched, bool ALIGN_EPI = false, bool SP2 = false>
__device__ __forceinline__ void gemm_phase(PG8_LAS unsigned char* lds, const Gemm g, const Sched& S, const Epi& E, int wave0) {
    int lane_l, wid_l = wave0; asm volatile("v_mbcnt_lo_u32_b32 %0, -1, 0\n\tv_mbcnt_hi_u32_b32 %0, -1, %0" : "=v"(lane_l)); asm volatile("" : "+s"(wid_l)); const int wid = wid_l, lane = lane_l, tid = wid * 64 + lane, wr = wid >> 2, wc = wid & 3, fr = lane & 15, fq = lane >> 4;
    int K_l = g.K; asm volatile("" : "+s"(K_l)); const int K = K_l, nt = K / BK;
    unsigned voffA[2], voffB[2];
#pragma unroll
    for (int i = 0; i < 2; ++i) { int R, C; stage_rc(tid * 16 + i * 8192, R, C); const int Rb = Epi::PERM ? ((R & ~31) + perm32(R & 31)) : R;
        voffA[i] = (unsigned)(R * K + C) * 2u; voffB[i] = (unsigned)(Rb * K + C) * 2u; }
    const size_t kstep = (size_t)(BK * 2);
    const size_t hstep = (size_t)HALF * K * 2;
    const size_t tstep = 2 * hstep;
    const unsigned ldsw = (unsigned)wid * 1024u;
    const int aoff = lds_byte(wr * 64 + fr, fq * 8), boff = lds_byte(wc * 32 + fr, fq * 8);
#define PG8_SA(b, h) (((b) * 2 + (h)) * HTB)
#define PG8_SB(b, h) ((4 + (b) * 2 + (h)) * HTB)
#define PG8_STAGE(bufoff, gbase, voff) do { _Pragma("unroll") for (int _i = 0; _i < 2; ++_i) \
        __builtin_amdgcn_global_load_lds((const unsigned*)((const char*)(gbase) + (voff)[_i]), (PG8_LAS unsigned*)(lds + (bufoff) + ldsw + _i * 8192), 16, 0, 0); } while (0)
#define PG8_LDA(dst, b, h) do { _Pragma("unroll") for (int m = 0; m < 4; ++m) _Pragma("unroll") for (int k = 0; k < 2; ++k) dst[m][k] = *(const PG8_LAS bf16x8*)(lds + PG8_SA(b, h) + aoff + m * 2048 + k * 1024); } while (0)
#define PG8_LDB(dst, b, h) do { _Pragma("unroll") for (int n = 0; n < 2; ++n) _Pragma("unroll") for (int k = 0; k < 2; ++k) dst[n][k] = *(const PG8_LAS bf16x8*)(lds + PG8_SB(b, h) + boff + n * 2048 + k * 1024); } while (0)
#define PG8_MMA(ai, bj, At, Bt) do { __builtin_amdgcn_s_setprio(1); _Pragma("unroll") for (int m = 0; m < 4; ++m) _Pragma("unroll") for (int n = 0; n < 2; ++n) _Pragma("unroll") for (int k = 0; k < 2; ++k) \
        acc[ai][bj][m][n] = __builtin_amdgcn_mfma_f32_16x16x32_bf16(Bt[n][k], At[m][k], acc[ai][bj][m][n], 0, 0, 0); __builtin_amdgcn_s_setprio(0); } while (0)
#define PG8_WAIT_V(n) asm volatile("s_waitcnt vmcnt(" #n ")" ::: "memory")
#define PG8_WAIT_L(n) asm volatile("s_waitcnt lgkmcnt(" #n ")" ::: "memory")
#define PG8_BAR __builtin_amdgcn_s_barrier()
#define PG8_SCHED __builtin_amdgcn_sched_barrier(0)
    Unit cur, nxt; int ui = 0;
    if (!S.next(0, cur)) return;
    f32x4 acc[2][2][4][2];
#pragma unroll
    for (int a = 0; a < 2; ++a)
#pragma unroll
        for (int b = 0; b < 2; ++b)
#pragma unroll
            for (int m = 0; m < 4; ++m)
#pragma unroll
                for (int n = 0; n < 2; ++n) acc[a][b][m][n] = (f32x4){0.f, 0.f, 0.f, 0.f};
    bf16x8 At[4][2], B0[2][2], B1[2][2];
    const char* cA = (const char*)g.A + (size_t)cur.pm * tstep; const char* cB = (const char*)g.Bt + (size_t)cur.pn * tstep;
    S.a_ready(cur);
    if constexpr (SP2) {
        PG8_STAGE(PG8_SB(0, 0), cB, voffB); PG8_STAGE(PG8_SB(0, 1), cB + hstep, voffB); PG8_STAGE(PG8_SA(0, 0), cA, voffA); PG8_STAGE(PG8_SA(0, 1), cA + hstep, voffA);
        if (wr == 1) PG8_BAR;
        PG8_WAIT_V(2); PG8_BAR;
        PG8_STAGE(PG8_SB(1, 0), cB + kstep, voffB); PG8_STAGE(PG8_SA(1, 0), cA + kstep, voffA); PG8_STAGE(PG8_SB(1, 1), cB + hstep + kstep, voffB);
        PG8_WAIT_V(6); PG8_BAR;
    } else {
        PG8_STAGE(PG8_SB(0, 0), cB, voffB); PG8_STAGE(PG8_SA(0, 0), cA, voffA); PG8_STAGE(PG8_SB(0, 1), cB + hstep, voffB); PG8_STAGE(PG8_SA(0, 1), cA + hstep, voffA);
        if (wr == 1) PG8_BAR;
        PG8_WAIT_V(4); PG8_BAR;
        PG8_STAGE(PG8_SB(1, 0), cB + kstep, voffB); PG8_STAGE(PG8_SA(1, 0), cA + kstep, voffA); PG8_STAGE(PG8_SB(1, 1), cB + hstep + kstep, voffB);
        PG8_WAIT_V(6); PG8_BAR;
    }
    for (;;) {
        const bool has_next = S.next(ui + 1, nxt);
        const char* nA = has_next ? (const char*)g.A + (size_t)nxt.pm * tstep : cA; const char* nB = has_next ? (const char*)g.Bt + (size_t)nxt.pn * tstep : cB;
        for (int t = 0; t < nt; t += 2) {
            const bool last = (t == nt - 2);
            const char* a1 = cA + (size_t)(t + 1) * kstep;
            const char* a2 = last ? nA : cA + (size_t)(t + 2) * kstep; const char* b2 = last ? nB : cB + (size_t)(t + 2) * kstep;
            const char* a3 = a2 + kstep; const char* b3 = b2 + kstep;
            if (last && has_next) S.a_ready(nxt);
            if constexpr (SP2) {
            PG8_LDB(B0, 0, 0); PG8_LDB(B1, 0, 1); PG8_SCHED; PG8_LDA(At, 0, 0); PG8_STAGE(PG8_SA(1, 1), a1 + hstep, voffA);
            PG8_WAIT_V(8); PG8_WAIT_L(0); PG8_BAR; PG8_MMA(0, 0, At, B0); PG8_MMA(0, 1, At, B1); PG8_BAR; PG8_SCHED;
            PG8_LDA(At, 0, 1); PG8_STAGE(PG8_SB(0, 0), b2, voffB); PG8_STAGE(PG8_SB(0, 1), b2 + hstep, voffB); PG8_STAGE(PG8_SA(0, 0), a2, voffA);
            PG8_WAIT_V(8); PG8_WAIT_L(0); PG8_BAR; PG8_MMA(1, 0, At, B0); PG8_MMA(1, 1, At, B1); PG8_BAR; PG8_SCHED;
            PG8_LDB(B0, 1, 0); PG8_LDB(B1, 1, 1); PG8_SCHED; PG8_LDA(At, 1, 0); PG8_STAGE(PG8_SA(0, 1), a2 + hstep, voffA);
            PG8_WAIT_V(8); PG8_WAIT_L(0); PG8_BAR; PG8_MMA(0, 0, At, B0); PG8_MMA(0, 1, At, B1); PG8_BAR; PG8_SCHED;
            PG8_LDA(At, 1, 1); PG8_STAGE(PG8_SB(1, 0), b3, voffB); PG8_STAGE(PG8_SB(1, 1), b3 + hstep, voffB); PG8_STAGE(PG8_SA(1, 0), a3, voffA);
            PG8_WAIT_V(8); PG8_WAIT_L(0); PG8_BAR; PG8_MMA(1, 0, At, B0); PG8_MMA(1, 1, At, B1); PG8_BAR; PG8_SCHED;
            } else {
            PG8_LDB(B0, 0, 0); PG8_SCHED; PG8_LDA(At, 0, 0); PG8_STAGE(PG8_SA(1, 1), a1 + hstep, voffA);
            PG8_WAIT_L(8); PG8_BAR; PG8_WAIT_L(0); PG8_MMA(0, 0, At, B0); PG8_BAR; PG8_SCHED;
            PG8_LDB(B1, 0, 1); PG8_STAGE(PG8_SB(0, 0), b2, voffB);
            PG8_BAR; PG8_WAIT_L(0); PG8_MMA(0, 1, At, B1); PG8_BAR;
            PG8_LDA(At, 0, 1); PG8_STAGE(PG8_SA(0, 0), a2, voffA);
            PG8_BAR; PG8_WAIT_L(0); PG8_MMA(1, 0, At, B0); PG8_BAR; PG8_SCHED;
            PG8_STAGE(PG8_SB(0, 1), b2 + hstep, voffB);
            PG8_WAIT_V(6); PG8_BAR; PG8_MMA(1, 1, At, B1); PG8_BAR;
            PG8_LDB(B0, 1, 0); PG8_SCHED; PG8_LDA(At, 1, 0); PG8_STAGE(PG8_SA(0, 1), a2 + hstep, voffA);
            PG8_WAIT_L(8); PG8_BAR; PG8_WAIT_L(0); PG8_MMA(0, 0, At, B0); PG8_BAR; PG8_SCHED;
            PG8_LDB(B1, 1, 1); PG8_STAGE(PG8_SB(1, 0), b3, voffB);
            PG8_BAR; PG8_WAIT_L(0); PG8_MMA(0, 1, At, B1); PG8_BAR;
            PG8_LDA(At, 1, 1); PG8_STAGE(PG8_SA(1, 0), a3, voffA);
            PG8_BAR; PG8_WAIT_L(0); PG8_MMA(1, 0, At, B0); PG8_BAR; PG8_SCHED;
            PG8_STAGE(PG8_SB(1, 1), b3 + hstep, voffB);
            PG8_WAIT_V(6); PG8_BAR; PG8_MMA(1, 1, At, B1); PG8_BAR;
            }
        }
        if constexpr (ALIGN_EPI) { if (wr == 0) PG8_BAR; }
        if constexpr (!Epi::AFTER_DRAIN) { E(acc, cur, wr, wc, fr, fq); S.done(cur); }
        if (!has_next) break;
        if (!S.keep(cur))
#pragma unroll
        for (int a = 0; a < 2; ++a)
#pragma unroll
            for (int b = 0; b < 2; ++b)
#pragma unroll
                for (int m = 0; m < 4; ++m)
#pragma unroll
                    for (int n = 0; n < 2; ++n) acc[a][b][m][n] = (f32x4){0.f, 0.f, 0.f, 0.f};
        cur = nxt; cA = nA; cB = nB; ++ui;
        if constexpr (ALIGN_EPI) { if (wr == 1) PG8_BAR; }
    }
    PG8_WAIT_V(0);
    if constexpr (!ALIGN_EPI) { if (wr == 0) PG8_BAR; }
    PG8_BAR;
    if constexpr (Epi::AFTER_DRAIN) { E.fused(acc, cur, wr, wc, fr, fq, lds, wid, lane); S.done(cur); }
#undef PG8_SA
#undef PG8_SB
#undef PG8_STAGE
#undef PG8_LDA
#undef PG8_LDB
#undef PG8_MMA
#undef PG8_WAIT_V
#undef PG8_WAIT_L
#undef PG8_BAR
#undef PG8_SCHED
}
}

constexpr int NWAVES = 8, NTHR = 512;
constexpr int DM = 1024, NB_P = 8, SEQ = 2048, NB_S = 32, TSMP = 8, DEPTH = 2;
constexpr int MP = NB_P * SEQ, MS = NB_S * TSMP, MT = MP + MS;
constexpr int PAST = 16384, PAGE = 128, NPAGES = 128, NPOOL = 5120;
constexpr int NH = 8, QKN = 64, QKR = 32, DQK = 96, VH = 64, QL = 384, KVL = 256, DMLA = 512;
constexpr int DC = 256, RH = 4, RN = 64, DR = 256, SW = 896, WL = 64;
constexpr int PROJ_SRC = 6432, NPROJ = 6656, PW = 6144;
constexpr int C_KV = 0, C_KR = 256, C_ZM = 384, C_CB = 896, C_CC = 1152, C_CX = 1408, C_ZC = 1664, C_RW = 1920, C_ZR = 2816, C_GM = 3072;
constexpr int NCB = NB_P + NB_S;
constexpr float RMS_EPS = 1e-6f, GN_EPS = 64e-5f;
constexpr float SC2 = 0.10206207261596577f * 1.4426950408889634f;
constexpr int NROPE = SEQ + TSMP;

constexpr size_t O_YP = 0, O_YS = O_YP + (size_t)MP * DM, O_CKVP = O_YS + (size_t)MS * DM, O_KPEP = O_CKVP + (size_t)DEPTH * MP * KVL,
    O_CONVP = O_KPEP + (size_t)DEPTH * MP * QKR, O_SHP = O_CONVP + (size_t)DEPTH * NB_P * 2 * DC, O_RWP = O_SHP + (size_t)DEPTH * NB_P * SW,
    O_CKVS = O_RWP + (size_t)DEPTH * NB_P * RH * RN * RN, O_KPES = O_CKVS + (size_t)DEPTH * MS * KVL, O_CONVS = O_KPES + (size_t)DEPTH * MS * QKR,
    O_SHS = O_CONVS + (size_t)DEPTH * NB_S * 2 * DC, O_RWS = O_SHS + (size_t)DEPTH * NB_S * SW, O_END = O_RWS + (size_t)DEPTH * NB_S * RH * RN * RN;
static_assert(O_END == 28047360, "output size");

constexpr size_t MiB = 1u << 20;
constexpr size_t al256(size_t x) { return (x + 255) & ~(size_t)255; }
constexpr size_t WS_CTL = 0;
constexpr size_t WS_MOD = 1 * MiB;
constexpr size_t WS_ZERO_BYTES = 2 * MiB;
static_assert((size_t)DEPTH * NCB * 3072 * 4 <= MiB, "MOD fits");
constexpr size_t WS_ROPE = 2 * MiB;
constexpr size_t WS_RSQ = WS_ROPE + al256((size_t)NROPE * 32 * 4);
constexpr size_t WS_W = 3 * MiB;
constexpr size_t LW_IN = 0, LW_Q = LW_IN + (size_t)NPROJ * DM * 2, LW_KV = LW_Q + (size_t)768 * QL * 2, LW_MLA = LW_KV + (size_t)1024 * KVL * 2,
    LW_CONV = LW_MLA + (size_t)DM * DMLA * 2, LW_RW = LW_CONV + (size_t)DM * DC * 2, LW_OUT = LW_RW + (size_t)DM * DR * 2, LW_W2T = LW_OUT + (size_t)DM * DM * 2, LW_A2T = LW_W2T + (size_t)DR * WL * 2, LW_STRIDE = LW_A2T + (size_t)DR * WL * 2;
constexpr size_t WS_U = al256(WS_W + 2 * LW_STRIDE);
constexpr size_t WS_QA = WS_U + (size_t)MT * DM * 2;
constexpr size_t WS_PROJ = WS_QA + (size_t)MT * QL * 2;
constexpr size_t WS_CKV = WS_PROJ + (size_t)MT * PW * 2;
constexpr size_t WS_KPE = WS_CKV + (size_t)MT * KVL * 2;
constexpr size_t WS_A4 = WS_KPE + (size_t)MT * QKR * 2;
constexpr size_t A4_STRIDE = (size_t)MT * 256;
constexpr size_t WS_SC = WS_A4 + 4 * A4_STRIDE * 2;
constexpr size_t WS_BONUS = WS_SC + (size_t)MT * 6 * DR * 4;
constexpr size_t WS_Q = WS_BONUS + (size_t)MT * DR * 4;
constexpr size_t WS_QS = WS_Q + (size_t)MP * 768 * 2;
constexpr size_t WS_KN = WS_QS + (size_t)MS * 768 * 4;
constexpr size_t WS_V = WS_KN + (size_t)MP * 512 * 2;
constexpr size_t WS_QLAT = WS_V + (size_t)MP * 512 * 2;
constexpr size_t WS_PO = WS_QLAT + (size_t)NB_S * 64 * 288 * 2;
constexpr size_t WS_PM = WS_PO + (size_t)NB_S * 8 * 64 * 256 * 4;
constexpr size_t WS_PL = WS_PM + (size_t)NB_S * 8 * 64 * 4;
constexpr size_t WS_MG = WS_PL + (size_t)NB_S * 8 * 64 * 4;
constexpr size_t WS_MERGED = WS_MG + (size_t)MT * DM * 2;
constexpr size_t WS_X1 = WS_MERGED + (size_t)MT * DM * 2;
constexpr size_t WS_X2 = WS_X1 + (size_t)MT * DM * 4;
constexpr size_t WS_YL = WS_X2 + (size_t)MT * DM * 4;
constexpr size_t WS_YP = WS_YL + (size_t)MP * DR * 4;
constexpr size_t WS_QC = WS_YP + (size_t)MP * DR * 4;
constexpr int RCL = 32, RNC = SEQ / RCL;
constexpr size_t WS_PC = WS_QC + (size_t)32 * RNC * 4096 * 4;
constexpr size_t WS_SALL = WS_PC + (size_t)32 * RNC * 4096 * 2;
constexpr size_t WS_END = WS_SALL + (size_t)32 * RNC * 4096 * 4;
constexpr int CW_BAR = 4096;

constexpr int RING_OFF = 0, RING_BYTES = 131072;
constexpr int LDSCTL_OFF = RING_BYTES, MISC_OFF = LDSCTL_OFF + 320;
constexpr int LDS_BYTES = 147456;

#define GAS __attribute__((address_space(1)))
#define LAS __attribute__((address_space(3)))
typedef unsigned short bf16;
typedef unsigned v4u __attribute__((ext_vector_type(4)));
typedef unsigned v2u __attribute__((ext_vector_type(2)));
typedef float f32x4 __attribute__((ext_vector_type(4)));
typedef float f32x2 __attribute__((ext_vector_type(2)));
typedef float f32x16 __attribute__((ext_vector_type(16)));
typedef short bf16x8 __attribute__((ext_vector_type(8)));
typedef short s16x4 __attribute__((ext_vector_type(4)));
typedef short v4i16_t __attribute__((ext_vector_type(4)));
#define LDS_WAIT() asm volatile("s_waitcnt lgkmcnt(0)" ::: "memory")
#define VM_WAIT() asm volatile("s_waitcnt vmcnt(0)" ::: "memory")
typedef float f32x2_t __attribute__((ext_vector_type(2)));
typedef __bf16 bf16x2_t __attribute__((ext_vector_type(2)));
__device__ __forceinline__ unsigned pk2(float lo, float hi) { f32x2_t v = {lo, hi}; bf16x2_t b = __builtin_convertvector(v, bf16x2_t); return __builtin_bit_cast(unsigned, b); }
__device__ __forceinline__ unsigned f2bf(float f) { return pk2(f, 0.f) & 0xffffu; }
__device__ __forceinline__ float bflo(unsigned u) { return __builtin_bit_cast(float, u << 16); }
__device__ __forceinline__ float bfhi(unsigned u) { return __builtin_bit_cast(float, u & 0xffff0000u); }
__device__ __forceinline__ float bf1(bf16 b) { return __builtin_bit_cast(float, ((unsigned)b) << 16); }
#define SHX(x, o) __builtin_bit_cast(float, __builtin_amdgcn_ds_bpermute(((lane) ^ (o)) << 2, __builtin_bit_cast(int, (float)(x))))
__device__ __forceinline__ float wave_sum_l(float v, int lane) {
#pragma unroll
    for (int o = 1; o < 64; o <<= 1) v += SHX(v, o);
    return v;
}
__device__ __forceinline__ float grp16_sum_l(float v, int lane) {
#pragma unroll
    for (int o = 1; o < 16; o <<= 1) v += SHX(v, o);
    return v;
}
#define RDL(x, k) __builtin_bit_cast(float, __builtin_amdgcn_readlane(__builtin_bit_cast(int, (float)(x)), (k)))
#define wave_sum(v) wave_sum_l((v), lane)
#define grp16_sum(v) grp16_sum_l((v), lane)
__device__ __forceinline__ float fexp(float x) { return __builtin_amdgcn_exp2f(x * 1.4426950408889634f); }
__device__ __forceinline__ float frcp(float x) { return __builtin_amdgcn_rcpf(x); }
__device__ __forceinline__ float frsq(float x) { return __builtin_amdgcn_rsqf(x); }
__device__ __forceinline__ float sigm(float x) { return frcp(1.f + fexp(-x)); }
__device__ __forceinline__ float silu(float x) { return x * frcp(1.f + fexp(-x)); }
__device__ __forceinline__ void row_info(int m, int& b, int& t, int& T, int& cb, int& pidx) {
    if (m < MP) { b = m >> 11; t = m & 2047; T = SEQ; cb = b; pidx = t; }
    else { const int mm = m - MP; b = mm >> 3; t = mm & 7; T = TSMP; cb = NB_P + b; pidx = SEQ + t; }
}
#define XB_TMO      128
#define XB_XCNT(j)  (256  + 64 * (j))
#define XB_XSUB(j)  (1280 + 64 * (j))
#define XB_XGEN(j)  (2304 + 64 * (j))
#define XB_TOP      3328
#define XB_TOPGEN   3392
#define XCD_BAR_WORDS 3456
#define XB_SPIN_CAP (1u << 18)

__device__ __forceinline__ unsigned xb_ld(unsigned* p)              { return __hip_atomic_load(p, __ATOMIC_RELAXED, __HIP_MEMORY_SCOPE_AGENT); }
__device__ __forceinline__ unsigned xb_add(unsigned* p, unsigned v) { return __hip_atomic_fetch_add(p, v, __ATOMIC_RELAXED, __HIP_MEMORY_SCOPE_AGENT); }
__device__ __forceinline__ unsigned xb_xcc_id() { return (unsigned)__builtin_amdgcn_s_getreg((3 << 11) | 20) & 0xFu; }
#define XB_SPIN(cond, bar) do { unsigned _sp = 0; while (cond) { __builtin_amdgcn_s_sleep(1); \
    if ((++_sp & 255u) == 0u) { if (xb_ld(&(bar)[XB_TMO])) break; if (_sp > XB_SPIN_CAP) { atomicAdd(&(bar)[XB_TMO], 1u); break; } } } } while (0)

struct XcdBarrier {
    unsigned* bar; unsigned x;
    volatile LAS unsigned* st;
};

__device__ __forceinline__ XcdBarrier xcd_barrier_post(unsigned* bar, volatile LAS unsigned* st) {
    XcdBarrier b; b.bar = bar; b.x = xb_xcc_id(); b.st = st;
    if (threadIdx.x == 0) (void)xb_add(&bar[XB_XCNT(b.x)], 1u);
    return b;
}
__device__ __forceinline__ void xcd_barrier_complete(unsigned* bar, unsigned x, unsigned& nloc, unsigned& nx) {
    const unsigned G = gridDim.x * gridDim.y * gridDim.z;
    unsigned sum, cnt, mine, sp = 0u;
    for (;;) {
        sum = 0u; cnt = 0u; mine = 0u;
#pragma unroll
        for (unsigned j = 0; j < 16; ++j) { const unsigned c = xb_ld(&bar[XB_XCNT(j)]); sum += c; cnt += (c > 0u) ? 1u : 0u; mine = (j == x) ? c : mine; }
        if (sum == G) break;
        __builtin_amdgcn_s_sleep(1);
        if ((++sp & 255u) == 0u) { if (xb_ld(&bar[XB_TMO])) break; if (sp > XB_SPIN_CAP) { atomicAdd(&bar[XB_TMO], 1u); break; } }
    }
    nloc = mine > 0u ? mine : 1u; nx = cnt > 0u ? cnt : 1u;
}

__device__ __forceinline__ void xcd_barrier(const XcdBarrier& b) {
    asm volatile("s_waitcnt vmcnt(0)" ::: "memory");
    __syncthreads();
    if (threadIdx.x == 0) {
        unsigned* bar = b.bar;
        __builtin_amdgcn_s_waitcnt(0);
        unsigned nloc = b.st[0], nx = b.st[1];
        if (nloc == 0u) { xcd_barrier_complete(bar, b.x, nloc, nx); b.st[0] = nloc; b.st[1] = nx; }
        const unsigned old = xb_add(&bar[XB_XSUB(b.x)], 1u);
        const unsigned gen = old / nloc;
        if (old + 1u == (gen + 1u) * nloc) {
            __builtin_amdgcn_fence(__ATOMIC_RELEASE, "agent");
            asm volatile("s_waitcnt vmcnt(0)" ::: "memory");
            const unsigned og = xb_add(&bar[XB_TOP], 1u);
            const unsigned tg = og / nx;
            if (og + 1u == (tg + 1u) * nx) xb_add(&bar[XB_TOPGEN], 1u);
            else XB_SPIN(xb_ld(&bar[XB_TOPGEN]) == tg, bar);
            __builtin_amdgcn_fence(__ATOMIC_ACQUIRE, "agent");
            xb_add(&bar[XB_XGEN(b.x)], 1u);
            asm volatile("s_waitcnt vmcnt(0)" ::: "memory");
        } else {
            XB_SPIN(xb_ld(&bar[XB_XGEN(b.x)]) == gen, bar);
            __builtin_amdgcn_fence(__ATOMIC_ACQUIRE, "agent");
            asm volatile("s_waitcnt vmcnt(0)" ::: "memory");
        }
    }
    __syncthreads();
}

#ifndef PROBE_DBL
#define PROBE_DBL 0
#endif
struct Args { const void* in[35]; float* out; unsigned char* ws; int ph_lo, ph_hi; };
enum { I_XP = 0, I_XS, I_CCKV, I_CKPE, I_SCONV, I_SSHIFT, I_SRWKV, I_PT, I_CP, I_CS, I_NORMG, I_WADA, I_BADA, I_WIN, I_QNG, I_WQB, I_KVNG, I_WUK, I_WUV, I_WMLA,
       I_CONVW, I_WCONV, I_MU, I_W0, I_W2, I_A0, I_A2, I_KK, I_KA, I_RK, I_GNG, I_GNB, I_WRW, I_WOUT, I_FNG };
#define INF(i) ((const float*)a.in[i])

struct ColIdent { int off; __device__ __forceinline__ int operator()(int d) const { return d + off; } };
struct ColWin { __device__ __forceinline__ int operator()(int d) const {
    if (d < 384) return d; if (d < 512) return -1; const int pc = d - 512;
    if (pc < 256) return 384 + pc;
    if (pc < 384) return (pc - 256 < 32) ? 640 + pc - 256 : -1;
    if (pc < 896) return 672 + pc - 384;
    if (pc < 1920) return 1184 + pc - 896;
    if (pc < 2816) return 2208 + pc - 1920;
    if (pc < 3072) return 3104 + pc - 2816;
    return 3360 + pc - 3072; } };
struct ColWq { __device__ __forceinline__ int operator()(int d) const { const int h = d / 96, j = d - h * 96; if (j < 64) return d; const int i = (j - 64) >> 1, par = (j - 64) & 1; return h * 96 + 64 + par * 16 + i; } };

template <class SrcCol>
__device__ __forceinline__ void tr_item(const float* __restrict__ W, int K, int Nsrc, bf16* WT, LAS float* scr, int item, int nblk, int lane, SrcCol sc, const float* __restrict__ kscale) {
    const int kb = item / nblk, nb = item - kb * nblk, k0 = 64 * kb, n0 = 32 * nb;
    const int srcc = sc(n0 + (lane & 31));
    float tv[32];
#pragma unroll
    for (int i = 0; i < 32; ++i) { const int kk = 2 * i + (lane >> 5); float v = 0.f; if (srcc >= 0) v = W[(size_t)(k0 + kk) * Nsrc + srcc]; if (kscale) v *= kscale[k0 + kk]; tv[i] = v; }
#pragma unroll
    for (int i = 0; i < 32; ++i) { const int kk = 2 * i + (lane >> 5); scr[kk * 33 + (lane & 31)] = tv[i]; }
    LDS_WAIT(); asm volatile("" ::: "memory");
    const int c = lane & 7;
#pragma unroll
    for (int j = 0; j < 4; ++j) { const int n = (lane >> 3) + 8 * j; const LAS float* s = scr + (8 * c) * 33 + n;
        v4u o; o.x = pk2(s[0], s[33]); o.y = pk2(s[66], s[99]); o.z = pk2(s[132], s[165]); o.w = pk2(s[198], s[231]);
        *(GAS v4u*)(WT + (size_t)(n0 + n) * K + k0 + 8 * c) = o; }
    LDS_WAIT(); asm volatile("" ::: "memory");
}

__device__ __forceinline__ void convert_weights(const Args& a, unsigned char* ws, LAS unsigned char* lds, int lane, int wave, int l, int gw, int NGW) {
    LAS float* scr = (LAS float*)(lds + wave * 16384);
    constexpr int I_IN = (DM / 64) * (NPROJ / 32), I_Q = (QL / 64) * (768 / 32), I_K = (KVL / 64) * (512 / 32), I_MLA = (DMLA / 64) * (DM / 32), I_C = (DC / 64) * (DM / 32), I_O = (DM / 64) * (DM / 32);
    constexpr int I_L = (WL / 64) * (DR / 32);
    constexpr int PER_L = I_IN + I_Q + 2 * I_K + I_MLA + 2 * I_C + I_O + 2 * I_L;
    unsigned char* wl = ws + WS_W + (size_t)l * LW_STRIDE;
    for (int rep_ = 0; rep_ < (((PROBE_DBL >> 21) & 1) ? 2 : 1); ++rep_)
    for (int it = gw; it < PER_L; it += NGW) {
        int r = it;
        if (r < I_IN) { tr_item(INF(I_WIN) + (size_t)l * DM * PROJ_SRC, DM, PROJ_SRC, (bf16*)(wl + LW_IN), scr, r, NPROJ / 32, lane, ColWin{}, nullptr); continue; } r -= I_IN;
        if (r < I_Q) { tr_item(INF(I_WQB) + (size_t)l * QL * 768, QL, 768, (bf16*)(wl + LW_Q), scr, r, 768 / 32, lane, ColWq{}, INF(I_QNG) + l * QL); continue; } r -= I_Q;
        if (r < I_K) { tr_item(INF(I_WUK) + (size_t)l * KVL * 512, KVL, 512, (bf16*)(wl + LW_KV), scr, r, 512 / 32, lane, ColIdent{0}, nullptr); continue; } r -= I_K;
        if (r < I_K) { tr_item(INF(I_WUV) + (size_t)l * KVL * 512, KVL, 512, (bf16*)(wl + LW_KV) + (size_t)512 * KVL, scr, r, 512 / 32, lane, ColIdent{0}, nullptr); continue; } r -= I_K;
        if (r < I_MLA) { const int hfm = r >= I_MLA / 2;
            tr_item(INF(I_WMLA) + (size_t)l * DMLA * DM + (size_t)hfm * 256 * DM, 256, DM, (bf16*)(wl + LW_MLA) + (size_t)hfm * DM * 256, scr, r - hfm * (I_MLA / 2), DM / 32, lane, ColIdent{0}, nullptr); continue; } r -= I_MLA;
        if (r < I_C) { tr_item(INF(I_WCONV) + (size_t)l * DC * DM, DC, DM, (bf16*)(wl + LW_CONV), scr, r, DM / 32, lane, ColIdent{0}, nullptr); continue; } r -= I_C;
        if (r < I_C) { tr_item(INF(I_WRW) + (size_t)l * DR * DM, DR, DM, (bf16*)(wl + LW_RW), scr, r, DM / 32, lane, ColIdent{0}, nullptr); continue; } r -= I_C;
        if (r < I_O) { tr_item(INF(I_WOUT) + (size_t)l * DM * DM, DM, DM, (bf16*)(wl + LW_OUT), scr, r, DM / 32, lane, ColIdent{0}, nullptr); continue; } r -= I_O;
        if (r < I_L) { tr_item(INF(I_W2) + (size_t)l * WL * DR, WL, DR, (bf16*)(wl + LW_W2T), scr, r, DR / 32, lane, ColIdent{0}, nullptr); continue; } r -= I_L;
        tr_item(INF(I_A2) + (size_t)l * WL * DR, WL, DR, (bf16*)(wl + LW_A2T), scr, r, DR / 32, lane, ColIdent{0}, nullptr);
    }
}

__device__ __forceinline__ void phase_prologue(const Args& a, LAS unsigned char* lds, int tid, int lane, int wave) {
    GAS unsigned char* wsg_ = (GAS unsigned char*)a.ws; asm volatile("" : "+s"(wsg_)); unsigned char* ws = (unsigned char*)wsg_;
    for (int arep_ = 0; arep_ < (((PROBE_DBL >> 22) & 1) ? 2 : 1); ++arep_)
    if (blockIdx.x < 192) {
        const int task = blockIdx.x, l = task / 96, rem = task - l * 96, kc = rem / 12, cc = rem - kc * 12;
        LAS float* tab = (LAS float*)lds;
        for (int i = 0; i < 10; ++i) { const int idx = tid + 512 * i, k = idx / 40, b = idx - k * 40;
            const float cv = (b < NB_P) ? INF(I_CP)[b * DM + kc * 128 + k] : INF(I_CS)[(b - NB_P) * DM + kc * 128 + k]; tab[idx] = silu(cv); }
        __syncthreads();
        const int j = cc * 256 + (tid & 255), half = tid >> 8;
        float acc[20];
#pragma unroll
        for (int q = 0; q < 20; ++q) acc[q] = 0.f;
        const float* wp = INF(I_WADA) + ((size_t)l * DM + kc * 128) * 3072 + j;
        for (int kb = 0; kb < 128; kb += 32) {
            float wv[32];
#pragma unroll
            for (int k = 0; k < 32; ++k) wv[k] = wp[(size_t)(kb + k) * 3072];
#pragma unroll
            for (int k = 0; k < 32; ++k) { const float w = wv[k]; const LAS f32x4* tr = (const LAS f32x4*)(tab + (kb + k) * 40 + half * 20);
#pragma unroll
                for (int q = 0; q < 5; ++q) { const f32x4 t4 = tr[q]; acc[4 * q] += t4.x * w; acc[4 * q + 1] += t4.y * w; acc[4 * q + 2] += t4.z * w; acc[4 * q + 3] += t4.w * w; } }
        }
        float* mod = (float*)(ws + WS_MOD) + ((size_t)l * NCB + half * 20) * 3072 + j;
#pragma unroll
        for (int q = 0; q < 20; ++q) unsafeAtomicAdd(mod + (size_t)q * 3072, ((PROBE_DBL >> 22) & 1) ? 0.5f * acc[q] : acc[q]);
        __syncthreads();
    }
    { const int gid = blockIdx.x * NTHR + tid;
      if (gid < NROPE * 16) { const int pidx = gid >> 4, i = gid & 15; const int pos = pidx < SEQ ? pidx : PAST + (pidx - SEQ);
        const double invd[16] = {1.0, 0.5623413251903491, 0.31622776601683794, 0.1778279410038923, 0.1, 0.05623413251903491, 0.03162277660168379, 0.01778279410038923,
                                 0.01, 0.005623413251903491, 0.0031622776601683794, 0.0017782794100389228, 0.001, 0.0005623413251903491, 0.00031622776601683794, 0.00017782794100389227};
        double iv = 1.0;
#pragma unroll
        for (int q = 0; q < 16; ++q) iv = (i == q) ? invd[q] : iv;
        const float ang = (float)pos * (float)iv;
        const double rev = (double)ang * 0.15915494309189535; double fr = rev - floor(rev); if (fr > 0.5) fr -= 1.0;
        const float r = (float)(fr * 6.283185307179586);
        float* rp = (float*)(ws + WS_ROPE) + (size_t)gid * 2; rp[0] = __cosf(r); rp[1] = __sinf(r); } }
    convert_weights(a, ws, lds, lane, wave, 0, blockIdx.x * NWAVES + wave, gridDim.x * NWAVES);
}

__device__ __forceinline__ const float* xrow_ptr(const Args& a, unsigned char* ws, int l, int m) {
    if (l == 0) return (m < MP) ? INF(I_XP) + (size_t)m * DM : INF(I_XS) + (size_t)(m - MP) * DM;
    return (const float*)(ws + WS_X1) + (size_t)m * DM;
}
__device__ __forceinline__ void phase_modulate(const Args& a, int l, int lane, int wave) {
    GAS unsigned char* wsg_ = (GAS unsigned char*)a.ws; asm volatile("" : "+s"(wsg_)); unsigned char* ws = (unsigned char*)wsg_;
    const int gw = blockIdx.x * NWAVES + wave, NGW = gridDim.x * NWAVES;
    const float* mod = (const float*)(ws + WS_MOD) + (size_t)l * NCB * 3072; const float* bada = INF(I_BADA) + l * 3072; const float* ng = INF(I_NORMG) + l * DM;
    bf16* U = (bf16*)(ws + WS_U);
    for (int grp = gw; grp < MT / 8; grp += NGW) {
        const int mbase = grp * 8; int b, t, T, cb, pidx; row_info(mbase, b, t, T, cb, pidx);
        const float* mrow = mod + (size_t)cb * 3072;
        f32x4 g[4], sh[4], sc[4];
#pragma unroll
        for (int j = 0; j < 4; ++j) { const int col = 4 * lane + 256 * j; g[j] = *(const f32x4*)(ng + col); sh[j] = *(const f32x4*)(mrow + col) + *(const f32x4*)(bada + col);
            sc[j] = *(const f32x4*)(mrow + DM + col) + *(const f32x4*)(bada + DM + col) + 1.0f; }
        f32x4 nx[4]; v2u nr[4];
        auto load_row = [&](int mr) {
            if (l == 0) { const f32x4* xr = (const f32x4*)xrow_ptr(a, ws, 0, mr) + lane;
#pragma unroll
                for (int j = 0; j < 4; ++j) nx[j] = xr[64 * j]; }
            else { const v2u* xr = (const v2u*)((const bf16*)(ws + WS_X1) + (size_t)mr * DM) + lane;
#pragma unroll
                for (int j = 0; j < 4; ++j) nr[j] = xr[64 * j]; } };
        load_row(mbase);
        for (int r = 0; r < 8; ++r) {
            const int m = mbase + r;
            f32x4 v[4];
            if (l == 0) {
#pragma unroll
                for (int j = 0; j < 4; ++j) v[j] = nx[j]; }
            else {
#pragma unroll
                for (int j = 0; j < 4; ++j) v[j] = (f32x4){bflo(nr[j].x), bfhi(nr[j].x), bflo(nr[j].y), bfhi(nr[j].y)}; }
            if (r + 1 < 8) load_row(m + 1);
            float ss = 0.f;
#pragma unroll
            for (int j = 0; j < 4; ++j) ss += (v[j].x * v[j].x + v[j].y * v[j].y) + (v[j].z * v[j].z + v[j].w * v[j].w);
            const float rs = frsq(wave_sum(ss) * (1.f / DM) + RMS_EPS);
#pragma unroll
            for (int j = 0; j < 4; ++j) { const int col = 4 * lane + 256 * j;
                const f32x4 u = v[j] * rs * g[j] * sc[j] + sh[j];
                v2u o; o.x = pk2(u.x, u.y); o.y = pk2(u.z, u.w); *(v2u*)(U + (size_t)m * DM + col) = o; }
        }
    }
}

namespace pg8 {
struct EpiProj {
    static constexpr bool PERM = true, AFTER_DRAIN = false;
    bf16_t* QA; bf16_t* PROJ; int noepi;
    __device__ __forceinline__ void operator()(const f32x4 (&acc)[2][2][4][2], const Unit& u, int wr, int wc, int fr, int fq) const {
        if (noepi) return;
        const int row0 = u.pm * BM + wr * 64 + fr;
#pragma unroll
        for (int bj = 0; bj < 2; ++bj) {
            const int blk = u.pn * 2 + bj; if (blk == 3) continue;
            bf16_t* base; int ld, c0; if (blk < 3) { base = QA; ld = QL; c0 = blk * 128; } else { base = PROJ; ld = PW; c0 = blk * 128 - 512; }
            const int col = c0 + wc * 32 + 8 * fq;
#pragma unroll
            for (int ai = 0; ai < 2; ++ai)
#pragma unroll
                for (int m = 0; m < 4; ++m) { f32x4 v0 = acc[ai][bj][m][0], v1 = acc[ai][bj][m][1];
                    if (blk >= 28) {
#pragma unroll
                        for (int e = 0; e < 4; ++e) { v0[e] = sigm(v0[e]); v1[e] = sigm(v1[e]); } }
                    u32x4 w; w.x = cvt_pk_bf16(v0[0], v0[1]); w.y = cvt_pk_bf16(v0[2], v0[3]); w.z = cvt_pk_bf16(v1[0], v1[1]); w.w = cvt_pk_bf16(v1[2], v1[3]);
                    *(u32x4*)(base + (size_t)(row0 + ai * HALF + m * 16) * ld + col) = w; }
        }
    }
};
struct EpiQ {
    static constexpr bool PERM = true, AFTER_DRAIN = false;
    const float* RSQ; const float* ROPE; bf16_t* Q; float* QS;
    __device__ __forceinline__ void operator()(const f32x4 (&acc)[2][2][4][2], const Unit& u, int wr, int wc, int fr, int fq) const {
        const int row0 = u.pm * BM + wr * 64 + fr;
#pragma unroll
        for (int aim = 0; aim < 4; ++aim) { const int ai = aim >> 1, mb = (aim & 1) * 2;
        float rsv[4]; f32x4 csa[4][2], csb[4][2];
#pragma unroll
            for (int m = mb; m < mb + 2; ++m) { const int row = row0 + ai * HALF + m * 16; rsv[m] = RSQ[row]; const int pidx = row >= MP ? SEQ + ((row - MP) & 7) : (row & 2047);
#pragma unroll
                for (int bj = 0; bj < 2; ++bj) { const int col = u.pn * BM + bj * HALF + wc * 32 + 8 * fq; const int h = col / 96, j = col - h * 96;
                    const int i0 = j < 64 ? 0 : (j - 64) >> 1; const float* rp = ROPE + ((size_t)pidx * 16 + i0) * 2; csa[m][bj] = *(const f32x4*)rp; csb[m][bj] = *(const f32x4*)(rp + 4); } }
#pragma unroll
            for (int m = mb; m < mb + 2; ++m) {
                const int row = row0 + ai * HALF + m * 16; const float rs = rsv[m];
                const bool samp = row >= MP;
#pragma unroll
                for (int bj = 0; bj < 2; ++bj) {
                    const int col = u.pn * BM + bj * HALF + wc * 32 + 8 * fq; const int h = col / 96, j = col - h * 96;
                    float v[8];
#pragma unroll
                    for (int e = 0; e < 4; ++e) { v[e] = acc[ai][bj][m][0][e] * rs; v[4 + e] = acc[ai][bj][m][1][e] * rs; }
                    if (j < 64) {
                        if (!samp) { u32x4 w; w.x = cvt_pk_bf16(v[0] * SC2, v[1] * SC2); w.y = cvt_pk_bf16(v[2] * SC2, v[3] * SC2); w.z = cvt_pk_bf16(v[4] * SC2, v[5] * SC2); w.w = cvt_pk_bf16(v[6] * SC2, v[7] * SC2);
                            *(u32x4*)(Q + (size_t)row * 768 + col) = w; }
                        else { float* d = QS + (size_t)(row - MP) * 768 + col; *(f32x4*)d = (f32x4){v[0], v[1], v[2], v[3]}; *(f32x4*)(d + 4) = (f32x4){v[4], v[5], v[6], v[7]}; }
                    } else {
                        const int i0 = (j - 64) >> 1;
                        const f32x4 cs0 = csa[m][bj], cs1 = csb[m][bj];
                        float o1[4], o2[4];
                        o1[0] = v[0] * cs0.x - v[1] * cs0.y; o2[0] = v[1] * cs0.x + v[0] * cs0.y;
                        o1[1] = v[2] * cs0.z - v[3] * cs0.w; o2[1] = v[3] * cs0.z + v[2] * cs0.w;
                        o1[2] = v[4] * cs1.x - v[5] * cs1.y; o2[2] = v[5] * cs1.x + v[4] * cs1.y;
                        o1[3] = v[6] * cs1.z - v[7] * cs1.w; o2[3] = v[7] * cs1.z + v[6] * cs1.w;
                        const int cb = h * 96 + 64 + i0;
                        if (!samp) { unsigned* d = (unsigned*)(Q + (size_t)row * 768 + cb);
                            d[0] = cvt_pk_bf16(o1[0] * SC2, o1[1] * SC2); d[1] = cvt_pk_bf16(o1[2] * SC2, o1[3] * SC2);
                            d[8] = cvt_pk_bf16(o2[0] * SC2, o2[1] * SC2); d[9] = cvt_pk_bf16(o2[2] * SC2, o2[3] * SC2); }
                        else { float* d = QS + (size_t)(row - MP) * 768 + cb; *(f32x4*)d = (f32x4){o1[0], o1[1], o1[2], o1[3]}; *(f32x4*)(d + 16) = (f32x4){o2[0], o2[1], o2[2], o2[3]}; }
                    }
                }
            }
        }
    }
};
struct EpiKV {
    static constexpr bool PERM = true, AFTER_DRAIN = false;
    bf16_t* KN; bf16_t* V;
    __device__ __forceinline__ void operator()(const f32x4 (&acc)[2][2][4][2], const Unit& u, int wr, int wc, int fr, int fq) const {
        const int row0 = u.pm * BM + wr * 64 + fr; bf16_t* base = (u.pn < 2) ? KN : V; const int colt = (u.pn & 1) * BM + wc * 32 + 8 * fq;
#pragma unroll
        for (int ai = 0; ai < 2; ++ai)
#pragma unroll
            for (int m = 0; m < 4; ++m)
#pragma unroll
                for (int bj = 0; bj < 2; ++bj) { const f32x4 v0 = acc[ai][bj][m][0], v1 = acc[ai][bj][m][1];
                    u32x4 w; w.x = cvt_pk_bf16(v0[0], v0[1]); w.y = cvt_pk_bf16(v0[2], v0[3]); w.z = cvt_pk_bf16(v1[0], v1[1]); w.w = cvt_pk_bf16(v1[2], v1[3]);
                    *(u32x4*)(base + (size_t)(row0 + ai * HALF + m * 16) * 512 + colt + bj * HALF) = w; }
    }
};
struct MergeOrder : StaticOrder {
    __device__ __forceinline__ bool next(int i, Unit& u) const { Unit t; if (!StaticOrder::next(i >> 2, t)) return false; const int sub = i & 3; u.pm = sub * 65 + t.pm; u.pn = sub * 4 + t.pn; return true; }
    __device__ __forceinline__ bool keep(const Unit& u) const { return u.pn < 4; }
};
struct EpiMerge {
    static constexpr bool PERM = true, AFTER_DRAIN = false;
    const bf16_t* PROJ; bf16_t* MG; bf16_t* MERGED; int noepi;
    __device__ __forceinline__ void operator()(const f32x4 (&acc)[2][2][4][2], const Unit& u, int wr, int wc, int fr, int fq) const {
        const int sub = u.pn >> 2; if (sub == 0 || noepi) return;
        const int pm = u.pm - sub * 65, pn = u.pn & 3, br = sub - 1;
        const int row0 = pm * BM + wr * 64 + fr, col0 = pn * BM + wc * 32 + 8 * fq;
#pragma unroll
        for (int ai = 0; ai < 2; ++ai) {
            u32x4 gw[4][2], pw[4][2];
#pragma unroll
            for (int m = 0; m < 4; ++m)
#pragma unroll
                for (int bj = 0; bj < 2; ++bj) { const size_t row = row0 + ai * HALF + m * 16; const int col = col0 + bj * HALF;
                    gw[m][bj] = *(const u32x4*)(PROJ + row * PW + C_GM + br * DM + col);
                    if (br > 0) pw[m][bj] = *(const u32x4*)(MG + row * DM + col); }
#pragma unroll
            for (int m = 0; m < 4; ++m)
#pragma unroll
                for (int bj = 0; bj < 2; ++bj) { const size_t row = row0 + ai * HALF + m * 16; const int col = col0 + bj * HALF;
                    const u32x4 g = gw[m][bj];
                    f32x4 v0 = acc[ai][bj][m][0] * (f32x4){bflo(g.x), bfhi(g.x), bflo(g.y), bfhi(g.y)}, v1 = acc[ai][bj][m][1] * (f32x4){bflo(g.z), bfhi(g.z), bflo(g.w), bfhi(g.w)};
                    if (br > 0) { const u32x4 q = pw[m][bj]; v0 = v0 + (f32x4){bflo(q.x), bfhi(q.x), bflo(q.y), bfhi(q.y)}; v1 = v1 + (f32x4){bflo(q.z), bfhi(q.z), bflo(q.w), bfhi(q.w)}; }
                    u32x4 w; w.x = cvt_pk_bf16(v0[0], v0[1]); w.y = cvt_pk_bf16(v0[2], v0[3]); w.z = cvt_pk_bf16(v1[0], v1[1]); w.w = cvt_pk_bf16(v1[2], v1[3]);
                    *(u32x4*)((br < 2 ? MG : MERGED) + row * DM + col) = w; }
        }
    }
};
template <bool XBF> struct EpiOut {
    static constexpr bool PERM = false, AFTER_DRAIN = false;
    const float* XPf; const bf16_t* XPb; bf16_t* XO; const float* MODG; const float* BADG;
    __device__ __forceinline__ void operator()(const f32x4 (&acc)[2][2][4][2], const Unit& u, int wr, int wc, int fr, int fq) const {
        const int row0 = u.pm * BM + wr * 64 + fr, col0 = u.pn * BM + wc * 32 + 4 * fq;
        const int cb = (u.pm * BM) >> 11; const float* gr = MODG + (size_t)cb * 3072;
        f32x4 gt[2][2];
#pragma unroll
        for (int bj = 0; bj < 2; ++bj)
#pragma unroll
            for (int n = 0; n < 2; ++n) { const int col = col0 + bj * HALF + n * 16; gt[bj][n] = *(const f32x4*)(gr + col) + *(const f32x4*)(BADG + col); }
#pragma unroll
        for (int aim = 0; aim < 4; ++aim) { const int ai = aim >> 1, mb = (aim & 1) * 2;
            f32x4 xv[4][2][2];
            if constexpr (!XBF) {
#pragma unroll
                for (int m = mb; m < mb + 2; ++m)
#pragma unroll
                    for (int bj = 0; bj < 2; ++bj)
#pragma unroll
                        for (int n = 0; n < 2; ++n) xv[m][bj][n] = *(const f32x4*)(XPf + (size_t)(row0 + ai * HALF + m * 16) * DM + col0 + bj * HALF + n * 16);
            } else {
#pragma unroll
                for (int m = mb; m < mb + 2; ++m)
#pragma unroll
                    for (int bj = 0; bj < 2; ++bj)
#pragma unroll
                        for (int n = 0; n < 2; ++n) { const unsigned long long q = *(const unsigned long long*)(XPb + (size_t)(row0 + ai * HALF + m * 16) * DM + col0 + bj * HALF + n * 16); const unsigned lo = (unsigned)q, hi = (unsigned)(q >> 32);
                            xv[m][bj][n] = (f32x4){__builtin_bit_cast(float, lo << 16), __builtin_bit_cast(float, lo & 0xffff0000u), __builtin_bit_cast(float, hi << 16), __builtin_bit_cast(float, hi & 0xffff0000u)}; }
            }
#pragma unroll
            for (int m = mb; m < mb + 2; ++m)
#pragma unroll
                for (int bj = 0; bj < 2; ++bj)
#pragma unroll
                    for (int n = 0; n < 2; ++n) { const f32x4 o = xv[m][bj][n] + gt[bj][n] * acc[ai][bj][m][n];
                        unsigned long long w = (unsigned long long)cvt_pk_bf16(o[0], o[1]) | ((unsigned long long)cvt_pk_bf16(o[2], o[3]) << 32);
                        *(unsigned long long*)(XO + (size_t)(row0 + ai * HALF + m * 16) * DM + col0 + bj * HALF + n * 16) = w; }
        }
    }
};
}

__device__ __forceinline__ float out_dummy() { return 0.f; }
__device__ __forceinline__ void phase_post(const Args& a, int l, LAS unsigned char* lds, int tid, int lane, int wave) {
    GAS unsigned char* wsg_ = (GAS unsigned char*)a.ws; asm volatile("" : "+s"(wsg_)); unsigned char* ws = (unsigned char*)wsg_;     float* out = a.out;
    const bf16* PROJ = (const bf16*)(ws + WS_PROJ); const bf16* QA = (const bf16*)(ws + WS_QA);
    float* RSQ = (float*)(ws + WS_RSQ); const float* ROPE = (const float*)(ws + WS_ROPE);
    bf16* CKV = (bf16*)(ws + WS_CKV); bf16* KPE = (bf16*)(ws + WS_KPE); bf16* ACONV = (bf16*)(ws + WS_A4) + 2 * A4_STRIDE;
    float* SC = (float*)(ws + WS_SC); float* BONUS = (float*)(ws + WS_BONUS);
    const int c4 = 4 * lane;
    const f32x4 gkv = *(const f32x4*)(INF(I_KVNG) + l * KVL + c4);
    const f32x4 cw0 = *(const f32x4*)(INF(I_CONVW) + (l * 3 + 0) * DC + c4), cw1 = *(const f32x4*)(INF(I_CONVW) + (l * 3 + 1) * DC + c4), cw2 = *(const f32x4*)(INF(I_CONVW) + (l * 3 + 2) * DC + c4);
    const float* mu = INF(I_MU) + l * SW;
    const f32x4 mu_r = *(const f32x4*)(mu + c4), mu_k = *(const f32x4*)(mu + 256 + c4), mu_v = *(const f32x4*)(mu + 512 + c4);
    const float mu_w = mu[768 + lane], mu_a = mu[832 + lane];
    const f32x4 w0v = *(const f32x4*)(INF(I_W0) + l * DR + c4), a0v = *(const f32x4*)(INF(I_A0) + l * DR + c4), kkv = *(const f32x4*)(INF(I_KK) + l * DR + c4),
                kav = *(const f32x4*)(INF(I_KA) + l * DR + c4), rkv = *(const f32x4*)(INF(I_RK) + l * DR + c4);
    constexpr int XS = 144, XB_OFF = 80 * XS, RL_OFF = 2 * 80 * XS, RL_MAT = 65 * 512;
    const unsigned char* wl = ws + WS_W + (size_t)l * LW_STRIDE;
    for (int bk = blockIdx.x; bk < MT / 65; bk += gridDim.x) {
    const int m0 = bk * 65;
    for (int r = wave; r < 80; r += NWAVES) {
        float tw = 0.f, ai = 0.f;
        if (r < 65) { const int m = m0 + r; int b, t, T, cb, pidx; row_info(m, b, t, T, cb, pidx); const bool samp = m >= MP;
            const bf16* R = PROJ + (size_t)m * PW + C_RW; const float* sprev = INF(I_SSHIFT) + (size_t)(l * NB_S + b) * SW;
            const float cwi = bf1(R[768 + lane]), cai = bf1(R[832 + lane]); float pwi = 0.f, pai = 0.f;
            if (t >= 1) { pwi = bf1(R[768 + lane - PW]); pai = bf1(R[832 + lane - PW]); } else if (samp) { pwi = sprev[768 + lane]; pai = sprev[832 + lane]; }
            const float wi = cwi + mu_w * (pwi - cwi); ai = cai + mu_a * (pai - cai); tw = 1.0f - 2.0f * frcp(fexp(2.0f * wi) + 1.0f); }
        *(LAS bf16*)(lds + r * XS + lane * 2) = (bf16)f2bf(tw); *(LAS bf16*)(lds + XB_OFF + r * XS + lane * 2) = (bf16)f2bf(ai);
    }
    __syncthreads();
    { const int fr = lane & 15, fq = lane >> 4;
      bf16x8 wf[2][2][2];
#pragma unroll
      for (int lo = 0; lo < 2; ++lo)
#pragma unroll
          for (int q = 0; q < 2; ++q)
#pragma unroll
              for (int ks = 0; ks < 2; ++ks) wf[lo][q][ks] = *(const bf16x8*)((const bf16*)(wl + (lo ? LW_A2T : LW_W2T)) + (size_t)(16 * (2 * wave + q) + fr) * WL + 32 * ks + 8 * fq);
      for (int rt = 0; rt < 5; ++rt) {
          pg8::f32x4 acc[2][2];
#pragma unroll
          for (int lo = 0; lo < 2; ++lo)
#pragma unroll
              for (int q = 0; q < 2; ++q) acc[lo][q] = (pg8::f32x4){0.f, 0.f, 0.f, 0.f};
#pragma unroll
          for (int ks = 0; ks < 2; ++ks) {
              const bf16x8 xa = *(const LAS bf16x8*)(lds + (16 * rt + fr) * XS + (32 * ks + 8 * fq) * 2), xb = *(const LAS bf16x8*)(lds + XB_OFF + (16 * rt + fr) * XS + (32 * ks + 8 * fq) * 2);
#pragma unroll
              for (int q = 0; q < 2; ++q) { acc[0][q] = __builtin_amdgcn_mfma_f32_16x16x32_bf16(wf[0][q][ks], xa, acc[0][q], 0, 0, 0); acc[1][q] = __builtin_amdgcn_mfma_f32_16x16x32_bf16(wf[1][q][ks], xb, acc[1][q], 0, 0, 0); } }
          const int row = 16 * rt + fr;
          if (row < 65) {
#pragma unroll
              for (int lo = 0; lo < 2; ++lo)
#pragma unroll
                  for (int q = 0; q < 2; ++q) { v2u o; o.x = pk2(acc[lo][q][0], acc[lo][q][1]); o.y = pk2(acc[lo][q][2], acc[lo][q][3]);
                      *(LAS v2u*)(lds + RL_OFF + lo * RL_MAT + row * 512 + (16 * (2 * wave + q) + 4 * fq) * 2) = o; } }
      } }
    __syncthreads();
    struct PostRaw { unsigned qa[3]; v2u kv, cc0, cx0, cc1, cx1, cc2, cx2, cb, zc, r0, k0, v0, r1, k1, v1; float kr1, kr2, cwi, cai, cs, sn; };
    auto load_row = [&](int rowi, PostRaw& w) {
        const int m = m0 + rowi; int b, t, T, cb_, pidx; row_info(m, b, t, T, cb_, pidx);
        const bf16* P = PROJ + (size_t)m * PW; const unsigned* q = (const unsigned*)(QA + (size_t)m * QL);
#pragma unroll
        for (int i = 0; i < 3; ++i) w.qa[i] = q[lane + 64 * i];
        w.kv = *(const v2u*)(P + C_KV + c4);
        w.kr1 = bf1(P[C_KR + (lane & 15)]); w.kr2 = bf1(P[C_KR + 16 + (lane & 15)]); w.cs = ROPE[((size_t)pidx * 16 + (lane & 15)) * 2]; w.sn = ROPE[((size_t)pidx * 16 + (lane & 15)) * 2 + 1];
        w.cc0 = *(const v2u*)(P + C_CC + c4); w.cx0 = *(const v2u*)(P + C_CX + c4); w.cb = *(const v2u*)(P + C_CB + c4); w.zc = *(const v2u*)(P + C_ZC + c4);
        const v2u z2 = {0u, 0u};
        w.cc1 = z2; w.cx1 = z2; w.cc2 = z2; w.cx2 = z2; w.r1 = z2; w.k1 = z2; w.v1 = z2;
        if (t >= 1) { w.cc1 = *(const v2u*)(P - PW + C_CC + c4); w.cx1 = *(const v2u*)(P - PW + C_CX + c4);
            w.r1 = *(const v2u*)(P - PW + C_RW + c4); w.k1 = *(const v2u*)(P - PW + C_RW + 256 + c4); w.v1 = *(const v2u*)(P - PW + C_RW + 512 + c4); }
        if (t >= 2) { w.cc2 = *(const v2u*)(P - 2 * PW + C_CC + c4); w.cx2 = *(const v2u*)(P - 2 * PW + C_CX + c4); }
        w.r0 = *(const v2u*)(P + C_RW + c4); w.k0 = *(const v2u*)(P + C_RW + 256 + c4); w.v0 = *(const v2u*)(P + C_RW + 512 + c4);
        w.cwi = bf1(P[C_RW + 768 + lane]); w.cai = bf1(P[C_RW + 832 + lane]);
    };
#define UNPK(w_) ((f32x4){bflo((w_).x), bfhi((w_).x), bflo((w_).y), bfhi((w_).y)})
    PostRaw nxt; load_row(wave, nxt);
    for (int rowi = wave; rowi < 65; rowi += NWAVES) {
        const PostRaw w = nxt;
        if (rowi + NWAVES < 65) load_row(rowi + NWAVES, nxt);
        const int m = m0 + rowi;
        int b, t, T, cb, pidx; row_info(m, b, t, T, cb, pidx); const bool samp = m >= MP;
        { float ss = 0.f;
#pragma unroll
          for (int i = 0; i < 3; ++i) { const float x = bflo(w.qa[i]), y = bfhi(w.qa[i]); ss += x * x + y * y; }
          ss = wave_sum(ss); if (lane == 0) RSQ[m] = frsq(ss * (1.f / QL) + RMS_EPS); }
        { f32x4 x = UNPK(w.kv);
          const float ss = wave_sum((x.x * x.x + x.y * x.y) + (x.z * x.z + x.w * x.w)); const float rs = frsq(ss * (1.f / KVL) + RMS_EPS);
          x = x * rs * gkv;
          float* o = samp ? out + O_CKVS + ((size_t)l * MS + (m - MP)) * KVL : out + O_CKVP + ((size_t)l * MP + m) * KVL;
          *(f32x4*)(o + c4) = x; v2u ob; ob.x = pk2(x.x, x.y); ob.y = pk2(x.z, x.w); *(v2u*)(CKV + (size_t)m * KVL + c4) = ob; }
        if (lane < 16) { const float o1 = w.kr1 * w.cs - w.kr2 * w.sn, o2 = w.kr2 * w.cs + w.kr1 * w.sn;
          float* o = samp ? out + O_KPES + ((size_t)l * MS + (m - MP)) * QKR : out + O_KPEP + ((size_t)l * MP + m) * QKR;
          o[lane] = o1; o[16 + lane] = o2; KPE[(size_t)m * QKR + lane] = (bf16)f2bf(o1); KPE[(size_t)m * QKR + 16 + lane] = (bf16)f2bf(o2); }
        { const f32x4 p0 = UNPK(w.cc0) * UNPK(w.cx0);
          f32x4 p1 = UNPK(w.cc1) * UNPK(w.cx1), p2 = UNPK(w.cc2) * UNPK(w.cx2);
          if (samp && t < 2) { const float* sconv = INF(I_SCONV) + ((size_t)(l * NB_S + b) * 2) * DC + c4;
              if (t == 0) { p1 = *(const f32x4*)(sconv + DC); p2 = *(const f32x4*)(sconv); } else p2 = *(const f32x4*)(sconv + DC); }
          const f32x4 cv = p2 * cw0 + p1 * cw1 + p0 * cw2;
          const v2u wz = w.zc;
          const f32x4 o = (f32x4){silu(bflo(wz.x)), silu(bfhi(wz.x)), silu(bflo(wz.y)), silu(bfhi(wz.y))} * UNPK(w.cb) * cv;
          v2u ob; ob.x = pk2(o.x, o.y); ob.y = pk2(o.z, o.w); *(v2u*)(ACONV + (size_t)m * DC + c4) = ob;
          if (t >= T - 2) { float* so = samp ? out + O_CONVS + (((size_t)l * NB_S + b) * 2 + (t - (T - 2))) * DC : out + O_CONVP + (((size_t)l * NB_P + b) * 2 + (t - (T - 2))) * DC;
              *(f32x4*)(so + c4) = p0; } }
        { const f32x4 cr = UNPK(w.r0), ck = UNPK(w.k0), cv_ = UNPK(w.v0); const float cwi = w.cwi, cai = w.cai;
          f32x4 pr = UNPK(w.r1), pk = UNPK(w.k1), pv = UNPK(w.v1);
          if (samp && t == 0) { const float* sprev = INF(I_SSHIFT) + (size_t)(l * NB_S + b) * SW; pr = *(const f32x4*)(sprev + c4); pk = *(const f32x4*)(sprev + 256 + c4); pv = *(const f32x4*)(sprev + 512 + c4); }
          if (t == T - 1) { float* so = samp ? out + O_SHS + ((size_t)l * NB_S + b) * SW : out + O_SHP + ((size_t)l * NB_P + b) * SW;
              *(f32x4*)(so + c4) = cr; *(f32x4*)(so + 256 + c4) = ck; *(f32x4*)(so + 512 + c4) = cv_; so[768 + lane] = cwi; so[832 + lane] = cai; }
          const f32x4 r = cr + mu_r * (pr - cr), k = ck + mu_k * (pk - ck), v = cv_ + mu_v * (pv - cv_);
          f32x4 accw = w0v, acca = a0v;
          { const v2u lw = *(const LAS v2u*)(lds + RL_OFF + rowi * 512 + c4 * 2), la = *(const LAS v2u*)(lds + RL_OFF + RL_MAT + rowi * 512 + c4 * 2);
            accw += UNPK(lw); acca += UNPK(la); }
          f32x4 dec, av;
#pragma unroll
          for (int e = 0; e < 4; ++e) { const float x = -accw[e];
              const float sp = fmaxf(x, 0.f) + __logf(1.0f + fexp(-fabsf(x))); const float wlog = -sp - 0.5f; dec[e] = fexp(-fexp(wlog)); av[e] = sigm(acca[e]); }
          f32x4 kk = k * kkv; const float ssq = grp16_sum((kk.x * kk.x + kk.y * kk.y) + (kk.z * kk.z + kk.w * kk.w)); kk = kk * frcp(fmaxf(sqrtf(ssq), 1e-12f));
          const f32x4 k2 = k * ((av - 1.0f) * kav + 1.0f);
          const f32x4 rkk = r * k2 * rkv; const float bon = grp16_sum((rkk.x + rkk.y) + (rkk.z + rkk.w));
          float* sc = SC + (size_t)m * 6 * DR + c4;
          *(f32x4*)(sc) = r; *(f32x4*)(sc + DR) = dec; *(f32x4*)(sc + 2 * DR) = k2; *(f32x4*)(sc + 3 * DR) = v; *(f32x4*)(sc + 4 * DR) = kk; *(f32x4*)(sc + 5 * DR) = kk * av;
          *(f32x4*)(BONUS + (size_t)m * DR + c4) = v * bon; }
    }
#undef UNPK
    __syncthreads();
    }
}

__device__ __forceinline__ void phase_qlat(const Args& a, int l, int lane, int wave) {
    GAS unsigned char* wsg_ = (GAS unsigned char*)a.ws; asm volatile("" : "+s"(wsg_)); unsigned char* ws = (unsigned char*)wsg_;
    const int gw = blockIdx.x * NWAVES + wave, NGW = gridDim.x * NWAVES;
    const float* QS = (const float*)(ws + WS_QS); bf16* QLT = (bf16*)(ws + WS_QLAT); const float* wuk = INF(I_WUK) + (size_t)l * KVL * 512;
    for (int task = gw; task < MS * NH; task += NGW) {
        const int mm = task >> 3, h = task & 7, b = mm >> 3, t = mm & 7, r = t * 8 + h;
        const float* q = QS + (size_t)mm * 768 + h * 96;
        const float qn = q[lane];
        bf16* dst = QLT + ((size_t)b * 64 + r) * 288;
#pragma unroll
        for (int ci = 0; ci < 4; ++ci) { const int c = lane + 64 * ci; const f32x4* wr = (const f32x4*)(wuk + ((size_t)c * NH + h) * 64); float acc = 0.f;
#pragma unroll
            for (int n4 = 0; n4 < 16; ++n4) { const f32x4 w = wr[n4]; acc += w.x * RDL(qn, 4 * n4) + w.y * RDL(qn, 4 * n4 + 1) + w.z * RDL(qn, 4 * n4 + 2) + w.w * RDL(qn, 4 * n4 + 3); }
            dst[c] = (bf16)f2bf(acc * SC2); }
        if (lane < 32) dst[256 + lane] = (bf16)f2bf(q[64 + lane] * SC2);
    }
}

__device__ __forceinline__ void glds16(const void* gsrc, unsigned lds_dst) { unsigned keep;
    asm volatile("s_mov_b32 %0, m0\n\ts_mov_b32 m0, %2\n\ts_nop 0\n\tglobal_load_lds_dwordx4 %1, off\n\ts_mov_b32 m0, %0" : "=&s"(keep) : "v"(gsrc), "s"(lds_dst) : "memory"); }
#define MFMA32(a_, b_, c_) __builtin_amdgcn_mfma_f32_32x32x16_bf16((a_), (b_), (c_), 0, 0, 0)
__device__ __forceinline__ bf16x8 pack8(const f32x16& x, int s) {
    v4u p; p.x = pk2(x[8 * s], x[8 * s + 1]); p.y = pk2(x[8 * s + 2], x[8 * s + 3]); p.z = pk2(x[8 * s + 4], x[8 * s + 5]); p.w = pk2(x[8 * s + 6], x[8 * s + 7]);
    return __builtin_bit_cast(bf16x8, p);
}
__device__ __forceinline__ bf16x8 vt_frag(const LAS unsigned char* p0, int rowstride8) {
    const s16x4 lo = __builtin_bit_cast(s16x4, __builtin_amdgcn_ds_read_tr16_b64_v4i16((LAS v4i16_t*)p0));
    const s16x4 hi = __builtin_bit_cast(s16x4, __builtin_amdgcn_ds_read_tr16_b64_v4i16((LAS v4i16_t*)(p0 + rowstride8)));
    bf16x8 r; r[0] = lo[0]; r[1] = lo[1]; r[2] = lo[2]; r[3] = lo[3]; r[4] = hi[0]; r[5] = hi[1]; r[6] = hi[2]; r[7] = hi[3]; return r;
}

constexpr int PA_KS = 208, PA_VS = 144;
constexpr int PA_KBYTES = 64 * PA_KS, PA_VBYTES = 64 * PA_VS, PA_BUF = PA_KBYTES + PA_VBYTES;
__device__ __forceinline__ void phase_attn_prompt(const Args& a, LAS unsigned char* lds, int tid, int lane, int wave, unsigned* qctr, volatile LAS unsigned* qslot) {
    GAS unsigned char* wsg_ = (GAS unsigned char*)a.ws; asm volatile("" : "+s"(wsg_)); unsigned char* ws = (unsigned char*)wsg_;
    const bf16* Q = (const bf16*)(ws + WS_Q); const bf16* KN = (const bf16*)(ws + WS_KN); const bf16* KPE = (const bf16*)(ws + WS_KPE); const bf16* V = (const bf16*)(ws + WS_V);
    const bf16* PROJ = (const bf16*)(ws + WS_PROJ); bf16* AMLA = (bf16*)(ws + WS_A4);
    const int r32 = lane & 31, h2 = lane >> 5;
    for (;;) {
        {
            if (tid == 0) *qslot = __hip_atomic_fetch_add(qctr, 1u, __ATOMIC_RELAXED, __HIP_MEMORY_SCOPE_AGENT);
            __syncthreads();
            const int u = (int)*qslot;
            __syncthreads();
            if (u >= 512) break;
            const int qb = 7 - (u >> 6), bh = u & 63, b = bh >> 3, h = bh & 7;
            const int q0w = qb * 256 + wave * 32;
            const size_t tok0 = (size_t)b * SEQ;
            bf16x8 Bq[6];
#pragma unroll
            for (int ks = 0; ks < 6; ++ks) Bq[ks] = *(const bf16x8*)(Q + (tok0 + q0w + r32) * 768 + h * 96 + 16 * ks + 8 * h2);
            f32x16 O0, O1;
#pragma unroll
            for (int i = 0; i < 16; ++i) { O0[i] = 0.f; O1[i] = 0.f; }
            float mrun = -INFINITY, lrun = 0.f;
            const int ntile = 4 * qb + 4;
            const int krow = tid >> 3, kch = tid & 7, prow = (tid & 255) >> 2, pch = tid & 3;
            v4u gkA, gpA, gvA, gkB, gpB, gvB;
            auto issue = [&](int kt, v4u& gk, v4u& gp, v4u& gv) { const size_t tk = tok0 + (size_t)kt * 64 + krow;
                gk = *(const v4u*)(KN + tk * 512 + h * 64 + kch * 8); gv = *(const v4u*)(V + tk * 512 + h * 64 + kch * 8); gp = *(const v4u*)(KPE + (tok0 + (size_t)kt * 64 + prow) * QKR + pch * 8); };
            auto stash = [&](int bufi, const v4u& gk, const v4u& gp, const v4u& gv) { LAS unsigned char* kn = lds + bufi * PA_BUF; LAS unsigned char* vn = kn + PA_KBYTES;
                *(LAS v4u*)(kn + krow * PA_KS + kch * 16) = gk; *(LAS v4u*)(vn + krow * PA_VS + kch * 16) = gv; if (tid < 256) *(LAS v4u*)(kn + prow * PA_KS + 128 + pch * 16) = gp; };
#define PA_BAR() do { LDS_WAIT(); __builtin_amdgcn_s_barrier(); asm volatile("" ::: "memory"); } while (0)
            auto compute = [&](int kt, int bufi) {
                const LAS unsigned char* kb = lds + bufi * PA_BUF; const LAS unsigned char* vb = kb + PA_KBYTES;
                if (kt * 64 <= q0w + 31) {
                    f32x16 S0, S1;
#pragma unroll
                    for (int i = 0; i < 16; ++i) { S0[i] = 0.f; S1[i] = 0.f; }
#pragma unroll
                    for (int ks = 0; ks < 6; ++ks) {
                        const bf16x8 k0 = *(const LAS bf16x8*)(kb + r32 * PA_KS + ks * 32 + h2 * 16);
                        const bf16x8 k1 = *(const LAS bf16x8*)(kb + (32 + r32) * PA_KS + ks * 32 + h2 * 16);
                        S0 = MFMA32(k0, Bq[ks], S0); S1 = MFMA32(k1, Bq[ks], S1);
                    }
                    if (kt * 64 + 63 > q0w) {
                        const int qq = q0w + r32, kbase = kt * 64 + 4 * h2;
#pragma unroll
                        for (int i = 0; i < 16; ++i) { const int key = kbase + (i & 3) + 8 * (i >> 2); if (key > qq) S0[i] = -INFINITY; if (key + 32 > qq) S1[i] = -INFINITY; }
                    }
                    float mx = S0[0];
#pragma unroll
                    for (int i = 1; i < 16; ++i) mx = fmaxf(mx, S0[i]);
#pragma unroll
                    for (int i = 0; i < 16; ++i) mx = fmaxf(mx, S1[i]);
                    mx = fmaxf(mx, SHX(mx, 32));
                    const float mnew = fmaxf(mrun, mx);
                    if (__builtin_amdgcn_ballot_w64(mnew > mrun)) {
                        const float alpha = __builtin_amdgcn_exp2f(mrun - mnew); mrun = mnew; lrun *= alpha;
#pragma unroll
                        for (int i = 0; i < 16; ++i) { O0[i] *= alpha; O1[i] *= alpha; }
                    }
                    float ps = 0.f;
#pragma unroll
                    for (int i = 0; i < 16; ++i) { S0[i] = __builtin_amdgcn_exp2f(S0[i] - mrun); S1[i] = __builtin_amdgcn_exp2f(S1[i] - mrun); ps += S0[i] + S1[i]; }
                    lrun += ps;
                    const int g = lane >> 4, li = lane & 15, cg = g & 1, tq = li >> 2, tp = li & 3;
                    const LAS unsigned char* vbase = vb + (4 * h2 + tq) * PA_VS + (16 * cg + 4 * tp) * 2;
#pragma unroll
                    for (int sub = 0; sub < 2; ++sub)
#pragma unroll
                        for (int s = 0; s < 2; ++s) {
                            const bf16x8 pb = pack8(sub == 0 ? S0 : S1, s);
                            const LAS unsigned char* vp = vbase + (32 * sub + 16 * s) * PA_VS;
                            O0 = MFMA32(vt_frag(vp, 8 * PA_VS), pb, O0);
                            O1 = MFMA32(vt_frag(vp + 64, 8 * PA_VS), pb, O1);
                        }
                }
            };
            issue(0, gkA, gpA, gvA); issue(1, gkB, gpB, gvB); stash(0, gkA, gpA, gvA); PA_BAR();
            for (int kt = 0; kt < ntile - 2; kt += 2) {
                issue(kt + 2, gkA, gpA, gvA); compute(kt, 0); stash(1, gkB, gpB, gvB); PA_BAR();
                issue(kt + 3, gkB, gpB, gvB); compute(kt + 1, 1); stash(0, gkA, gpA, gvA); PA_BAR();
            }
            compute(ntile - 2, 0); stash(1, gkB, gpB, gvB); PA_BAR();
            compute(ntile - 1, 1);
            const float ltot = lrun + SHX(lrun, 32); const float inv = frcp(ltot);
            const size_t row = tok0 + q0w + r32;
            v2u zz[2][4];
#pragma unroll
            for (int dt = 0; dt < 2; ++dt)
#pragma unroll
                for (int g4 = 0; g4 < 4; ++g4) zz[dt][g4] = *(const v2u*)(PROJ + row * PW + C_ZM + h * 64 + dt * 32 + 8 * g4 + 4 * h2);
#pragma unroll
            for (int dt = 0; dt < 2; ++dt)
#pragma unroll
                for (int g4 = 0; g4 < 4; ++g4) { const int d0 = dt * 32 + 8 * g4 + 4 * h2;
                    const v2u zw = zz[dt][g4];
                    const f32x16& O = dt == 0 ? O0 : O1;
                    const float o0 = O[4 * g4] * inv * silu(bflo(zw.x)), o1 = O[4 * g4 + 1] * inv * silu(bfhi(zw.x)), o2 = O[4 * g4 + 2] * inv * silu(bflo(zw.y)), o3 = O[4 * g4 + 3] * inv * silu(bfhi(zw.y));
                    v2u ob; ob.x = pk2(o0, o1); ob.y = pk2(o2, o3); *(v2u*)(AMLA + (size_t)(h >> 2) * A4_STRIDE + row * 256 + (h & 3) * 64 + d0) = ob; }
        }
    }
}

constexpr int RA_SUB = 8, RA_STEP = 6 * 256, RA_BUF = RA_SUB * RA_STEP;
__device__ __forceinline__ float dpp_xor1(float x) { return __builtin_bit_cast(float, __builtin_amdgcn_update_dpp(0, __builtin_bit_cast(int, x), 0xB1, 0xF, 0xF, true)); }
__device__ __forceinline__ float dpp_xor2(float x) { return __builtin_bit_cast(float, __builtin_amdgcn_update_dpp(0, __builtin_bit_cast(int, x), 0x4E, 0xF, 0xF, true)); }

__device__ __forceinline__ void phase_rwkvA(const Args& a, LAS unsigned char* lds, int tid, int lane, int wave) {
    GAS unsigned char* wsg_ = (GAS unsigned char*)a.ws; asm volatile("" : "+s"(wsg_)); unsigned char* ws = (unsigned char*)wsg_;
    const float* SC = (const float*)(ws + WS_SC); float* YL = (float*)(ws + WS_YL); float* YP = (float*)(ws + WS_YP); float* QC = (float*)(ws + WS_QC); bf16* PC = (bf16*)(ws + WS_PC);
    const int pr = wave >> 1, part = wave & 1;
    const int ib = lane >> 2, jb = lane & 3;
    const int pt = part * 64 + lane;
    LAS unsigned char* mybuf = lds + pr * (2 * RA_BUF);
    for (int bk = blockIdx.x; bk < 8 * RNC; bk += gridDim.x) {
        const int seq = bk / (RNC / 4), c = (bk % (RNC / 4)) * 4 + pr, b = seq >> 2, h = seq & 3;
        const size_t m0 = (size_t)b * SEQ + (size_t)c * RCL;
        f32x2 S[4][8];
#pragma unroll
        for (int r = 0; r < 4; ++r)
#pragma unroll
            for (int pp = 0; pp < 8; ++pp) { S[r][pp].x = (part == 1 && (4 * ib + r) == (16 * jb + 2 * pp)) ? 1.f : 0.f; S[r][pp].y = (part == 1 && (4 * ib + r) == (16 * jb + 2 * pp + 1)) ? 1.f : 0.f; }
        f32x4 stg[6];
        auto stage_load = [&](int sub) {
#pragma unroll
            for (int i = 0; i < 6; ++i) { const int q = pt + 128 * i, st = q / 96, rem = q - st * 96, vec = rem >> 4, ch = rem & 15;
                const int srcv = vec == 0 ? 4 : vec == 1 ? 1 : vec == 2 ? 5 : vec == 3 ? 2 : vec == 4 ? 0 : 3;
                stg[i] = *(const f32x4*)(SC + (m0 + sub * RA_SUB + st) * 6 * DR + srcv * DR + h * 64 + ch * 4); }
        };
        auto stage_store = [&](int buf) {
#pragma unroll
            for (int i = 0; i < 6; ++i) { const int q = pt + 128 * i, st = q / 96, rem = q - st * 96;
                *(LAS f32x4*)(mybuf + buf * RA_BUF + st * RA_STEP + rem * 16) = stg[i]; }
        };
        stage_load(0); stage_store(0); __syncthreads();
        for (int sub = 0; sub < RCL / RA_SUB; ++sub) {
            const bool more = sub + 1 < RCL / RA_SUB;
            if (more) stage_load(sub + 1);
            const LAS unsigned char* cur = mybuf + (sub & 1) * RA_BUF;
            for (int st = 0; st < RA_SUB; ++st) {
                const LAS f32x4* base = (const LAS f32x4*)(cur + st * RA_STEP);
                const LAS f32x2* b2 = (const LAS f32x2*)base;
                f32x2 sa2[4];
#pragma unroll
                for (int r = 0; r < 4; ++r) sa2[r] = (f32x2){0.f, 0.f};
#pragma unroll
                for (int pp = 0; pp < 8; ++pp) { const f32x2 kq = b2[8 * jb + pp];
#pragma unroll
                    for (int r = 0; r < 4; ++r) sa2[r] += S[r][pp] * kq; }
                float sa[4];
#pragma unroll
                for (int r = 0; r < 4; ++r) { float t = -(sa2[r].x + sa2[r].y); t += dpp_xor1(t); t += dpp_xor2(t); sa[r] = t; }
                f32x4 vv = base[80 + ib]; if (part == 1) vv = (f32x4){0.f, 0.f, 0.f, 0.f};
                f32x2 y2[4];
#pragma unroll
                for (int r = 0; r < 4; ++r) y2[r] = (f32x2){0.f, 0.f};
#pragma unroll
                for (int pp = 0; pp < 8; ++pp) { const f32x2 wq = b2[32 + 8 * jb + pp], bq = b2[64 + 8 * jb + pp], kq = b2[96 + 8 * jb + pp], rq = b2[128 + 8 * jb + pp];
#pragma unroll
                    for (int r = 0; r < 4; ++r) { const f32x2 sar = {sa[r], sa[r]}, vr = {vv[r], vv[r]};
                        S[r][pp] = S[r][pp] * wq + (sar * bq + vr * kq); y2[r] += S[r][pp] * rq; } }
                float y[4];
#pragma unroll
                for (int r = 0; r < 4; ++r) { float t = y2[r].x + y2[r].y; t += dpp_xor1(t); t += dpp_xor2(t); y[r] = t; }
                if (jb == 0) { float* yo = (part == 1 ? YP : YL) + (m0 + sub * RA_SUB + st) * DR + h * 64 + 4 * ib; *(f32x4*)yo = (f32x4){y[0], y[1], y[2], y[3]}; }
            }
            if (more) stage_store((sub + 1) & 1);
            __syncthreads();
        }
        const size_t cb = (((size_t)seq * RNC + c) * 64 + 4 * ib) * 64 + 16 * jb;
        if (part == 0) {
#pragma unroll
            for (int r = 0; r < 4; ++r)
#pragma unroll
                for (int q = 0; q < 4; ++q) *(f32x4*)(QC + cb + r * 64 + 4 * q) = (f32x4){S[r][2 * q].x, S[r][2 * q].y, S[r][2 * q + 1].x, S[r][2 * q + 1].y};
        } else {
#pragma unroll
            for (int r = 0; r < 4; ++r)
#pragma unroll
                for (int q = 0; q < 2; ++q) { v4u w; w.x = pk2(S[r][4 * q].x, S[r][4 * q].y); w.y = pk2(S[r][4 * q + 1].x, S[r][4 * q + 1].y); w.z = pk2(S[r][4 * q + 2].x, S[r][4 * q + 2].y); w.w = pk2(S[r][4 * q + 3].x, S[r][4 * q + 3].y);
                    *(v4u*)(PC + cb + r * 64 + 8 * q) = w; }
        }
    }
}

constexpr int RB_BUF = 24576;
__device__ __forceinline__ void rwkv_chain(const Args& a, int l, LAS unsigned char* lds, int lane, int seq) {
    GAS unsigned char* wsg_ = (GAS unsigned char*)a.ws; asm volatile("" : "+s"(wsg_)); unsigned char* ws = (unsigned char*)wsg_;
    const float* QC = (const float*)(ws + WS_QC); const bf16* PC = (const bf16*)(ws + WS_PC); float* SALL = (float*)(ws + WS_SALL);
    const int r32 = lane & 31, h2 = lane >> 5, g = lane >> 4, li = lane & 15, cg = g & 1, tq = li >> 2, tp = li & 3;
    f32x16 St[2][2];
#pragma unroll
    for (int x = 0; x < 2; ++x)
#pragma unroll
        for (int y = 0; y < 2; ++y)
#pragma unroll
            for (int q = 0; q < 16; ++q) St[x][y][q] = 0.f;
    const unsigned lds0 = (unsigned)(uintptr_t)lds;
    auto dma = [&](int c) {
        const size_t cbase = ((size_t)seq * RNC + c) * 4096; const unsigned bb = lds0 + (c % 3) * RB_BUF;
#pragma unroll
        for (int x = 0; x < 8; ++x) glds16(PC + cbase + (size_t)(lane + 64 * x) * 8, (unsigned)__builtin_amdgcn_readfirstlane(bb + x * 1024));
#pragma unroll
        for (int jt = 0; jt < 2; ++jt)
#pragma unroll
            for (int it = 0; it < 2; ++it)
#pragma unroll
                for (int g4 = 0; g4 < 4; ++g4)
                    glds16(QC + cbase + (size_t)(32 * it + r32) * 64 + 32 * jt + 8 * g4 + 4 * h2, (unsigned)__builtin_amdgcn_readfirstlane(bb + 8192 + ((jt * 2 + it) * 4 + g4) * 1024));
    };
    dma(0); dma(1);
    for (int c = 0; c < RNC; ++c) {
        const size_t cbase = ((size_t)seq * RNC + c) * 4096; const LAS unsigned char* bb = lds + (c % 3) * RB_BUF;
        if (c == 0) asm volatile("s_waitcnt vmcnt(24)" ::: "memory"); else if (c == 1) asm volatile("s_waitcnt vmcnt(40)" ::: "memory");
        else if (c == RNC - 1) asm volatile("s_waitcnt vmcnt(32)" ::: "memory"); else asm volatile("s_waitcnt vmcnt(56)" ::: "memory");
        if (c + 2 < RNC) dma(c + 2);
        asm volatile("" ::: "memory");
        f32x16 D[2][2];
#pragma unroll
        for (int jt = 0; jt < 2; ++jt)
#pragma unroll
            for (int it = 0; it < 2; ++it)
#pragma unroll
                for (int g4 = 0; g4 < 4; ++g4) { const size_t off = cbase + (size_t)(32 * it + r32) * 64 + 32 * jt + 8 * g4 + 4 * h2;
                    *(GAS f32x4*)((GAS float*)SALL + off) = (f32x4){St[jt][it][4 * g4], St[jt][it][4 * g4 + 1], St[jt][it][4 * g4 + 2], St[jt][it][4 * g4 + 3]};
                    const f32x4 qv = *(const LAS f32x4*)(bb + 8192 + ((jt * 2 + it) * 4 + g4) * 1024 + lane * 16);
                    D[jt][it][4 * g4] = qv.x; D[jt][it][4 * g4 + 1] = qv.y; D[jt][it][4 * g4 + 2] = qv.z; D[jt][it][4 * g4 + 3] = qv.w; }
#pragma unroll
        for (int kt = 0; kt < 2; ++kt)
#pragma unroll
            for (int s = 0; s < 2; ++s) {
                const bf16x8 b0 = pack8(St[kt][0], s), b1 = pack8(St[kt][1], s);
                const LAS unsigned char* pp = bb + (32 * kt + 16 * s + 4 * h2 + tq) * 128 + (16 * cg + 4 * tp) * 2;
                const bf16x8 a0 = vt_frag(pp, 8 * 128), a1 = vt_frag(pp + 64, 8 * 128);
                D[0][0] = MFMA32(a0, b0, D[0][0]); D[0][1] = MFMA32(a0, b1, D[0][1]); D[1][0] = MFMA32(a1, b0, D[1][0]); D[1][1] = MFMA32(a1, b1, D[1][1]);
            }
        LDS_WAIT(); asm volatile("" ::: "memory");
#pragma unroll
        for (int x = 0; x < 2; ++x)
#pragma unroll
            for (int y = 0; y < 2; ++y) St[x][y] = D[x][y];
    }
    const int b = seq >> 2, h = seq & 3;
    float* so = a.out + O_RWP + ((((size_t)l * NB_P + b) * RH + h) * RN) * RN;
#pragma unroll
    for (int jt = 0; jt < 2; ++jt)
#pragma unroll
        for (int it = 0; it < 2; ++it)
#pragma unroll
            for (int g4 = 0; g4 < 4; ++g4) *(f32x4*)(so + (size_t)(32 * it + r32) * 64 + 32 * jt + 8 * g4 + 4 * h2) = (f32x4){St[jt][it][4 * g4], St[jt][it][4 * g4 + 1], St[jt][it][4 * g4 + 2], St[jt][it][4 * g4 + 3]};
}

__device__ __forceinline__ void phase_rwkvC(const Args& a, int l, LAS unsigned char* lds, int lane, int wave) {
    GAS unsigned char* wsg_ = (GAS unsigned char*)a.ws; asm volatile("" : "+s"(wsg_)); unsigned char* ws = (unsigned char*)wsg_;
    const float* YL = (const float*)(ws + WS_YL); const float* YP = (const float*)(ws + WS_YP); const float* SALL = (const float*)(ws + WS_SALL);
    const float* BONUS = (const float*)(ws + WS_BONUS); const bf16* PROJ = (const bf16*)(ws + WS_PROJ); bf16* ARW = (bf16*)(ws + WS_A4) + 3 * A4_STRIDE;
    const int r32 = lane & 31, h2 = lane >> 5;
    for (int item = blockIdx.x * NWAVES + wave; item < 2048; item += gridDim.x * NWAVES) {
        const int seq = item >> 6, c = item & 63, b = seq >> 2, h = seq & 3;
        const size_t m = (size_t)b * SEQ + (size_t)c * RCL + r32;
        const float* sc = SALL + ((size_t)seq * RNC + c) * 4096;
        f32x16 D[2];
#pragma unroll
        for (int it = 0; it < 2; ++it)
#pragma unroll
            for (int g4 = 0; g4 < 4; ++g4) { const f32x4 yl = *(const f32x4*)(YL + m * DR + h * 64 + 32 * it + 8 * g4 + 4 * h2);
                D[it][4 * g4] = yl.x; D[it][4 * g4 + 1] = yl.y; D[it][4 * g4 + 2] = yl.z; D[it][4 * g4 + 3] = yl.w; }
#pragma unroll
        for (int ks = 0; ks < 4; ++ks) {
            const f32x4* yp = (const f32x4*)(YP + m * DR + h * 64 + 16 * ks + 8 * h2); const f32x4 y0 = yp[0], y1 = yp[1];
            v4u bw; bw.x = pk2(y0.x, y0.y); bw.y = pk2(y0.z, y0.w); bw.z = pk2(y1.x, y1.y); bw.w = pk2(y1.z, y1.w);
            const bf16x8 bfr = __builtin_bit_cast(bf16x8, bw);
#pragma unroll
            for (int it = 0; it < 2; ++it) { const f32x4* sp = (const f32x4*)(sc + (size_t)(32 * it + r32) * 64 + 16 * ks + 8 * h2); const f32x4 s0 = sp[0], s1 = sp[1];
                v4u aw; aw.x = pk2(s0.x, s0.y); aw.y = pk2(s0.z, s0.w); aw.z = pk2(s1.x, s1.y); aw.w = pk2(s1.z, s1.w);
                D[it] = MFMA32(__builtin_bit_cast(bf16x8, aw), bfr, D[it]); }
        }
        f32x4 gg[2][4], gb[2][4], bo[2][4]; v2u zw[2][4];
#pragma unroll
        for (int it = 0; it < 2; ++it)
#pragma unroll
            for (int g4 = 0; g4 < 4; ++g4) { const int i0 = h * 64 + 32 * it + 8 * g4 + 4 * h2;
                gg[it][g4] = *(const f32x4*)(INF(I_GNG) + l * DR + i0); gb[it][g4] = *(const f32x4*)(INF(I_GNB) + l * DR + i0); bo[it][g4] = *(const f32x4*)(BONUS + m * DR + i0);
                zw[it][g4] = *(const v2u*)(PROJ + m * PW + C_ZR + i0); }
        float s1 = 0.f;
#pragma unroll
        for (int it = 0; it < 2; ++it)
#pragma unroll
            for (int q = 0; q < 16; ++q) s1 += D[it][q];
        const float mu = (s1 + SHX(s1, 32)) * (1.f / 64.f);
        float s2 = 0.f;
#pragma unroll
        for (int it = 0; it < 2; ++it)
#pragma unroll
            for (int q = 0; q < 16; ++q) { const float d = D[it][q] - mu; s2 += d * d; }
        const float rs = frsq((s2 + SHX(s2, 32)) * (1.f / 64.f) + GN_EPS);
#pragma unroll
        for (int it = 0; it < 2; ++it)
#pragma unroll
            for (int g4 = 0; g4 < 4; ++g4) { const int i0 = h * 64 + 32 * it + 8 * g4 + 4 * h2;
                const f32x4 G = gg[it][g4], B = gb[it][g4], O = bo[it][g4]; const v2u z = zw[it][g4];
                const float o0 = ((D[it][4 * g4] - mu) * rs * G.x + B.x + O.x) * silu(bflo(z.x)), o1 = ((D[it][4 * g4 + 1] - mu) * rs * G.y + B.y + O.y) * silu(bfhi(z.x)),
                            o2 = ((D[it][4 * g4 + 2] - mu) * rs * G.z + B.z + O.z) * silu(bflo(z.y)), o3 = ((D[it][4 * g4 + 3] - mu) * rs * G.w + B.w + O.w) * silu(bfhi(z.y));
                v2u ob; ob.x = pk2(o0, o1); ob.y = pk2(o2, o3); *(v2u*)(ARW + m * DR + i0) = ob; }
    }
}

template <int KSTEPS>
__device__ __forceinline__ void thin_acc(const bf16* A, int lda, const bf16* Bt, int ldb, int n0, int lane, int wave, LAS unsigned char* lds, pg8::f32x4& acc) {
    const int fr = lane & 15, fq = lane >> 4; constexpr int kper = KSTEPS * 32;
    const bf16* bp = Bt + (size_t)(n0 + fr) * ldb + wave * kper + 8 * fq; const bf16* ap = A + (size_t)fr * lda + wave * kper + 8 * fq;
    bf16x8 bfr[KSTEPS], af[KSTEPS][8];
#pragma unroll
    for (int ks = 0; ks < KSTEPS; ++ks) { bfr[ks] = *(const bf16x8*)(bp + 32 * ks);
#pragma unroll
        for (int rt = 0; rt < 8; ++rt) af[ks][rt] = *(const bf16x8*)(ap + (size_t)rt * 16 * lda + 32 * ks); }
    pg8::f32x4 part[8];
#pragma unroll
    for (int rt = 0; rt < 8; ++rt) part[rt] = (pg8::f32x4){0.f, 0.f, 0.f, 0.f};
#pragma unroll
    for (int ks = 0; ks < KSTEPS; ++ks)
#pragma unroll
        for (int rt = 0; rt < 8; ++rt) part[rt] = __builtin_amdgcn_mfma_f32_16x16x32_bf16(bfr[ks], af[ks][rt], part[rt], 0, 0, 0);
    LAS pg8::f32x4* red = (LAS pg8::f32x4*)lds;
#pragma unroll
    for (int rt = 0; rt < 8; ++rt) red[(wave * 8 + rt) * 64 + lane] = part[rt];
    __syncthreads();
#pragma unroll
    for (int w2 = 0; w2 < 8; ++w2) acc += red[(w2 * 8 + wave) * 64 + lane];
    __syncthreads();
}
__device__ __forceinline__ void thin_merge_sample(const Args& a, int l, LAS unsigned char* lds, int lane, int wave, int unit) {
    GAS unsigned char* wsg_ = (GAS unsigned char*)a.ws; asm volatile("" : "+s"(wsg_)); unsigned char* ws = (unsigned char*)wsg_;
    const int slice = unit & 63, rh = unit >> 6;
    const bf16* A4 = (const bf16*)(ws + WS_A4) + (size_t)(MP + rh * 128) * 256; const bf16* B4 = (const bf16*)(ws + WS_W + (size_t)l * LW_STRIDE + LW_MLA);
    const bf16* PROJ = (const bf16*)(ws + WS_PROJ); bf16* MERGED = (bf16*)(ws + WS_MERGED);
    const int n0 = 16 * slice, fr = lane & 15, fq = lane >> 4;
    const size_t m = (size_t)MP + rh * 128 + wave * 16 + fr; const int n = n0 + 4 * fq;
    v2u gw[3];
#pragma unroll
    for (int br = 0; br < 3; ++br) gw[br] = *(const v2u*)(PROJ + m * PW + C_GM + br * DM + n);
    pg8::f32x4 acc[3];
#pragma unroll
    for (int br = 0; br < 3; ++br) acc[br] = (pg8::f32x4){0.f, 0.f, 0.f, 0.f};
    thin_acc<1>(A4, 256, B4, 256, n0, lane, wave, lds, acc[0]);
    thin_acc<1>(A4 + A4_STRIDE, 256, B4 + (size_t)DM * 256, 256, n0, lane, wave, lds, acc[0]);
    thin_acc<1>(A4 + 2 * A4_STRIDE, 256, B4 + (size_t)2 * DM * 256, 256, n0, lane, wave, lds, acc[1]);
    thin_acc<1>(A4 + 3 * A4_STRIDE, 256, B4 + (size_t)3 * DM * 256, 256, n0, lane, wave, lds, acc[2]);
    pg8::f32x4 o = {0.f, 0.f, 0.f, 0.f};
#pragma unroll
    for (int br = 0; br < 3; ++br) o += acc[br] * (pg8::f32x4){bflo(gw[br].x), bfhi(gw[br].x), bflo(gw[br].y), bfhi(gw[br].y)};
    v2u ob; ob.x = pk2(o[0], o[1]); ob.y = pk2(o[2], o[3]); *(v2u*)(MERGED + m * DM + n) = ob;
}
__device__ __forceinline__ void thin_out_sample(const Args& a, int l, LAS unsigned char* lds, int lane, int wave, int unit) {
    GAS unsigned char* wsg_ = (GAS unsigned char*)a.ws; asm volatile("" : "+s"(wsg_)); unsigned char* ws = (unsigned char*)wsg_;
    const int slice = unit & 63, rh = unit >> 6;
    const bf16* A = (const bf16*)(ws + WS_MERGED) + (size_t)(MP + rh * 128) * DM; const bf16* Bt = (const bf16*)(ws + WS_W + (size_t)l * LW_STRIDE + LW_OUT);
    const float* xin = INF(I_XS); const bf16* xinb = (const bf16*)(ws + WS_X1) + (size_t)MP * DM; bf16* xo = (bf16*)(ws + (l == 0 ? WS_X1 : WS_X2)) + (size_t)MP * DM;
    const float* modg = (const float*)(ws + WS_MOD) + (size_t)l * NCB * 3072 + 2048; const float* badg = INF(I_BADA) + l * 3072 + 2048;
    const int n0 = 16 * slice, fr = lane & 15, fq = lane >> 4;
    const int mm = rh * 128 + wave * 16 + fr, n = n0 + 4 * fq, cb = NB_P + (mm >> 3);
    const pg8::f32x4 gt = *(const pg8::f32x4*)(modg + (size_t)cb * 3072 + n) + *(const pg8::f32x4*)(badg + n);
    pg8::f32x4 xv;
    if (l == 0) xv = *(const pg8::f32x4*)(xin + (size_t)mm * DM + n); else { const v2u q = *(const v2u*)(xinb + (size_t)mm * DM + n); xv = (pg8::f32x4){bflo(q.x), bfhi(q.x), bflo(q.y), bfhi(q.y)}; }
    pg8::f32x4 acc = {0.f, 0.f, 0.f, 0.f};
    thin_acc<4>(A, DM, Bt, DM, n0, lane, wave, lds, acc);
    { const pg8::f32x4 o = xv + gt * acc; v2u ob; ob.x = pk2(o[0], o[1]); ob.y = pk2(o[2], o[3]); *(v2u*)(xo + (size_t)mm * DM + n) = ob; }
}

constexpr int UT_LDS = 29184;
__device__ __forceinline__ void phase_rwkvA_ut(const Args& a, LAS unsigned char* lds, int lane, int wave) {
    if (wave >= 4) return;
    GAS unsigned char* wsg_ = (GAS unsigned char*)a.ws; asm volatile("" : "+s"(wsg_)); unsigned char* ws = (unsigned char*)wsg_;
    const float* SC = (const float*)(ws + WS_SC); float* YL = (float*)(ws + WS_YL); float* YP = (float*)(ws + WS_YP); float* QC = (float*)(ws + WS_QC); bf16* PC = (bf16*)(ws + WS_PC);
    LAS unsigned char* L = lds + wave * UT_LDS;
    LAS unsigned char* IKa = L, *IB = L + 4096, *IKt = L + 8192, *IR = L + 12288, *IV = L + 16384, *IW = L + 20480, *IU = L + 24576;
    LAS float* MB = (LAS float*)(L + 0); LAS float* MVI = (LAS float*)(L + 20480); LAS float* GC = (LAS float*)(L + 28672);
    const int r32 = lane & 31, h2 = lane >> 5, g = lane >> 4, li = lane & 15, cg = g & 1, tq = li >> 2, tp = li & 3;
    for (int ch = (int)blockIdx.x * 4 + wave; ch < 32 * RNC; ch += (int)gridDim.x * 4) {
        const int seq = ch / RNC, c = ch - seq * RNC, b = seq >> 2, h = seq & 3;
        const size_t m0 = (size_t)b * SEQ + (size_t)c * RCL;
        float ka[32];
        { const float* sp = SC + m0 * 6 * DR + h * 64 + lane; float Gt[32], tmp[32];
#pragma unroll
          for (int t = 0; t < 32; ++t) Gt[t] = sp[(size_t)t * 6 * DR + DR];
#pragma unroll
          for (int t = 0; t < 32; ++t) tmp[t] = sp[(size_t)t * 6 * DR + 4 * DR];
          { float G = 1.f;
#pragma unroll
            for (int t = 0; t < 32; ++t) { ka[t] = tmp[t] * G; G *= Gt[t]; Gt[t] = G; *(LAS bf16*)(IKa + t * 128 + lane * 2) = (bf16)f2bf(ka[t]); } }
#pragma unroll
          for (int t = 0; t < 32; ++t) tmp[t] = sp[(size_t)t * 6 * DR];
#pragma unroll
          for (int t = 0; t < 32; ++t) *(LAS bf16*)(IR + t * 128 + lane * 2) = (bf16)f2bf(tmp[t] * Gt[t]);
#pragma unroll
          for (int t = 0; t < 32; ++t) tmp[t] = sp[(size_t)t * 6 * DR + 3 * DR];
#pragma unroll
          for (int t = 0; t < 32; ++t) *(LAS bf16*)(IV + t * 128 + lane * 2) = (bf16)f2bf(tmp[t]);
          GC[lane] = Gt[31];
#pragma unroll
          for (int t = 0; t < 32; ++t) Gt[t] = frcp(Gt[t]);
#pragma unroll
          for (int t = 0; t < 32; ++t) tmp[t] = sp[(size_t)t * 6 * DR + 5 * DR];
#pragma unroll
          for (int t = 0; t < 32; ++t) *(LAS bf16*)(IB + t * 128 + lane * 2) = (bf16)f2bf(tmp[t] * Gt[t]);
#pragma unroll
          for (int t = 0; t < 32; ++t) tmp[t] = sp[(size_t)t * 6 * DR + 2 * DR];
#pragma unroll
          for (int t = 0; t < 32; ++t) *(LAS bf16*)(IKt + t * 128 + lane * 2) = (bf16)f2bf(tmp[t] * Gt[t]);
        }
        LDS_WAIT(); asm volatile("" ::: "memory");
        f32x16 MbT, MkT, AbT, AkT;
#pragma unroll
        for (int q = 0; q < 16; ++q) { MbT[q] = 0.f; MkT[q] = 0.f; AbT[q] = 0.f; AkT[q] = 0.f; }
#pragma unroll
        for (int ks = 0; ks < 4; ++ks) { const int off = r32 * 128 + (16 * ks + 8 * h2) * 2;
            const bf16x8 fb = *(const LAS bf16x8*)(IB + off), fk = *(const LAS bf16x8*)(IKt + off), fa = *(const LAS bf16x8*)(IKa + off), fr_ = *(const LAS bf16x8*)(IR + off);
            MbT = MFMA32(fb, fa, MbT); MkT = MFMA32(fk, fa, MkT); AbT = MFMA32(fb, fr_, AbT); AkT = MFMA32(fk, fr_, AkT); }
#pragma unroll
        for (int q = 0; q < 16; ++q) { const int s = (q & 3) + 8 * (q >> 2) + 4 * h2;
            if (s >= r32) { MbT[q] = 0.f; MkT[q] = 0.f; } if (s > r32) { AbT[q] = 0.f; AkT[q] = 0.f; } }
        LDS_WAIT(); asm volatile("" ::: "memory");
#pragma unroll
        for (int g4 = 0; g4 < 4; ++g4) *(LAS f32x4*)(MB + r32 * 32 + 8 * g4 + 4 * h2) = (f32x4){MbT[4 * g4], MbT[4 * g4 + 1], MbT[4 * g4 + 2], MbT[4 * g4 + 3]};
        { f32x16 mv[2];
#pragma unroll
          for (int it = 0; it < 2; ++it)
#pragma unroll
              for (int q = 0; q < 16; ++q) mv[it][q] = 0.f;
#pragma unroll
          for (int ks = 0; ks < 2; ++ks) { const bf16x8 pb = pack8(MkT, ks);
#pragma unroll
              for (int it = 0; it < 2; ++it) mv[it] = MFMA32(vt_frag(IV + (16 * ks + 4 * h2 + tq) * 128 + (32 * it + 16 * cg + 4 * tp) * 2, 8 * 128), pb, mv[it]); }
#pragma unroll
          for (int it = 0; it < 2; ++it)
#pragma unroll
              for (int g4 = 0; g4 < 4; ++g4) *(LAS f32x4*)(MVI + r32 * 64 + 32 * it + 8 * g4 + 4 * h2) = (f32x4){mv[it][4 * g4], mv[it][4 * g4 + 1], mv[it][4 * g4 + 2], mv[it][4 * g4 + 3]}; }
        LDS_WAIT(); asm volatile("" ::: "memory");
        { float x1[32], x2[32];
#pragma unroll
          for (int t = 0; t < 32; ++t) x2[t] = -MVI[t * 64 + lane];
          LDS_WAIT(); asm volatile("" ::: "memory");
#pragma unroll
          for (int t = 0; t < 32; ++t) { float a1 = -ka[t], a2 = x2[t];
#pragma unroll
              for (int s4 = 0; s4 < 32; s4 += 4) { if (s4 < t) { const f32x4 mq = *(const LAS f32x4*)(MB + t * 32 + s4);
                  a1 -= mq.x * x1[s4]; a2 -= mq.x * x2[s4];
                  if (s4 + 1 < t) { a1 -= mq.y * x1[s4 + 1]; a2 -= mq.y * x2[s4 + 1]; }
                  if (s4 + 2 < t) { a1 -= mq.z * x1[s4 + 2]; a2 -= mq.z * x2[s4 + 2]; }
                  if (s4 + 3 < t) { a1 -= mq.w * x1[s4 + 3]; a2 -= mq.w * x2[s4 + 3]; } } }
              x1[t] = a1; x2[t] = a2;
              *(LAS bf16*)(IW + t * 128 + lane * 2) = (bf16)f2bf(a1); *(LAS bf16*)(IU + t * 128 + lane * 2) = (bf16)f2bf(a2); } }
        LDS_WAIT(); asm volatile("" ::: "memory");
        const size_t cbase = ((size_t)seq * RNC + c) * 4096;
#pragma unroll
        for (int jt = 0; jt < 2; ++jt) {
            f32x16 pt[2], qt[2];
#pragma unroll
            for (int x = 0; x < 2; ++x)
#pragma unroll
                for (int q = 0; q < 16; ++q) { pt[x][q] = 0.f; qt[x][q] = 0.f; }
#pragma unroll
            for (int ks = 0; ks < 2; ++ks) { const int ro = (16 * ks + 4 * h2 + tq) * 128, co = (16 * cg + 4 * tp) * 2;
                const bf16x8 ab = vt_frag(IB + ro + 64 * jt + co, 8 * 128), ak = vt_frag(IKt + ro + 64 * jt + co, 8 * 128);
#pragma unroll
                for (int x = 0; x < 2; ++x) { const bf16x8 bw = vt_frag(IW + ro + 64 * x + co, 8 * 128), bu = vt_frag(IU + ro + 64 * x + co, 8 * 128), bv = vt_frag(IV + ro + 64 * x + co, 8 * 128);
                    pt[x] = MFMA32(ab, bw, pt[x]); qt[x] = MFMA32(ab, bu, qt[x]); qt[x] = MFMA32(ak, bv, qt[x]); } }
#pragma unroll
            for (int g4 = 0; g4 < 4; ++g4) { const int j0 = 32 * jt + 8 * g4 + 4 * h2; const f32x4 gc = *(const LAS f32x4*)(GC + j0);
#pragma unroll
                for (int x = 0; x < 2; ++x) { const int kcol = 32 * x + r32;
                    f32x4 pv = {pt[x][4 * g4], pt[x][4 * g4 + 1], pt[x][4 * g4 + 2], pt[x][4 * g4 + 3]};
#pragma unroll
                    for (int e = 0; e < 4; ++e) if (j0 + e == kcol) pv[e] += 1.f;
                    pv = pv * gc; v2u pw; pw.x = pk2(pv.x, pv.y); pw.y = pk2(pv.z, pv.w);
                    *(v2u*)(PC + cbase + (size_t)kcol * 64 + j0) = pw;
                    *(f32x4*)(QC + cbase + (size_t)kcol * 64 + j0) = (f32x4){qt[x][4 * g4], qt[x][4 * g4 + 1], qt[x][4 * g4 + 2], qt[x][4 * g4 + 3]} * gc; } }
        }
        { f32x16 yp[2], yl[2];
#pragma unroll
          for (int x = 0; x < 2; ++x)
#pragma unroll
              for (int q = 0; q < 16; ++q) { yp[x][q] = 0.f; yl[x][q] = 0.f; }
#pragma unroll
          for (int ks = 0; ks < 2; ++ks) { const bf16x8 pab = pack8(AbT, ks), pak = pack8(AkT, ks); const int ro = (16 * ks + 4 * h2 + tq) * 128, co = (16 * cg + 4 * tp) * 2;
#pragma unroll
              for (int x = 0; x < 2; ++x) { yp[x] = MFMA32(vt_frag(IW + ro + 64 * x + co, 8 * 128), pab, yp[x]);
                  yl[x] = MFMA32(vt_frag(IU + ro + 64 * x + co, 8 * 128), pab, yl[x]); yl[x] = MFMA32(vt_frag(IV + ro + 64 * x + co, 8 * 128), pak, yl[x]); } }
          const size_t mrow = (m0 + r32) * DR + h * 64;
#pragma unroll
          for (int x = 0; x < 2; ++x)
#pragma unroll
              for (int g4 = 0; g4 < 4; ++g4) { const int j0 = 32 * x + 8 * g4 + 4 * h2; const v2u rw = *(const LAS v2u*)(IR + r32 * 128 + j0 * 2);
                  *(f32x4*)(YP + mrow + j0) = (f32x4){yp[x][4 * g4] + bflo(rw.x), yp[x][4 * g4 + 1] + bfhi(rw.x), yp[x][4 * g4 + 2] + bflo(rw.y), yp[x][4 * g4 + 3] + bfhi(rw.y)};
                  *(f32x4*)(YL + mrow + j0) = (f32x4){yl[x][4 * g4], yl[x][4 * g4 + 1], yl[x][4 * g4 + 2], yl[x][4 * g4 + 3]}; } }
        LDS_WAIT(); asm volatile("" ::: "memory");
    }
}

constexpr int SA_RS = 592;
constexpr int SA_BUF = 64 * SA_RS;
__device__ __forceinline__ void phase_attn_sample(const Args& a, int l, LAS unsigned char* lds, int tid, int lane, int wave, unsigned* sctr, volatile LAS unsigned* qslot) {
    GAS unsigned char* wsg_ = (GAS unsigned char*)a.ws; asm volatile("" : "+s"(wsg_)); unsigned char* ws = (unsigned char*)wsg_;
    const bf16* QLT = (const bf16*)(ws + WS_QLAT); const bf16* CKVn = (const bf16*)(ws + WS_CKV) + (size_t)MP * KVL; const bf16* KPEn = (const bf16*)(ws + WS_KPE) + (size_t)MP * QKR;
    float* PO = (float*)(ws + WS_PO); float* PM = (float*)(ws + WS_PM); float* PL = (float*)(ws + WS_PL);
    const float* cckv = INF(I_CCKV) + (size_t)l * NPOOL * PAGE * KVL; const float* ckpe = INF(I_CKPE) + (size_t)l * NPOOL * PAGE * QKR; const int* pt = (const int*)a.in[I_PT];
    const int r32 = lane & 31, h2 = lane >> 5, rt = wave & 1, ch = (wave >> 1) & 1, kp = wave >> 2;
    const int g = lane >> 4, li = lane & 15, cg = g & 1, tq = li >> 2, tp = li & 3;
    for (;;) {
        if (tid == 0) *qslot = __hip_atomic_fetch_add(sctr, 1u, __ATOMIC_RELAXED, __HIP_MEMORY_SCOPE_AGENT);
        __syncthreads();
        const int unit = (int)*qslot;
        __syncthreads();
        if (unit >= NB_S * 8) break;
        const int b = unit >> 3, split = unit & 7;
        LAS unsigned char* xbuf = lds + 2 * SA_BUF;
        bf16x8 Bq[9];
#pragma unroll
        for (int ks = 0; ks < 9; ++ks) Bq[ks] = *(const bf16x8*)(QLT + ((size_t)b * 64 + rt * 32 + r32) * 288 + 16 * (9 * ch + ks) + 8 * h2);
        f32x16 O[4];
#pragma unroll
        for (int ct = 0; ct < 4; ++ct)
#pragma unroll
            for (int i = 0; i < 16; ++i) O[ct][i] = 0.f;
        float mrun = -INFINITY, lrun = 0.f;
        constexpr int NP = 32;
        const bool has_new = (split == 7);
        const int mypool = pt[b * NPAGES + split * 16 + (lane & 15)];
        const unsigned vo_c = (unsigned)(tid >> 6) * (KVL * 4u) + (unsigned)(tid & 63) * 16u, vo_p = (unsigned)(tid >> 3) * (QKR * 4u) + (unsigned)(tid & 7) * 16u;
        const int so_c = (tid >> 6) * SA_RS + (tid & 63) * 8, so_p = (tid >> 3) * SA_RS + 512 + (tid & 7) * 8;
        f32x4 gA[8], pA, gB[8], pB;
        auto load_tile = [&](int j, f32x4 (&gc)[8], f32x4& gp) {
            const int pool = __builtin_amdgcn_readlane(mypool, j >> 1);
            const char* src = (const char*)(cckv + ((size_t)pool * PAGE + (j & 1) * 64) * KVL); const char* srp = (const char*)(ckpe + ((size_t)pool * PAGE + (j & 1) * 64) * QKR);
#pragma unroll
            for (int i = 0; i < 8; ++i) gc[i] = __builtin_nontemporal_load((const f32x4*)(src + (vo_c + (unsigned)i * (8u * KVL * 4u))));
            gp = __builtin_nontemporal_load((const f32x4*)(srp + vo_p));
        };
        auto store_tile = [&](LAS unsigned char* buf, const f32x4 (&gc)[8], const f32x4& gp) {
            LAS unsigned char* d = buf + so_c;
#pragma unroll
            for (int i = 0; i < 8; ++i) { v2u w; w.x = pk2(gc[i].x, gc[i].y); w.y = pk2(gc[i].z, gc[i].w); *(LAS v2u*)(d + i * (8 * SA_RS)) = w; }
            { v2u w; w.x = pk2(gp.x, gp.y); w.y = pk2(gp.z, gp.w); *(LAS v2u*)(buf + so_p) = w; }
        };
        auto store_new = [&](LAS unsigned char* buf) {
            for (int q = tid; q < 32 * 36; q += NTHR) { const int key = q / 36, c16 = q - key * 36; v4u w = {0u, 0u, 0u, 0u};
                if (key < 8) w = (c16 < 32) ? *(const v4u*)(CKVn + ((size_t)b * 8 + key) * KVL + c16 * 8) : *(const v4u*)(KPEn + ((size_t)b * 8 + key) * QKR + (c16 - 32) * 8);
                *(LAS v4u*)(buf + key * SA_RS + c16 * 16) = w; }
        };
        auto compute = [&](const LAS unsigned char* tb, bool isnew) {
            f32x16 S0;
#pragma unroll
            for (int i = 0; i < 16; ++i) S0[i] = 0.f;
            const LAS unsigned char* kb = tb + r32 * SA_RS + h2 * 16 + ch * (9 * 32);
#pragma unroll
            for (int ks = 0; ks < 9; ++ks) { const bf16x8 k0 = *(const LAS bf16x8*)(kb + ks * 32); S0 = MFMA32(k0, Bq[ks], S0); }
            {   LAS f32x4* xw = (LAS f32x4*)(xbuf + wave * 4096) + lane; const LAS f32x4* xr = (const LAS f32x4*)(xbuf + (wave ^ 2) * 4096) + lane;
#pragma unroll
                for (int q4 = 0; q4 < 4; ++q4) xw[q4 * 64] = (f32x4){S0[4 * q4], S0[4 * q4 + 1], S0[4 * q4 + 2], S0[4 * q4 + 3]};
                LDS_WAIT(); __builtin_amdgcn_s_barrier(); asm volatile("" ::: "memory");
#pragma unroll
                for (int q4 = 0; q4 < 4; ++q4) { const f32x4 o = xr[q4 * 64]; S0[4 * q4] += o.x; S0[4 * q4 + 1] += o.y; S0[4 * q4 + 2] += o.z; S0[4 * q4 + 3] += o.w; }
            }
            if (isnew) {
                const int tq_ = (rt * 32 + r32) >> 3;
#pragma unroll
                for (int i = 0; i < 16; ++i) { const int key = 32 * kp + 4 * h2 + (i & 3) + 8 * (i >> 2); if (key > tq_) S0[i] = -INFINITY; }
            }
            float mx = S0[0];
#pragma unroll
            for (int i = 1; i < 16; ++i) mx = fmaxf(mx, S0[i]);
            mx = fmaxf(mx, SHX(mx, 32));
            const float mnew = fmaxf(mrun, mx);
            if (__builtin_amdgcn_ballot_w64(mnew > mrun)) {
                const float alpha = __builtin_amdgcn_exp2f(mrun - mnew); mrun = mnew; lrun *= alpha;
#pragma unroll
                for (int ct = 0; ct < 4; ++ct)
#pragma unroll
                    for (int i = 0; i < 16; ++i) O[ct][i] *= alpha;
            }
            float ps = 0.f;
#pragma unroll
            for (int i = 0; i < 16; ++i) { S0[i] = __builtin_amdgcn_exp2f(S0[i] - mrun); ps += S0[i]; }
            lrun += ps;
            const LAS unsigned char* vbase = tb + (4 * h2 + tq) * SA_RS + (ch * 128 + 16 * cg + 4 * tp) * 2;
#pragma unroll
            for (int s = 0; s < 2; ++s) {
                const bf16x8 pb = pack8(S0, s);
                const LAS unsigned char* vp = vbase + (16 * s) * SA_RS;
#pragma unroll
                for (int ct = 0; ct < 4; ++ct) O[ct] = MFMA32(vt_frag(vp + 64 * ct, 8 * SA_RS), pb, O[ct]);
            }
        };
#define SA_BAR() do { LDS_WAIT(); __builtin_amdgcn_s_barrier(); asm volatile("" ::: "memory"); } while (0)
        load_tile(0, gA, pA); load_tile(1, gB, pB); store_tile(lds, gA, pA); SA_BAR();
        for (int j = 0; j < NP - 2; j += 2) {
            load_tile(j + 2, gA, pA);
            compute(lds + kp * 32 * SA_RS, false);
            store_tile(lds + SA_BUF, gB, pB);
            SA_BAR();
            load_tile(j + 3, gB, pB);
            compute(lds + SA_BUF + kp * 32 * SA_RS, false);
            store_tile(lds, gA, pA);
            SA_BAR();
        }
        compute(lds + kp * 32 * SA_RS, false);
        store_tile(lds + SA_BUF, gB, pB);
        SA_BAR();
        compute(lds + SA_BUF + kp * 32 * SA_RS, false);
        if (has_new) store_new(lds);
        __syncthreads();
        if (has_new) compute(lds + kp * 32 * SA_RS, true);
        __syncthreads();
        const float ltot = lrun + SHX(lrun, 32);
        LAS float* xb = (LAS float*)(lds + (wave & 3) * 17408);
        if (kp == 1) {
#pragma unroll
            for (int ct = 0; ct < 4; ++ct)
#pragma unroll
                for (int i = 0; i < 16; ++i) xb[(ct * 16 + i) * 64 + lane] = O[ct][i];
            xb[4096 + lane] = mrun; xb[4160 + lane] = ltot;
        }
        __syncthreads();
        if (kp == 0) {
            const float m1 = xb[4096 + lane], l1 = xb[4160 + lane];
            const float mm = fmaxf(mrun, m1); const float a0 = __builtin_amdgcn_exp2f(mrun - mm), a1 = __builtin_amdgcn_exp2f(m1 - mm);
            const int row = rt * 32 + r32; const size_t pbase = ((size_t)b * 8 + split) * 64 + row;
#pragma unroll
            for (int ct = 0; ct < 4; ++ct)
#pragma unroll
                for (int g4 = 0; g4 < 4; ++g4) { const int c0 = ch * 128 + ct * 32 + 8 * g4 + 4 * h2;
                    f32x4 o;
#pragma unroll
                    for (int e = 0; e < 4; ++e) o[e] = O[ct][4 * g4 + e] * a0 + xb[(ct * 16 + 4 * g4 + e) * 64 + lane] * a1;
                    *(f32x4*)(PO + pbase * 256 + c0) = o; }
            if (ch == 0 && h2 == 0) { PM[pbase] = mm; PL[pbase] = ltot * a0 + l1 * a1; }
        }
        __syncthreads();
    }
}

__device__ __forceinline__ void phase_combine(const Args& a, int l, LAS unsigned char* lds, int lane, int wave) {
    GAS unsigned char* wsg_ = (GAS unsigned char*)a.ws; asm volatile("" : "+s"(wsg_)); unsigned char* ws = (unsigned char*)wsg_;
    const int gw = blockIdx.x * NWAVES + wave, NGW = gridDim.x * NWAVES;
    const float* PO = (const float*)(ws + WS_PO); const float* PM = (const float*)(ws + WS_PM); const float* PL = (const float*)(ws + WS_PL);
    const float* wuv = INF(I_WUV) + (size_t)l * KVL * 512; const bf16* PROJ = (const bf16*)(ws + WS_PROJ); bf16* AMLA = (bf16*)(ws + WS_A4);
    LAS float* ol = (LAS float*)(lds + 65536 + wave * 1024);
    for (int task = gw; task < MS * NH; task += NGW) {
        const int mm = task >> 3, h = task & 7, b = mm >> 3, t = mm & 7, r = t * 8 + h;
        float ms[8], mmax = -INFINITY;
#pragma unroll
        for (int s = 0; s < 8; ++s) { ms[s] = PM[((size_t)b * 8 + s) * 64 + r]; mmax = fmaxf(mmax, ms[s]); }
        float L = 0.f, wsc[8];
#pragma unroll
        for (int s = 0; s < 8; ++s) { wsc[s] = __builtin_amdgcn_exp2f(ms[s] - mmax); L += wsc[s] * PL[((size_t)b * 8 + s) * 64 + r]; }
        const float invL = frcp(L);
#pragma unroll
        for (int ci = 0; ci < 4; ++ci) { const int c = lane + 64 * ci; float acc = 0.f;
#pragma unroll
            for (int s = 0; s < 8; ++s) acc += wsc[s] * PO[(((size_t)b * 8 + s) * 64 + r) * 256 + c];
            ol[c] = acc * invL; }
        LDS_WAIT(); asm volatile("" ::: "memory");
        float o = 0.f;
#pragma unroll 8
        for (int c = 0; c < 256; ++c) o += ol[c] * wuv[((size_t)c * NH + h) * 64 + lane];
        const size_t m = (size_t)MP + mm;
        const float z = bf1(PROJ[m * PW + C_ZM + h * 64 + lane]);
        AMLA[(size_t)(h >> 2) * A4_STRIDE + m * 256 + (h & 3) * 64 + lane] = (bf16)f2bf(o * silu(z));
        LDS_WAIT(); asm volatile("" ::: "memory");
    }
}

constexpr int SCAN_TS = 32;
__device__ __forceinline__ void scan_sample(const Args& a, int l, LAS unsigned char* lds, int lane, int sidx) {
    GAS unsigned char* wsg_ = (GAS unsigned char*)a.ws; asm volatile("" : "+s"(wsg_)); unsigned char* ws = (unsigned char*)wsg_;
    const float* SC = (const float*)(ws + WS_SC); const float* BONUS = (const float*)(ws + WS_BONUS); const bf16* PROJ = (const bf16*)(ws + WS_PROJ); bf16* ARW = (bf16*)(ws + WS_A4) + 3 * A4_STRIDE;
    LAS float* st = (LAS float*)lds;
    { const int seq = NB_P * RH + sidx;
        const bool samp = seq >= NB_P * RH; const int sb = samp ? seq - NB_P * RH : seq; const int b = sb >> 2, h = sb & 3;
        const int T = samp ? TSMP : SEQ; const size_t m0 = samp ? (size_t)MP + b * TSMP : (size_t)b * SEQ;
        float S[64];
        if (samp) { const f32x4* s0 = (const f32x4*)(INF(I_SRWKV) + ((((size_t)l * NB_S + b) * RH + h) * RN + lane) * RN);
#pragma unroll
            for (int j = 0; j < 16; ++j) { const f32x4 v = s0[j]; S[4 * j] = v.x; S[4 * j + 1] = v.y; S[4 * j + 2] = v.z; S[4 * j + 3] = v.w; } }
        else {
#pragma unroll
            for (int j = 0; j < 64; ++j) S[j] = 0.f; }
        const float gng = INF(I_GNG)[l * DR + h * 64 + lane], gnb = INF(I_GNB)[l * DR + h * 64 + lane];
        for (int t0 = 0; t0 < T; t0 += SCAN_TS) {
            const int nt = (T - t0) < SCAN_TS ? (T - t0) : SCAN_TS;
            for (int tt = 0; tt < nt; ++tt) { const float* sc = SC + (m0 + t0 + tt) * 6 * DR + h * 64 + lane; LAS float* d = st + tt * 320 + lane;
                d[0] = sc[0]; d[64] = sc[DR]; d[128] = sc[2 * DR]; d[192] = sc[4 * DR]; d[256] = sc[5 * DR]; }
            LDS_WAIT(); asm volatile("" ::: "memory");
            float vn = SC[(m0 + t0) * 6 * DR + 3 * DR + h * 64 + lane], bon = BONUS[(m0 + t0) * DR + h * 64 + lane], zn = bf1(PROJ[(m0 + t0) * PW + C_ZR + h * 64 + lane]);
            for (int tt = 0; tt < nt; ++tt) {
                const size_t m = m0 + t0 + tt;
                const float v = vn, bo_c = bon, z_c = zn;
                if (tt + 1 < nt) { vn = SC[(m + 1) * 6 * DR + 3 * DR + h * 64 + lane]; bon = BONUS[(m + 1) * DR + h * 64 + lane]; zn = bf1(PROJ[(m + 1) * PW + C_ZR + h * 64 + lane]); }
                const LAS f32x4* vr = (const LAS f32x4*)(st + tt * 320); const LAS f32x4* vw = vr + 16; const LAS f32x4* vk = vr + 32; const LAS f32x4* vkk = vr + 48; const LAS f32x4* vb = vr + 64;
                float sa = 0.f;
#pragma unroll
                for (int j = 0; j < 16; ++j) { const f32x4 q = vkk[j]; sa -= S[4 * j] * q.x + S[4 * j + 1] * q.y + S[4 * j + 2] * q.z + S[4 * j + 3] * q.w; }
                float y = 0.f;
#pragma unroll
                for (int j = 0; j < 16; ++j) { const f32x4 w = vw[j], bb = vb[j], kq = vk[j], rq = vr[j];
                    S[4 * j] = S[4 * j] * w.x + sa * bb.x + v * kq.x; S[4 * j + 1] = S[4 * j + 1] * w.y + sa * bb.y + v * kq.y;
                    S[4 * j + 2] = S[4 * j + 2] * w.z + sa * bb.z + v * kq.z; S[4 * j + 3] = S[4 * j + 3] * w.w + sa * bb.w + v * kq.w;
                    y += S[4 * j] * rq.x + S[4 * j + 1] * rq.y + S[4 * j + 2] * rq.z + S[4 * j + 3] * rq.w; }
                const float mu = wave_sum(y) * (1.f / 64.f); const float d = y - mu; const float var = wave_sum(d * d) * (1.f / 64.f);
                const float yn = d * (frsq(var + GN_EPS)) * gng + gnb;
                const float o = yn + bo_c;
                const float z = z_c;
                ARW[m * DR + h * 64 + lane] = (bf16)f2bf(o * silu(z));
            }
            LDS_WAIT(); asm volatile("" ::: "memory");
        }
        float* so = samp ? a.out + O_RWS + ((((size_t)l * NB_S + b) * RH + h) * RN + lane) * RN : a.out + O_RWP + ((((size_t)l * NB_P + b) * RH + h) * RN + lane) * RN;
#pragma unroll
        for (int j = 0; j < 16; ++j) *(f32x4*)(so + 4 * j) = (f32x4){S[4 * j], S[4 * j + 1], S[4 * j + 2], S[4 * j + 3]};
    }
}

__device__ __forceinline__ void phase_final(const Args& a, int lane, int wave) {
    GAS unsigned char* wsg_ = (GAS unsigned char*)a.ws; asm volatile("" : "+s"(wsg_)); unsigned char* ws = (unsigned char*)wsg_;
    const int gw = blockIdx.x * NWAVES + wave, NGW = gridDim.x * NWAVES;
    const bf16* X = (const bf16*)(ws + WS_X2); const float* fg = INF(I_FNG);
    f32x4 g[4];
#pragma unroll
    for (int j = 0; j < 4; ++j) g[j] = *(const f32x4*)(fg + 4 * lane + 256 * j);
    for (int grp = gw; grp < MT / 8; grp += NGW) {
        const int mbase = grp * 8;
        v2u nr[4];
        auto load_row = [&](int mr) { const v2u* xr = (const v2u*)(X + (size_t)mr * DM) + lane;
#pragma unroll
            for (int j = 0; j < 4; ++j) nr[j] = xr[64 * j]; };
        load_row(mbase);
        for (int r = 0; r < 8; ++r) {
            const int m = mbase + r;
            f32x4 v[4];
#pragma unroll
            for (int j = 0; j < 4; ++j) v[j] = (f32x4){bflo(nr[j].x), bfhi(nr[j].x), bflo(nr[j].y), bfhi(nr[j].y)};
            if (r + 1 < 8) load_row(m + 1);
            float ss = 0.f;
#pragma unroll
            for (int j = 0; j < 4; ++j) ss += (v[j].x * v[j].x + v[j].y * v[j].y) + (v[j].z * v[j].z + v[j].w * v[j].w);
            const float rs = frsq(wave_sum(ss) * (1.f / DM) + RMS_EPS);
            float* o = (m < MP) ? a.out + O_YP + (size_t)m * DM : a.out + O_YS + (size_t)(m - MP) * DM;
#pragma unroll
            for (int j = 0; j < 4; ++j) *(f32x4*)(o + 4 * lane + 256 * j) = v[j] * rs * g[j];
        }
    }
}

#if defined(ONLY)
#define PH_EN(k) (ONLY == (k))
#elif defined(SKIPA)
#define PH_EN(k) ((k) != SKIPA && (k) != SKIPB && (k) != SKIPC)
#else
#define PH_EN(k) 1
#endif
#ifndef PROBE_DBL
#define PROBE_DBL 0
#endif
#define REP(k) for (int rep_ = 0; rep_ < (((PROBE_DBL >> (k)) & 1) ? 2 : 1); ++rep_)
constexpr int NS_FIRST = 128;
constexpr int PH_PER_LAYER = 8, N_PHASES = 1 + DEPTH * PH_PER_LAYER + 1;
__global__ void __launch_bounds__(NTHR, 2) fwd(Args a) {
    extern __shared__ __attribute__((aligned(16))) unsigned char lds_raw[];
    LAS unsigned char* lds = (LAS unsigned char*)lds_raw;
    const int wave0 = __builtin_amdgcn_readfirstlane(threadIdx.x >> 6);
    int tid = threadIdx.x, lane = tid & 63, wave = wave0;
#define RETID() do { int w_ = wave0, l_; asm volatile("" : "+s"(w_)); asm volatile("v_mbcnt_lo_u32_b32 %0, -1, 0\n\tv_mbcnt_hi_u32_b32 %0, -1, %0" : "=v"(l_)); wave = w_; lane = l_; tid = wave * 64 + lane; } while (0)
    volatile LAS unsigned* MISC = (volatile LAS unsigned*)(lds + MISC_OFF);
    for (int u = tid; u < (LDS_BYTES - LDSCTL_OFF) / 4; u += NTHR) ((LAS unsigned*)(lds + LDSCTL_OFF))[u] = 0u;
    __syncthreads();
    const bool fused = (a.ph_hi - a.ph_lo) > 1;
    XcdBarrier bar; bar.bar = (unsigned*)(a.ws + WS_CTL) + CW_BAR; bar.x = 0; bar.st = nullptr;
    if (fused) bar = xcd_barrier_post((unsigned*)(a.ws + WS_CTL) + CW_BAR, MISC + 8);
    const int lo = a.ph_lo, hi = a.ph_hi;
#define IN(k) (lo <= (k) && (k) < hi)
#define SEAM(k) do { if (IN(k) && IN((k) + 1)) { xcd_barrier(bar); if ((PROBE_DBL >> 20) & 1) xcd_barrier(bar); } } while (0)
    if (IN(0)) {
#if PH_EN(0)
 RETID(); phase_prologue(a, lds, tid, lane, wave);
#endif
 }
    SEAM(0);
    for (int l = 0; l < DEPTH; ++l) {
        const int pb = 1 + l * PH_PER_LAYER;
        if (IN(pb + 0)) {
#if PH_EN(1)
 REP(1) { RETID(); phase_modulate(a, l, lane, wave); }
#endif
 }
        SEAM(pb + 0);
        if (IN(pb + 1) && PH_EN(2)) REP(2) {
            GAS unsigned char* wsg_ = (GAS unsigned char*)a.ws; asm volatile("" : "+s"(wsg_)); unsigned char* ws = (unsigned char*)wsg_;     unsigned char* wl = ws + WS_W + (size_t)l * LW_STRIDE;
            pg8::Gemm g{(const bf16*)(ws + WS_U), (const bf16*)(wl + LW_IN), MT, NPROJ, DM}; pg8::StaticOrder S; S.init(MT, NPROJ, gridDim.x, blockIdx.x);
            if ((PROBE_DBL >> 27) & 1) { pg8::EpiProj E0{(bf16*)(ws + WS_QA), (bf16*)(ws + WS_PROJ), 1}; pg8::gemm_phase<pg8::EpiProj, pg8::StaticOrder, true, true>(lds + RING_OFF, g, S, E0, wave0); }
            pg8::EpiProj E{(bf16*)(ws + WS_QA), (bf16*)(ws + WS_PROJ), 0};
            pg8::gemm_phase<pg8::EpiProj, pg8::StaticOrder, true, true>(lds + RING_OFF, g, S, E, wave0);
            if (l == 0 && blockIdx.x >= 154) { RETID(); convert_weights(a, ws, lds, lane, wave, 1, ((int)blockIdx.x - 154) * NWAVES + wave, ((int)gridDim.x - 154) * NWAVES); }
        }
        SEAM(pb + 1);
        if (IN(pb + 2)) {
#if PH_EN(3)
 REP(3) { RETID(); phase_post(a, l, lds, tid, lane, wave); }
#endif
 }
        SEAM(pb + 2);
        if (IN(pb + 3) && PH_EN(4)) REP(4) {
            GAS unsigned char* wsg_ = (GAS unsigned char*)a.ws; asm volatile("" : "+s"(wsg_)); unsigned char* ws = (unsigned char*)wsg_;     unsigned char* wl = ws + WS_W + (size_t)l * LW_STRIDE;
            { pg8::Gemm g{(const bf16*)(ws + WS_QA), (const bf16*)(wl + LW_Q), MT, 768, QL}; pg8::StaticOrder S; S.init(MT, 768, gridDim.x, blockIdx.x);
              pg8::EpiQ E{(const float*)(ws + WS_RSQ), (const float*)(ws + WS_ROPE), (bf16*)(ws + WS_Q), (float*)(ws + WS_QS)};
              pg8::gemm_phase<pg8::EpiQ, pg8::StaticOrder, true, true>(lds + RING_OFF, g, S, E, wave0); }
            { pg8::Gemm g{(const bf16*)(ws + WS_CKV), (const bf16*)(wl + LW_KV), MP, 1024, KVL}; pg8::StaticOrder S; S.init(MP, 1024, gridDim.x, (blockIdx.x + 195) % gridDim.x);
              pg8::EpiKV E{(bf16*)(ws + WS_KN), (bf16*)(ws + WS_V)};
              pg8::gemm_phase<pg8::EpiKV, pg8::StaticOrder, true, true>(lds + RING_OFF, g, S, E, wave0); }
        }
        if (IN(pb + 3)) { REP(5) { RETID(); phase_rwkvA_ut(a, lds, lane, wave); } }
        SEAM(pb + 3);
        if (IN(pb + 4)) REP(6) {
            unsigned* cw = (unsigned*)(a.ws + WS_CTL) + 64 + 64 * (l * 2 + rep_);
            RETID(); phase_qlat(a, l, lane, wave);
            asm volatile("s_waitcnt vmcnt(0)" ::: "memory");
            __syncthreads();
            if (threadIdx.x == 0) { __builtin_amdgcn_fence(__ATOMIC_RELEASE, "agent"); asm volatile("s_waitcnt vmcnt(0)" ::: "memory"); (void)xb_add(cw + 32, 1u); }
            RETID();
            if (blockIdx.x < 32) {
                if (wave == 0) rwkv_chain(a, l, lds, lane, (int)blockIdx.x);
                else if (wave <= 4) scan_sample(a, l, lds + 73728 + (wave - 1) * 10240, lane, (int)blockIdx.x * 4 + (wave - 1));
                __syncthreads();
            }
            const bool sfirst = (int)blockIdx.x >= NS_FIRST;
#pragma nounroll
            for (int pass = 0; pass < 2; ++pass) {
                if ((pass == 0) == sfirst) {
                    if (threadIdx.x == 0) { XB_SPIN(xb_ld(cw + 32) < gridDim.x, bar.bar); __builtin_amdgcn_fence(__ATOMIC_ACQUIRE, "agent"); asm volatile("s_waitcnt vmcnt(0)" ::: "memory"); }
                    __syncthreads();
                    RETID(); phase_attn_sample(a, l, lds, tid, lane, wave, cw + 16, MISC + 16);
                } else { RETID(); phase_attn_prompt(a, lds, tid, lane, wave, cw, MISC + 16); }
            }
        }
        SEAM(pb + 4);
        if (IN(pb + 5)) {
 REP(8) { RETID(); phase_combine(a, l, lds, lane, wave); }
 REP(13) { RETID(); phase_rwkvC(a, l, lds, lane, wave); }
 }
        SEAM(pb + 5);
        if (IN(pb + 6) && PH_EN(9)) REP(9) {
            GAS unsigned char* wsg_ = (GAS unsigned char*)a.ws; asm volatile("" : "+s"(wsg_)); unsigned char* ws = (unsigned char*)wsg_;     unsigned char* wl = ws + WS_W + (size_t)l * LW_STRIDE;
            if (blockIdx.x >= 128) for (int r2_ = 0; r2_ < (((PROBE_DBL >> 26) & 1) ? 2 : 1); ++r2_) { RETID(); thin_merge_sample(a, l, lds, lane, wave, (int)blockIdx.x - 128); }
            pg8::Gemm g{(const bf16*)(ws + WS_A4), (const bf16*)(wl + LW_MLA), 4 * MT, 4 * DM, 256}; pg8::MergeOrder S; S.init(MP, DM, gridDim.x, blockIdx.x);
            if ((PROBE_DBL >> 24) & 1) { pg8::EpiMerge E0{(const bf16*)(ws + WS_PROJ), (bf16*)(ws + WS_MG), (bf16*)(ws + WS_MERGED), 1}; pg8::gemm_phase<pg8::EpiMerge, pg8::MergeOrder, true, true>(lds + RING_OFF, g, S, E0, wave0); }
            pg8::EpiMerge E{(const bf16*)(ws + WS_PROJ), (bf16*)(ws + WS_MG), (bf16*)(ws + WS_MERGED), 0};
            pg8::gemm_phase<pg8::EpiMerge, pg8::MergeOrder, true, true>(lds + RING_OFF, g, S, E, wave0);
        }
        SEAM(pb + 6);
        if (IN(pb + 7) && PH_EN(10)) REP(10) {
            GAS unsigned char* wsg_ = (GAS unsigned char*)a.ws; asm volatile("" : "+s"(wsg_)); unsigned char* ws = (unsigned char*)wsg_;     unsigned char* wl = ws + WS_W + (size_t)l * LW_STRIDE;
            if (blockIdx.x >= 128) for (int r2_ = 0; r2_ < (((PROBE_DBL >> 25) & 1) ? 2 : 1); ++r2_) { RETID(); thin_out_sample(a, l, lds, lane, wave, (int)blockIdx.x - 128); }
            pg8::Gemm g{(const bf16*)(ws + WS_MERGED), (const bf16*)(wl + LW_OUT), MP, DM, DM}; pg8::StaticOrder S; S.init(MP, DM, gridDim.x, blockIdx.x);
            if (l == 0) { pg8::EpiOut<false> E{INF(I_XP), nullptr, (bf16*)(ws + WS_X1), (const float*)(ws + WS_MOD) + 2048, INF(I_BADA) + 2048};
                pg8::gemm_phase<pg8::EpiOut<false>, pg8::StaticOrder, true, true>(lds + RING_OFF, g, S, E, wave0); }
            else { pg8::EpiOut<true> E{nullptr, (const bf16*)(ws + WS_X1), (bf16*)(ws + WS_X2), (const float*)(ws + WS_MOD) + (size_t)NCB * 3072 + 2048, INF(I_BADA) + 3072 + 2048};
                pg8::gemm_phase<pg8::EpiOut<true>, pg8::StaticOrder, true, true>(lds + RING_OFF, g, S, E, wave0); }
        }
        SEAM(pb + 7);
    }
    if (IN(N_PHASES - 1)) {
#if PH_EN(11)
 REP(11) { RETID(); phase_final(a, lane, wave); }
#endif
 }
#undef IN
#undef SEAM
}

#ifndef N_LAUNCH_MODE
#define N_LAUNCH_MODE 1
#endif
extern "C" void kernel_launch(void* const* d_in, const int* in_sizes, int n_in, void* d_out, int out_size, void* d_ws, size_t ws_size, hipStream_t stream) {
    static int grid = 0;
    if (grid == 0) {
        if (n_in != 35 || out_size != (int)O_END || ws_size < WS_END) { fprintf(stderr, "kernel_launch: unexpected sizes n_in %d out %d ws %zu (need %zu)\n", n_in, out_size, ws_size, (size_t)WS_END); grid = -1; return; }
        int dev = 0, cus = 0, per_cu = 0;
        if (hipGetDevice(&dev) != hipSuccess || hipDeviceGetAttribute(&cus, hipDeviceAttributeMultiprocessorCount, dev) != hipSuccess) { grid = -1; return; }
        if (hipFuncSetAttribute((const void*)fwd, hipFuncAttributeMaxDynamicSharedMemorySize, LDS_BYTES) != hipSuccess) { fprintf(stderr, "kernel_launch: hipFuncSetAttribute failed\n"); grid = -1; return; }
        if (hipOccupancyMaxActiveBlocksPerMultiprocessor(&per_cu, (const void*)fwd, NTHR, LDS_BYTES) != hipSuccess || per_cu < 1) fprintf(stderr, "kernel_launch: occupancy query says %d\n", per_cu);
        (void)hipGetLastError();
        grid = cus;
    }
    if (grid < 0) return;
    if (hipMemsetAsync((char*)d_ws + WS_CTL, 0, WS_ZERO_BYTES, stream) != hipSuccess) return;
    Args a{};
    for (int i = 0; i < 35; ++i) a.in[i] = d_in[i];
    a.out = (float*)d_out; a.ws = (unsigned char*)d_ws;
#if N_LAUNCH_MODE == 1
    a.ph_lo = 0; a.ph_hi = N_PHASES;
    hipLaunchKernelGGL(fwd, dim3(grid), dim3(NTHR), LDS_BYTES, stream, a);
#else
    for (int p = 0; p < N_PHASES; ++p) { a.ph_lo = p; a.ph_hi = p + 1; hipLaunchKernelGGL(fwd, dim3(grid), dim3(NTHR), LDS_BYTES, stream, a); }
#endif
}
```

```cpp
#include <hip/hip_runtime.h>
#include <cstdio>
#include <cstdint>
namespace pg8 {
#define PG8_LAS __attribute__((address_space(3)))
typedef unsigned short bf16_t;
typedef short bf16x8 __attribute__((ext_vector_type(8)));
typedef float f32x4 __attribute__((ext_vector_type(4)));
typedef unsigned u32x4 __attribute__((ext_vector_type(4)));
constexpr int BM = 256, BK = 64, HALF = 128, HTB = HALF * BK * 2  , STAGE_BYTES = 8 * HTB, NXCD = 8, WGM = 8;

__host__ __device__ __forceinline__ int lds_byte(int r, int c) { const int st = (r >> 4) * 2 + (c >> 5), rr = r & 15, cc = c & 31, ob = rr * 64 + cc * 2; return st * 1024 + (ob ^ (((ob >> 9) & 1) << 5)); }
__host__ __device__ __forceinline__ void stage_rc(int b, int& R, int& C) { const int st = b / 1024, sb = b % 1024, swz = sb ^ (((sb >> 9) & 1) << 5); R = (st >> 1) * 16 + swz / 64; C = (st & 1) * 32 + (swz % 64) / 2; }
__host__ __device__ __forceinline__ int perm32(int rho) { const int n = rho >> 4, i = rho & 15; return 8 * (i >> 2) + 4 * n + (i & 3); }

struct Unit { int pm, pn; };
struct Gemm { const bf16_t* A; const bf16_t* Bt; int M, N, K; };

struct StaticOrder {
    int nM, nN, nwg, G, c;
    __host__ __device__ void init(int M, int N, int G_, int c_) { nM = M / BM; nN = N / BM; nwg = nM * nN; G = G_; c = c_; }
    __host__ __device__ bool next(int i, Unit& u) const {
        const long L = (long)i * G + c; if (L >= nwg) return false;
        int wgid = (int)L; { const int q = nwg / NXCD, r = nwg % NXCD, xcd = wgid % NXCD, off = wgid / NXCD; wgid = (xcd < r ? xcd * (q + 1) : r * (q + 1) + (xcd - r) * q) + off; }
        const int nig = WGM * nN, gid = wgid / nig, fm = gid * WGM, gsz = (nM - fm) < WGM ? (nM - fm) : WGM;
        u.pm = fm + ((wgid % nig) % gsz); u.pn = (wgid % nig) / gsz; return true;
    }
    __device__ __forceinline__ void a_ready(const Unit&) const {}
    __device__ __forceinline__ void done(const Unit&) const {}
    __device__ __forceinline__ bool keep(const Unit&) const { return false; }
};
__device__ __forceinline__ unsigned cvt_pk_bf16(float lo, float hi) { unsigned r; asm volatile("v_cvt_pk_bf16_f32 %0, %1, %2" : "=v"(r) : "v"(lo), "v"(hi)); return r; }
typedef float f32x2 __attribute__((ext_vector_type(2)));
template <class Epi, class Sched, bool ALIGN_EPI = false, bool SP2 = false>
__device__ __forceinline__ void gemm_phase(PG8_LAS unsigned char* lds, const Gemm g, const Sched& S, const Epi& E, int wave0) {
    int lane_l, wid_l = wave0; asm volatile("v_mbcnt_lo_u32_b32 %0, -1, 0\n\tv_mbcnt_hi_u32_b32 %0, -1, %0" : "=v"(lane_l)); asm volatile("" : "+s"(wid_l)); const int wid = wid_l, lane = lane_l, tid = wid * 64 + lane, wr = wid >> 2, wc = wid & 3, fr = lane & 15, fq = lane >> 4;
    int K_l = g.K; asm volatile("" : "+s"(K_l)); const int K = K_l, nt = K / BK;
    unsigned voffA[2], voffB[2];
#pragma unroll
    for (int i = 0; i < 2; ++i) { int R, C; stage_rc(tid * 16 + i * 8192, R, C); const int Rb = Epi::PERM ? ((R & ~31) + perm32(R & 31)) : R;
        voffA[i] = (unsigned)(R * K + C) * 2u; voffB[i] = (unsigned)(Rb * K + C) * 2u; }
    const size_t kstep = (size_t)(BK * 2);
    const size_t hstep = (size_t)HALF * K * 2;
    const size_t tstep = 2 * hstep;
    const unsigned ldsw = (unsigned)wid * 1024u;
    const int aoff = lds_byte(wr * 64 + fr, fq * 8), boff = lds_byte(wc * 32 + fr, fq * 8);
#define PG8_SA(b, h) (((b) * 2 + (h)) * HTB)
#define PG8_SB(b, h) ((4 + (b) * 2 + (h)) * HTB)
#define PG8_STAGE(bufoff, gbase, voff) do { _Pragma("unroll") for (int _i = 0; _i < 2; ++_i) \
        __builtin_amdgcn_global_load_lds((const unsigned*)((const char*)(gbase) + (voff)[_i]), (PG8_LAS unsigned*)(lds + (bufoff) + ldsw + _i * 8192), 16, 0, 0); } while (0)
#define PG8_LDA(dst, b, h) do { _Pragma("unroll") for (int m = 0; m < 4; ++m) _Pragma("unroll") for (int k = 0; k < 2; ++k) dst[m][k] = *(const PG8_LAS bf16x8*)(lds + PG8_SA(b, h) + aoff + m * 2048 + k * 1024); } while (0)
#define PG8_LDB(dst, b, h) do { _Pragma("unroll") for (int n = 0; n < 2; ++n) _Pragma("unroll") for (int k = 0; k < 2; ++k) dst[n][k] = *(const PG8_LAS bf16x8*)(lds + PG8_SB(b, h) + boff + n * 2048 + k * 1024); } while (0)
#define PG8_MMA(ai, bj, At, Bt) do { __builtin_amdgcn_s_setprio(1); _Pragma("unroll") for (int m = 0; m < 4; ++m) _Pragma("unroll") for (int n = 0; n < 2; ++n) _Pragma("unroll") for (int k = 0; k < 2; ++k) \
        acc[ai][bj][m][n] = __builtin_amdgcn_mfma_f32_16x16x32_bf16(Bt[n][k], At[m][k], acc[ai][bj][m][n], 0, 0, 0); __builtin_amdgcn_s_setprio(0); } while (0)
#define PG8_WAIT_V(n) asm volatile("s_waitcnt vmcnt(" #n ")" ::: "memory")
#define PG8_WAIT_L(n) asm volatile("s_waitcnt lgkmcnt(" #n ")" ::: "memory")
#define PG8_BAR __builtin_amdgcn_s_barrier()
#define PG8_SCHED __builtin_amdgcn_sched_barrier(0)
    Unit cur, nxt; int ui = 0;
    if (!S.next(0, cur)) return;
    f32x4 acc[2][2][4][2];
#pragma unroll
    for (int a = 0; a < 2; ++a)
#pragma unroll
        for (int b = 0; b < 2; ++b)
#pragma unroll
            for (int m = 0; m < 4; ++m)
#pragma unroll
                for (int n = 0; n < 2; ++n) acc[a][b][m][n] = (f32x4){0.f, 0.f, 0.f, 0.f};
    bf16x8 At[4][2], B0[2][2], B1[2][2];
    const char* cA = (const char*)g.A + (size_t)cur.pm * tstep; const char* cB = (const char*)g.Bt + (size_t)cur.pn * tstep;
    S.a_ready(cur);
    if constexpr (SP2) {
        PG8_STAGE(PG8_SB(0, 0), cB, voffB); PG8_STAGE(PG8_SB(0, 1), cB + hstep, voffB); PG8_STAGE(PG8_SA(0, 0), cA, voffA); PG8_STAGE(PG8_SA(0, 1), cA + hstep, voffA);
        if (wr == 1) PG8_BAR;
        PG8_WAIT_V(2); PG8_BAR;
        PG8_STAGE(PG8_SB(1, 0), cB + kstep, voffB); PG8_STAGE(PG8_SA(1, 0), cA + kstep, voffA); PG8_STAGE(PG8_SB(1, 1), cB + hstep + kstep, voffB);
        PG8_WAIT_V(6); PG8_BAR;
    } else {
        PG8_STAGE(PG8_SB(0, 0), cB, voffB); PG8_STAGE(PG8_SA(0, 0), cA, voffA); PG8_STAGE(PG8_SB(0, 1), cB + hstep, voffB); PG8_STAGE(PG8_SA(0, 1), cA + hstep, voffA);
        if (wr == 1) PG8_BAR;
        PG8_WAIT_V(4); PG8_BAR;
        PG8_STAGE(PG8_SB(1, 0), cB + kstep, voffB); PG8_STAGE(PG8_SA(1, 0), cA + kstep, voffA); PG8_STAGE(PG8_SB(1, 1), cB + hstep + kstep, voffB);
        PG8_WAIT_V(6); PG8_BAR;
    }
    for (;;) {
        const bool has_next = S.next(ui + 1, nxt);
        const char* nA = has_next ? (const char*)g.A + (size_t)nxt.pm * tstep : cA; const char* nB = has_next ? (const char*)g.Bt + (size_t)nxt.pn * tstep : cB;
        for (int t = 0; t < nt; t += 2) {
            const bool last = (t == nt - 2);
            const char* a1 = cA + (size_t)(t + 1) * kstep;
            const char* a2 = last ? nA : cA + (size_t)(t + 2) * kstep; const char* b2 = last ? nB : cB + (size_t)(t + 2) * kstep;
            const char* a3 = a2 + kstep; const char* b3 = b2 + kstep;
            if (last && has_next) S.a_ready(nxt);
            if constexpr (SP2) {
            PG8_LDB(B0, 0, 0); PG8_LDB(B1, 0, 1); PG8_SCHED; PG8_LDA(At, 0, 0); PG8_STAGE(PG8_SA(1, 1), a1 + hstep, voffA);
            PG8_WAIT_V(8); PG8_WAIT_L(0); PG8_BAR; PG8_MMA(0, 0, At, B0); PG8_MMA(0, 1, At, B1); PG8_BAR; PG8_SCHED;
            PG8_LDA(At, 0, 1); PG8_STAGE(PG8_SB(0, 0), b2, voffB); PG8_STAGE(PG8_SB(0, 1), b2 + hstep, voffB); PG8_STAGE(PG8_SA(0, 0), a2, voffA);
            PG8_WAIT_V(8); PG8_WAIT_L(0); PG8_BAR; PG8_MMA(1, 0, At, B0); PG8_MMA(1, 1, At, B1); PG8_BAR; PG8_SCHED;
            PG8_LDB(B0, 1, 0); PG8_LDB(B1, 1, 1); PG8_SCHED; PG8_LDA(At, 1, 0); PG8_STAGE(PG8_SA(0, 1), a2 + hstep, voffA);
            PG8_WAIT_V(8); PG8_WAIT_L(0); PG8_BAR; PG8_MMA(0, 0, At, B0); PG8_MMA(0, 1, At, B1); PG8_BAR; PG8_SCHED;
            PG8_LDA(At, 1, 1); PG8_STAGE(PG8_SB(1, 0), b3, voffB); PG8_STAGE(PG8_SB(1, 1), b3 + hstep, voffB); PG8_STAGE(PG8_SA(1, 0), a3, voffA);
            PG8_WAIT_V(8); PG8_WAIT_L(0); PG8_BAR; PG8_MMA(1, 0, At, B0); PG8_MMA(1, 1, At, B1); PG8_BAR; PG8_SCHED;
            } else {
            PG8_LDB(B0, 0, 0); PG8_SCHED; PG8_LDA(At, 0, 0); PG8_STAGE(PG8_SA(1, 1), a1 + hstep, voffA);
            PG8_WAIT_L(8); PG8_BAR; PG8_WAIT_L(0); PG8_MMA(0, 0, At, B0); PG8_BAR; PG8_SCHED;
            PG8_LDB(B1, 0, 1); PG8_STAGE(PG8_SB(0, 0), b2, voffB);
            PG8_BAR; PG8_WAIT_L(0); PG8_MMA(0, 1, At, B1); PG8_BAR;
            PG8_LDA(At, 0, 1); PG8_STAGE(PG8_SA(0, 0), a2, voffA);
            PG8_BAR; PG8_WAIT_L(0); PG8_MMA(1, 0, At, B0); PG8_BAR; PG8_SCHED;
            PG8_STAGE(PG8_SB(0, 1), b2 + hstep, voffB);
            PG8_WAIT_V(6); PG8_BAR; PG8_MMA(1, 1, At, B1); PG8_BAR;
            PG8_LDB(B0, 1, 0); PG8_SCHED; PG8_LDA(At, 1, 0); PG8_STAGE(PG8_SA(0, 1), a2 + hstep, voffA);
            PG8_WAIT_L(8); PG8_BAR; PG8_WAIT_L(0); PG8_MMA(0, 0, At, B0); PG8_BAR; PG8_SCHED;
            PG8_LDB(B1, 1, 1); PG8_STAGE(PG8_SB(1, 0), b3, voffB);
            PG8_BAR; PG8_WAIT_L(0); PG8_MMA(0, 1, At, B1); PG8_BAR;
            PG8_LDA(At, 1, 1); PG8_STAGE(PG8_SA(1, 0), a3, voffA);
            PG8_BAR; PG8_WAIT_L(0); PG8_MMA(1, 0, At, B0); PG8_BAR; PG8_SCHED;
            PG8_STAGE(PG8_SB(1, 1), b3 + hstep, voffB);
            PG8_WAIT_V(6); PG8_BAR; PG8_MMA(1, 1, At, B1); PG8_BAR;
            }
        }
        if constexpr (ALIGN_EPI) { if (wr == 0) PG8_BAR; }
        if constexpr (!Epi::AFTER_DRAIN) { E(acc, cur, wr, wc, fr, fq); S.done(cur); }
        if (!has_next) break;
        if (!S.keep(cur))
#pragma unroll
        for (int a = 0; a < 2; ++a)
#pragma unroll
            for (int b = 0; b < 2; ++b)
#pragma unroll
                for (int m = 0; m < 4; ++m)
#pragma unroll
                    for (int n = 0; n < 2; ++n) acc[a][b][m][n] = (f32x4){0.f, 0.f, 0.f, 0.f};
        cur = nxt; cA = nA; cB = nB; ++ui;
        if constexpr (ALIGN_EPI) { if (wr == 1) PG8_BAR; }
    }
    PG8_WAIT_V(0);
    if constexpr (!ALIGN_EPI) { if (wr == 0) PG8_BAR; }
    PG8_BAR;
    if constexpr (Epi::AFTER_DRAIN) { E.fused(acc, cur, wr, wc, fr, fq, lds, wid, lane); S.done(cur); }
#undef PG8_SA
#undef PG8_SB
#undef PG8_STAGE
#undef PG8_LDA
#undef PG8_LDB
#undef PG8_MMA
#undef PG8_WAIT_V
#undef PG8_WAIT_L
#undef PG8_BAR
#undef PG8_SCHED
}
}

constexpr int NWAVES = 8, NTHR = 512;
constexpr int DM = 1024, NB_P = 8, SEQ = 2048, NB_S = 32, TSMP = 8, DEPTH = 2;
constexpr int MP = NB_P * SEQ, MS = NB_S * TSMP, MT = MP + MS;
constexpr int PAST = 16384, PAGE = 128, NPAGES = 128, NPOOL = 5120;
constexpr int NH = 8, QKN = 64, QKR = 32, DQK = 96, VH = 64, QL = 384, KVL = 256, DMLA = 512;
constexpr int DC = 256, RH = 4, RN = 64, DR = 256, SW = 896, WL = 64;
constexpr int PROJ_SRC = 6432, NPROJ = 6656, PW = 6144;
constexpr int C_KV = 0, C_KR = 256, C_ZM = 384, C_CB = 896, C_CC = 1152, C_CX = 1408, C_ZC = 1664, C_RW = 1920, C_ZR = 2816, C_GM = 3072;
constexpr int NCB = NB_P + NB_S;
constexpr float RMS_EPS = 1e-6f, GN_EPS = 64e-5f;
constexpr float SC2 = 0.10206207261596577f * 1.4426950408889634f;
constexpr int NROPE = SEQ + TSMP;

constexpr size_t O_YP = 0, O_YS = O_YP + (size_t)MP * DM, O_CKVP = O_YS + (size_t)MS * DM, O_KPEP = O_CKVP + (size_t)DEPTH * MP * KVL,
    O_CONVP = O_KPEP + (size_t)DEPTH * MP * QKR, O_SHP = O_CONVP + (size_t)DEPTH * NB_P * 2 * DC, O_RWP = O_SHP + (size_t)DEPTH * NB_P * SW,
    O_CKVS = O_RWP + (size_t)DEPTH * NB_P * RH * RN * RN, O_KPES = O_CKVS + (size_t)DEPTH * MS * KVL, O_CONVS = O_KPES + (size_t)DEPTH * MS * QKR,
    O_SHS = O_CONVS + (size_t)DEPTH * NB_S * 2 * DC, O_RWS = O_SHS + (size_t)DEPTH * NB_S * SW, O_END = O_RWS + (size_t)DEPTH * NB_S * RH * RN * RN;
static_assert(O_END == 28047360, "output size");

constexpr size_t MiB = 1u << 20;
constexpr size_t al256(size_t x) { return (x + 255) & ~(size_t)255; }
constexpr size_t WS_CTL = 0;
constexpr size_t WS_MOD = 1 * MiB;
constexpr size_t WS_ZERO_BYTES = 2 * MiB;
static_assert((size_t)DEPTH * NCB * 3072 * 4 <= MiB, "MOD fits");
constexpr size_t WS_ROPE = 2 * MiB;
constexpr size_t WS_RSQ = WS_ROPE + al256((size_t)NROPE * 32 * 4);
constexpr size_t WS_W = 3 * MiB;
constexpr size_t LW_IN = 0, LW_Q = LW_IN + (size_t)NPROJ * DM * 2, LW_KV = LW_Q + (size_t)768 * QL * 2, LW_MLA = LW_KV + (size_t)1024 * KVL * 2,
    LW_CONV = LW_MLA + (size_t)DM * DMLA * 2, LW_RW = LW_CONV + (size_t)DM * DC * 2, LW_OUT = LW_RW + (size_t)DM * DR * 2, LW_W2T = LW_OUT + (size_t)DM * DM * 2, LW_A2T = LW_W2T + (size_t)DR * WL * 2, LW_STRIDE = LW_A2T + (size_t)DR * WL * 2;
constexpr size_t WS_U = al256(WS_W + 2 * LW_STRIDE);
constexpr size_t WS_QA = WS_U + (size_t)MT * DM * 2;
constexpr size_t WS_PROJ = WS_QA + (size_t)MT * QL * 2;
constexpr size_t WS_CKV = WS_PROJ + (size_t)MT * PW * 2;
constexpr size_t WS_KPE = WS_CKV + (size_t)MT * KVL * 2;
constexpr size_t WS_A4 = WS_KPE + (size_t)MT * QKR * 2;
constexpr size_t A4_STRIDE = (size_t)MT * 256;
constexpr size_t WS_SC = WS_A4 + 4 * A4_STRIDE * 2;
constexpr size_t WS_BONUS = WS_SC + (size_t)MT * 6 * DR * 4;
constexpr size_t WS_Q = WS_BONUS + (size_t)MT * DR * 4;
constexpr size_t WS_QS = WS_Q + (size_t)MP * 768 * 2;
constexpr size_t WS_KN = WS_QS + (size_t)MS * 768 * 4;
constexpr size_t WS_V = WS_KN + (size_t)MP * 512 * 2;
constexpr size_t WS_QLAT = WS_V + (size_t)MP * 512 * 2;
constexpr size_t WS_PO = WS_QLAT + (size_t)NB_S * 64 * 288 * 2;
constexpr size_t WS_PM = WS_PO + (size_t)NB_S * 8 * 64 * 256 * 4;
constexpr size_t WS_PL = WS_PM + (size_t)NB_S * 8 * 64 * 4;
constexpr size_t WS_MG = WS_PL + (size_t)NB_S * 8 * 64 * 4;
constexpr size_t WS_MERGED = WS_MG + (size_t)MT * DM * 2;
constexpr size_t WS_X1 = WS_MERGED + (size_t)MT * DM * 2;
constexpr size_t WS_X2 = WS_X1 + (size_t)MT * DM * 4;
constexpr size_t WS_YL = WS_X2 + (size_t)MT * DM * 4;
constexpr size_t WS_YP = WS_YL + (size_t)MP * DR * 4;
constexpr size_t WS_QC = WS_YP + (size_t)MP * DR * 4;
constexpr int RCL = 32, RNC = SEQ / RCL;
constexpr size_t WS_PC = WS_QC + (size_t)32 * RNC * 4096 * 4;
constexpr size_t WS_SALL = WS_PC + (size_t)32 * RNC * 4096 * 2;
constexpr size_t WS_END = WS_SALL + (size_t)32 * RNC * 4096 * 4;
constexpr int CW_BAR = 4096;

constexpr int RING_OFF = 0, RING_BYTES = 131072;
constexpr int LDSCTL_OFF = RING_BYTES, MISC_OFF = LDSCTL_OFF + 320;
constexpr int LDS_BYTES = 147456;

#define GAS __attribute__((address_space(1)))
#define LAS __attribute__((address_space(3)))
typedef unsigned short bf16;
typedef unsigned v4u __attribute__((ext_vector_type(4)));
typedef unsigned v2u __attribute__((ext_vector_type(2)));
typedef float f32x4 __attribute__((ext_vector_type(4)));
typedef float f32x2 __attribute__((ext_vector_type(2)));
typedef float f32x16 __attribute__((ext_vector_type(16)));
typedef short bf16x8 __attribute__((ext_vector_type(8)));
typedef short s16x4 __attribute__((ext_vector_type(4)));
typedef short v4i16_t __attribute__((ext_vector_type(4)));
#define LDS_WAIT() asm volatile("s_waitcnt lgkmcnt(0)" ::: "memory")
#define VM_WAIT() asm volatile("s_waitcnt vmcnt(0)" ::: "memory")
typedef float f32x2_t __attribute__((ext_vector_type(2)));
typedef __bf16 bf16x2_t __attribute__((ext_vector_type(2)));
__device__ __forceinline__ unsigned pk2(float lo, float hi) { f32x2_t v = {lo, hi}; bf16x2_t b = __builtin_convertvector(v, bf16x2_t); return __builtin_bit_cast(unsigned, b); }
__device__ __forceinline__ unsigned f2bf(float f) { return pk2(f, 0.f) & 0xffffu; }
__device__ __forceinline__ float bflo(unsigned u) { return __builtin_bit_cast(float, u << 16); }
__device__ __forceinline__ float bfhi(unsigned u) { return __builtin_bit_cast(float, u & 0xffff0000u); }
__device__ __forceinline__ float bf1(bf16 b) { return __builtin_bit_cast(float, ((unsigned)b) << 16); }
#define SHX(x, o) __builtin_bit_cast(float, __builtin_amdgcn_ds_bpermute(((lane) ^ (o)) << 2, __builtin_bit_cast(int, (float)(x))))
__device__ __forceinline__ float wave_sum_l(float v, int lane) {
#pragma unroll
    for (int o = 1; o < 64; o <<= 1) v += SHX(v, o);
    return v;
}
__device__ __forceinline__ float grp16_sum_l(float v, int lane) {
#pragma unroll
    for (int o = 1; o < 16; o <<= 1) v += SHX(v, o);
    return v;
}
#define RDL(x, k) __builtin_bit_cast(float, __builtin_amdgcn_readlane(__builtin_bit_cast(int, (float)(x)), (k)))
#define wave_sum(v) wave_sum_l((v), lane)
#define grp16_sum(v) grp16_sum_l((v), lane)
__device__ __forceinline__ float fexp(float x) { return __builtin_amdgcn_exp2f(x * 1.4426950408889634f); }
__device__ __forceinline__ float frcp(float x) { return __builtin_amdgcn_rcpf(x); }
__device__ __forceinline__ float frsq(float x) { return __builtin_amdgcn_rsqf(x); }
__device__ __forceinline__ float sigm(float x) { return frcp(1.f + fexp(-x)); }
__device__ __forceinline__ float silu(float x) { return x * frcp(1.f + fexp(-x)); }
__device__ __forceinline__ void row_info(int m, int& b, int& t, int& T, int& cb, int& pidx) {
    if (m < MP) { b = m >> 11; t = m & 2047; T = SEQ; cb = b; pidx = t; }
    else { const int mm = m - MP; b = mm >> 3; t = mm & 7; T = TSMP; cb = NB_P + b; pidx = SEQ + t; }
}
#define XB_TMO      128
#define XB_XCNT(j)  (256  + 64 * (j))
#define XB_XSUB(j)  (1280 + 64 * (j))
#define XB_XGEN(j)  (2304 + 64 * (j))
#define XB_TOP      3328
#define XB_TOPGEN   3392
#define XCD_BAR_WORDS 3456
#define XB_SPIN_CAP (1u << 18)

__device__ __forceinline__ unsigned xb_ld(unsigned* p)              { return __hip_atomic_load(p, __ATOMIC_RELAXED, __HIP_MEMORY_SCOPE_AGENT); }
__device__ __forceinline__ unsigned xb_add(unsigned* p, unsigned v) { return __hip_atomic_fetch_add(p, v, __ATOMIC_RELAXED, __HIP_MEMORY_SCOPE_AGENT); }
__device__ __forceinline__ unsigned xb_xcc_id() { return (unsigned)__builtin_amdgcn_s_getreg((3 << 11) | 20) & 0xFu; }
#define XB_SPIN(cond, bar) do { unsigned _sp = 0; while (cond) { __builtin_amdgcn_s_sleep(1); \
    if ((++_sp & 255u) == 0u) { if (xb_ld(&(bar)[XB_TMO])) break; if (_sp > XB_SPIN_CAP) { atomicAdd(&(bar)[XB_TMO], 1u); break; } } } } while (0)

struct XcdBarrier {
    unsigned* bar; unsigned x;
    volatile LAS unsigned* st;
};

__device__ __forceinline__ XcdBarrier xcd_barrier_post(unsigned* bar, volatile LAS unsigned* st) {
    XcdBarrier b; b.bar = bar; b.x = xb_xcc_id(); b.st = st;
    if (threadIdx.x == 0) (void)xb_add(&bar[XB_XCNT(b.x)], 1u);
    return b;
}
__device__ __forceinline__ void xcd_barrier_complete(unsigned* bar, unsigned x, unsigned& nloc, unsigned& nx) {
    const unsigned G = gridDim.x * gridDim.y * gridDim.z;
    unsigned sum, cnt, mine, sp = 0u;
    for (;;) {
        sum = 0u; cnt = 0u; mine = 0u;
#pragma unroll
        for (unsigned j = 0; j < 16; ++j) { const unsigned c = xb_ld(&bar[XB_XCNT(j)]); sum += c; cnt += (c > 0u) ? 1u : 0u; mine = (j == x) ? c : mine; }
        if (sum == G) break;
        __builtin_amdgcn_s_sleep(1);
        if ((++sp & 255u) == 0u) { if (xb_ld(&bar[XB_TMO])) break; if (sp > XB_SPIN_CAP) { atomicAdd(&bar[XB_TMO], 1u); break; } }
    }
    nloc = mine > 0u ? mine : 1u; nx = cnt > 0u ? cnt : 1u;
}

__device__ __forceinline__ void xcd_barrier(const XcdBarrier& b) {
    asm volatile("s_waitcnt vmcnt(0)" ::: "memory");
    __syncthreads();
    if (threadIdx.x == 0) {
        unsigned* bar = b.bar;
        __builtin_amdgcn_s_waitcnt(0);
        unsigned nloc = b.st[0], nx = b.st[1];
        if (nloc == 0u) { xcd_barrier_complete(bar, b.x, nloc, nx); b.st[0] = nloc; b.st[1] = nx; }
        const unsigned old = xb_add(&bar[XB_XSUB(b.x)], 1u);
        const unsigned gen = old / nloc;
        if (old + 1u == (gen + 1u) * nloc) {
            __builtin_amdgcn_fence(__ATOMIC_RELEASE, "agent");
            asm volatile("s_waitcnt vmcnt(0)" ::: "memory");
            const unsigned og = xb_add(&bar[XB_TOP], 1u);
            const unsigned tg = og / nx;
            if (og + 1u == (tg + 1u) * nx) xb_add(&bar[XB_TOPGEN], 1u);
            else XB_SPIN(xb_ld(&bar[XB_TOPGEN]) == tg, bar);
            __builtin_amdgcn_fence(__ATOMIC_ACQUIRE, "agent");
            xb_add(&bar[XB_XGEN(b.x)], 1u);
            asm volatile("s_waitcnt vmcnt(0)" ::: "memory");
        } else {
            XB_SPIN(xb_ld(&bar[XB_XGEN(b.x)]) == gen, bar);
            __builtin_amdgcn_fence(__ATOMIC_ACQUIRE, "agent");
            asm volatile("s_waitcnt vmcnt(0)" ::: "memory");
        }
    }
    __syncthreads();
}

#ifndef PROBE_DBL
#define PROBE_DBL 0
#endif
struct Args { const void* in[35]; float* out; unsigned char* ws; int ph_lo, ph_hi; };
enum { I_XP = 0, I_XS, I_CCKV, I_CKPE, I_SCONV, I_SSHIFT, I_SRWKV, I_PT, I_CP, I_CS, I_NORMG, I_WADA, I_BADA, I_WIN, I_QNG, I_WQB, I_KVNG, I_WUK, I_WUV, I_WMLA,
       I_CONVW, I_WCONV, I_MU, I_W0, I_W2, I_A0, I_A2, I_KK, I_KA, I_RK, I_GNG, I_GNB, I_WRW, I_WOUT, I_FNG };
#define INF(i) ((const float*)a.in[i])

struct ColIdent { int off; __device__ __forceinline__ int operator()(int d) const { return d + off; } };
struct ColWin { __device__ __forceinline__ int operator()(int d) const {
    if (d < 384) return d; if (d < 512) return -1; const int pc = d - 512;
    if (pc < 256) return 384 + pc;
    if (pc < 384) return (pc - 256 < 32) ? 640 + pc - 256 : -1;
    if (pc < 896) return 672 + pc - 384;
    if (pc < 1920) return 1184 + pc - 896;
    if (pc < 2816) return 2208 + pc - 1920;
    if (pc < 3072) return 3104 + pc - 2816;
    return 3360 + pc - 3072; } };
struct ColWq { __device__ __forceinline__ int operator()(int d) const { const int h = d / 96, j = d - h * 96; if (j < 64) return d; const int i = (j - 64) >> 1, par = (j - 64) & 1; return h * 96 + 64 + par * 16 + i; } };

template <class SrcCol>
__device__ __forceinline__ void tr_item(const float* __restrict__ W, int K, int Nsrc, bf16* WT, LAS float* scr, int item, int nblk, int lane, SrcCol sc, const float* __restrict__ kscale) {
    const int kb = item / nblk, nb = item - kb * nblk, k0 = 64 * kb, n0 = 32 * nb;
    const int srcc = sc(n0 + (lane & 31));
    float tv[32];
#pragma unroll
    for (int i = 0; i < 32; ++i) { const int kk = 2 * i + (lane >> 5); float v = 0.f; if (srcc >= 0) v = W[(size_t)(k0 + kk) * Nsrc + srcc]; if (kscale) v *= kscale[k0 + kk]; tv[i] = v; }
#pragma unroll
    for (int i = 0; i < 32; ++i) { const int kk = 2 * i + (lane >> 5); scr[kk * 33 + (lane & 31)] = tv[i]; }
    LDS_WAIT(); asm volatile("" ::: "memory");
    const int c = lane & 7;
#pragma unroll
    for (int j = 0; j < 4; ++j) { const int n = (lane >> 3) + 8 * j; const LAS float* s = scr + (8 * c) * 33 + n;
        v4u o; o.x = pk2(s[0], s[33]); o.y = pk2(s[66], s[99]); o.z = pk2(s[132], s[165]); o.w = pk2(s[198], s[231]);
        *(GAS v4u*)(WT + (size_t)(n0 + n) * K + k0 + 8 * c) = o; }
    LDS_WAIT(); asm volatile("" ::: "memory");
}

__device__ __forceinline__ void convert_weights(const Args& a, unsigned char* ws, LAS unsigned char* lds, int lane, int wave, int l, int gw, int NGW) {
    LAS float* scr = (LAS float*)(lds + wave * 16384);
    constexpr int I_IN = (DM / 64) * (NPROJ / 32), I_Q = (QL / 64) * (768 / 32), I_K = (KVL / 64) * (512 / 32), I_MLA = (DMLA / 64) * (DM / 32), I_C = (DC / 64) * (DM / 32), I_O = (DM / 64) * (DM / 32);
    constexpr int I_L = (WL / 64) * (DR / 32);
    constexpr int PER_L = I_IN + I_Q + 2 * I_K + I_MLA + 2 * I_C + I_O + 2 * I_L;
    unsigned char* wl = ws + WS_W + (size_t)l * LW_STRIDE;
    for (int rep_ = 0; rep_ < (((PROBE_DBL >> 21) & 1) ? 2 : 1); ++rep_)
    for (int it = gw; it < PER_L; it += NGW) {
        int r = it;
        if (r < I_IN) { tr_item(INF(I_WIN) + (size_t)l * DM * PROJ_SRC, DM, PROJ_SRC, (bf16*)(wl + LW_IN), scr, r, NPROJ / 32, lane, ColWin{}, nullptr); continue; } r -= I_IN;
        if (r < I_Q) { tr_item(INF(I_WQB) + (size_t)l * QL * 768, QL, 768, (bf16*)(wl + LW_Q), scr, r, 768 / 32, lane, ColWq{}, INF(I_QNG) + l * QL); continue; } r -= I_Q;
        if (r < I_K) { tr_item(INF(I_WUK) + (size_t)l * KVL * 512, KVL, 512, (bf16*)(wl + LW_KV), scr, r, 512 / 32, lane, ColIdent{0}, nullptr); continue; } r -= I_K;
        if (r < I_K) { tr_item(INF(I_WUV) + (size_t)l * KVL * 512, KVL, 512, (bf16*)(wl + LW_KV) + (size_t)512 * KVL, scr, r, 512 / 32, lane, ColIdent{0}, nullptr); continue; } r -= I_K;
        if (r < I_MLA) { const int hfm = r >= I_MLA / 2;
            tr_item(INF(I_WMLA) + (size_t)l * DMLA * DM + (size_t)hfm * 256 * DM, 256, DM, (bf16*)(wl + LW_MLA) + (size_t)hfm * DM * 256, scr, r - hfm * (I_MLA / 2), DM / 32, lane, ColIdent{0}, nullptr); continue; } r -= I_MLA;
        if (r < I_C) { tr_item(INF(I_WCONV) + (size_t)l * DC * DM, DC, DM, (bf16*)(wl + LW_CONV), scr, r, DM / 32, lane, ColIdent{0}, nullptr); continue; } r -= I_C;
        if (r < I_C) { tr_item(INF(I_WRW) + (size_t)l * DR * DM, DR, DM, (bf16*)(wl + LW_RW), scr, r, DM / 32, lane, ColIdent{0}, nullptr); continue; } r -= I_C;
        if (r < I_O) { tr_item(INF(I_WOUT) + (size_t)l * DM * DM, DM, DM, (bf16*)(wl + LW_OUT), scr, r, DM / 32, lane, ColIdent{0}, nullptr); continue; } r -= I_O;
        if (r < I_L) { tr_item(INF(I_W2) + (size_t)l * WL * DR, WL, DR, (bf16*)(wl + LW_W2T), scr, r, DR / 32, lane, ColIdent{0}, nullptr); continue; } r -= I_L;
        tr_item(INF(I_A2) + (size_t)l * WL * DR, WL, DR, (bf16*)(wl + LW_A2T), scr, r, DR / 32, lane, ColIdent{0}, nullptr);
    }
}

__device__ __forceinline__ void phase_prologue(const Args& a, LAS unsigned char* lds, int tid, int lane, int wave) {
    GAS unsigned char* wsg_ = (GAS unsigned char*)a.ws; asm volatile("" : "+s"(wsg_)); unsigned char* ws = (unsigned char*)wsg_;
    for (int arep_ = 0; arep_ < (((PROBE_DBL >> 22) & 1) ? 2 : 1); ++arep_)
    if (blockIdx.x < 192) {
        const int task = blockIdx.x, l = task / 96, rem = task - l * 96, kc = rem / 12, cc = rem - kc * 12;
        LAS float* tab = (LAS float*)lds;
        for (int i = 0; i < 10; ++i) { const int idx = tid + 512 * i, k = idx / 40, b = idx - k * 40;
            const float cv = (b < NB_P) ? INF(I_CP)[b * DM + kc * 128 + k] : INF(I_CS)[(b - NB_P) * DM + kc * 128 + k]; tab[idx] = silu(cv); }
        __syncthreads();
        const int j = cc * 256 + (tid & 255), half = tid >> 8;
        float acc[20];
#pragma unroll
        for (int q = 0; q < 20; ++q) acc[q] = 0.f;
        const float* wp = INF(I_WADA) + ((size_t)l * DM + kc * 128) * 3072 + j;
        for (int kb = 0; kb < 128; kb += 32) {
            float wv[32];
#pragma unroll
            for (int k = 0; k < 32; ++k) wv[k] = wp[(size_t)(kb + k) * 3072];
#pragma unroll
            for (int k = 0; k < 32; ++k) { const float w = wv[k]; const LAS f32x4* tr = (const LAS f32x4*)(tab + (kb + k) * 40 + half * 20);
#pragma unroll
                for (int q = 0; q < 5; ++q) { const f32x4 t4 = tr[q]; acc[4 * q] += t4.x * w; acc[4 * q + 1] += t4.y * w; acc[4 * q + 2] += t4.z * w; acc[4 * q + 3] += t4.w * w; } }
        }
        float* mod = (float*)(ws + WS_MOD) + ((size_t)l * NCB + half * 20) * 3072 + j;
#pragma unroll
        for (int q = 0; q < 20; ++q) unsafeAtomicAdd(mod + (size_t)q * 3072, ((PROBE_DBL >> 22) & 1) ? 0.5f * acc[q] : acc[q]);
        __syncthreads();
    }
    { const int gid = blockIdx.x * NTHR + tid;
      if (gid < NROPE * 16) { const int pidx = gid >> 4, i = gid & 15; const int pos = pidx < SEQ ? pidx : PAST + (pidx - SEQ);
        const double invd[16] = {1.0, 0.5623413251903491, 0.31622776601683794, 0.1778279410038923, 0.1, 0.05623413251903491, 0.03162277660168379, 0.01778279410038923,
                                 0.01, 0.005623413251903491, 0.0031622776601683794, 0.0017782794100389228, 0.001, 0.0005623413251903491, 0.00031622776601683794, 0.00017782794100389227};
        double iv = 1.0;
#pragma unroll
        for (int q = 0; q < 16; ++q) iv = (i == q) ? invd[q] : iv;
        const float ang = (float)pos * (float)iv;
        const double rev = (double)ang * 0.15915494309189535; double fr = rev - floor(rev); if (fr > 0.5) fr -= 1.0;
        const float r = (float)(fr * 6.283185307179586);
        float* rp = (float*)(ws + WS_ROPE) + (size_t)gid * 2; rp[0] = __cosf(r); rp[1] = __sinf(r); } }
    convert_weights(a, ws, lds, lane, wave, 0, blockIdx.x * NWAVES + wave, gridDim.x * NWAVES);
}

__device__ __forceinline__ const float* xrow_ptr(const Args& a, unsigned char* ws, int l, int m) {
    if (l == 0) return (m < MP) ? INF(I_XP) + (size_t)m * DM : INF(I_XS) + (size_t)(m - MP) * DM;
    return (const float*)(ws + WS_X1) + (size_t)m * DM;
}
__device__ __forceinline__ void phase_modulate(const Args& a, int l, int lane, int wave) {
    GAS unsigned char* wsg_ = (GAS unsigned char*)a.ws; asm volatile("" : "+s"(wsg_)); unsigned char* ws = (unsigned char*)wsg_;
    const int gw = blockIdx.x * NWAVES + wave, NGW = gridDim.x * NWAVES;
    const float* mod = (const float*)(ws + WS_MOD) + (size_t)l * NCB * 3072; const float* bada = INF(I_BADA) + l * 3072; const float* ng = INF(I_NORMG) + l * DM;
    bf16* U = (bf16*)(ws + WS_U);
    for (int grp = gw; grp < MT / 8; grp += NGW) {
        const int mbase = grp * 8; int b, t, T, cb, pidx; row_info(mbase, b, t, T, cb, pidx);
        const float* mrow = mod + (size_t)cb * 3072;
        f32x4 g[4], sh[4], sc[4];
#pragma unroll
        for (int j = 0; j < 4; ++j) { const int col = 4 * lane + 256 * j; g[j] = *(const f32x4*)(ng + col); sh[j] = *(const f32x4*)(mrow + col) + *(const f32x4*)(bada + col);
            sc[j] = *(const f32x4*)(mrow + DM + col) + *(const f32x4*)(bada + DM + col) + 1.0f; }
        f32x4 nx[4]; v2u nr[4];
        auto load_row = [&](int mr) {
            if (l == 0) { const f32x4* xr = (const f32x4*)xrow_ptr(a, ws, 0, mr) + lane;
#pragma unroll
                for (int j = 0; j < 4; ++j) nx[j] = xr[64 * j]; }
            else { const v2u* xr = (const v2u*)((const bf16*)(ws + WS_X1) + (size_t)mr * DM) + lane;
#pragma unroll
                for (int j = 0; j < 4; ++j) nr[j] = xr[64 * j]; } };
        load_row(mbase);
        for (int r = 0; r < 8; ++r) {
            const int m = mbase + r;
            f32x4 v[4];
            if (l == 0) {
#pragma unroll
                for (int j = 0; j < 4; ++j) v[j] = nx[j]; }
            else {
#pragma unroll
                for (int j = 0; j < 4; ++j) v[j] = (f32x4){bflo(nr[j].x), bfhi(nr[j].x), bflo(nr[j].y), bfhi(nr[j].y)}; }
            if (r + 1 < 8) load_row(m + 1);
            float ss = 0.f;
#pragma unroll
            for (int j = 0; j < 4; ++j) ss += (v[j].x * v[j].x + v[j].y * v[j].y) + (v[j].z * v[j].z + v[j].w * v[j].w);
            const float rs = frsq(wave_sum(ss) * (1.f / DM) + RMS_EPS);
#pragma unroll
            for (int j = 0; j < 4; ++j) { const int col = 4 * lane + 256 * j;
                const f32x4 u = v[j] * rs * g[j] * sc[j] + sh[j];
                v2u o; o.x = pk2(u.x, u.y); o.y = pk2(u.z, u.w); *(v2u*)(U + (size_t)m * DM + col) = o; }
        }
    }
}

namespace pg8 {
struct EpiProj {
    static constexpr bool PERM = true, AFTER_DRAIN = false;
    bf16_t* QA; bf16_t* PROJ; int noepi;
    __device__ __forceinline__ void operator()(const f32x4 (&acc)[2][2][4][2], const Unit& u, int wr, int wc, int fr, int fq) const {
        if (noepi) return;
        const int row0 = u.pm * BM + wr * 64 + fr;
#pragma unroll
        for (int bj = 0; bj < 2; ++bj) {
            const int blk = u.pn * 2 + bj; if (blk == 3) continue;
            bf16_t* base; int ld, c0; if (blk < 3) { base = QA; ld = QL; c0 = blk * 128; } else { base = PROJ; ld = PW; c0 = blk * 128 - 512; }
            const int col = c0 + wc * 32 + 8 * fq;
#pragma unroll
            for (int ai = 0; ai < 2; ++ai)
#pragma unroll
                for (int m = 0; m < 4; ++m) { f32x4 v0 = acc[ai][bj][m][0], v1 = acc[ai][bj][m][1];
                    if (blk >= 28) {
#pragma unroll
                        for (int e = 0; e < 4; ++e) { v0[e] = sigm(v0[e]); v1[e] = sigm(v1[e]); } }
                    u32x4 w; w.x = cvt_pk_bf16(v0[0], v0[1]); w.y = cvt_pk_bf16(v0[2], v0[3]); w.z = cvt_pk_bf16(v1[0], v1[1]); w.w = cvt_pk_bf16(v1[2], v1[3]);
                    *(u32x4*)(base + (size_t)(row0 + ai * HALF + m * 16) * ld + col) = w; }
        }
    }
};
struct EpiQ {
    static constexpr bool PERM = true, AFTER_DRAIN = false;
    const float* RSQ; const float* ROPE; bf16_t* Q; float* QS;
    __device__ __forceinline__ void operator()(const f32x4 (&acc)[2][2][4][2], const Unit& u, int wr, int wc, int fr, int fq) const {
        const int row0 = u.pm * BM + wr * 64 + fr;
#pragma unroll
        for (int aim = 0; aim < 4; ++aim) { const int ai = aim >> 1, mb = (aim & 1) * 2;
        float rsv[4]; f32x4 csa[4][2], csb[4][2];
#pragma unroll
            for (int m = mb; m < mb + 2; ++m) { const int row = row0 + ai * HALF + m * 16; rsv[m] = RSQ[row]; const int pidx = row >= MP ? SEQ + ((row - MP) & 7) : (row & 2047);
#pragma unroll
                for (int bj = 0; bj < 2; ++bj) { const int col = u.pn * BM + bj * HALF + wc * 32 + 8 * fq; const int h = col / 96, j = col - h * 96;
                    const int i0 = j < 64 ? 0 : (j - 64) >> 1; const float* rp = ROPE + ((size_t)pidx * 16 + i0) * 2; csa[m][bj] = *(const f32x4*)rp; csb[m][bj] = *(const f32x4*)(rp + 4); } }
#pragma unroll
            for (int m = mb; m < mb + 2; ++m) {
                const int row = row0 + ai * HALF + m * 16; const float rs = rsv[m];
                const bool samp = row >= MP;
#pragma unroll
                for (int bj = 0; bj < 2; ++bj) {
                    const int col = u.pn * BM + bj * HALF + wc * 32 + 8 * fq; const int h = col / 96, j = col - h * 96;
                    float v[8];
#pragma unroll
                    for (int e = 0; e < 4; ++e) { v[e] = acc[ai][bj][m][0][e] * rs; v[4 + e] = acc[ai][bj][m][1][e] * rs; }
                    if (j < 64) {
                        if (!samp) { u32x4 w; w.x = cvt_pk_bf16(v[0] * SC2, v[1] * SC2); w.y = cvt_pk_bf16(v[2] * SC2, v[3] * SC2); w.z = cvt_pk_bf16(v[4] * SC2, v[5] * SC2); w.w = cvt_pk_bf16(v[6] * SC2, v[7] * SC2);
                            *(u32x4*)(Q + (size_t)row * 768 + col) = w; }
                        else { float* d = QS + (size_t)(row - MP) * 768 + col; *(f32x4*)d = (f32x4){v[0], v[1], v[2], v[3]}; *(f32x4*)(d + 4) = (f32x4){v[4], v[5], v[6], v[7]}; }
                    } else {
                        const int i0 = (j - 64) >> 1;
                        const f32x4 cs0 = csa[m][bj], cs1 = csb[m][bj];
                        float o1[4], o2[4];
                        o1[0] = v[0] * cs0.x - v[1] * cs0.y; o2[0] = v[1] * cs0.x + v[0] * cs0.y;
                        o1[1] = v[2] * cs0.z - v[3] * cs0.w; o2[1] = v[3] * cs0.z + v[2] * cs0.w;
                        o1[2] = v[4] * cs1.x - v[5] * cs1.y; o2[2] = v[5] * cs1.x + v[4] * cs1.y;
                        o1[3] = v[6] * cs1.z - v[7] * cs1.w; o2[3] = v[7] * cs1.z + v[6] * cs1.w;
                        const int cb = h * 96 + 64 + i0;
                        if (!samp) { unsigned* d = (unsigned*)(Q + (size_t)row * 768 + cb);
                            d[0] = cvt_pk_bf16(o1[0] * SC2, o1[1] * SC2); d[1] = cvt_pk_bf16(o1[2] * SC2, o1[3] * SC2);
                            d[8] = cvt_pk_bf16(o2[0] * SC2, o2[1] * SC2); d[9] = cvt_pk_bf16(o2[2] * SC2, o2[3] * SC2); }
                        else { float* d = QS + (size_t)(row - MP) * 768 + cb; *(f32x4*)d = (f32x4){o1[0], o1[1], o1[2], o1[3]}; *(f32x4*)(d + 16) = (f32x4){o2[0], o2[1], o2[2], o2[3]}; }
                    }
                }
            }
        }
    }
};
struct EpiKV {
    static constexpr bool PERM = true, AFTER_DRAIN = false;
    bf16_t* KN; bf16_t* V;
    __device__ __forceinline__ void operator()(const f32x4 (&acc)[2][2][4][2], const Unit& u, int wr, int wc, int fr, int fq) const {
        const int row0 = u.pm * BM + wr * 64 + fr; bf16_t* base = (u.pn < 2) ? KN : V; const int colt = (u.pn & 1) * BM + wc * 32 + 8 * fq;
#pragma unroll
        for (int ai = 0; ai < 2; ++ai)
#pragma unroll
            for (int m = 0; m < 4; ++m)
#pragma unroll
                for (int bj = 0; bj < 2; ++bj) { const f32x4 v0 = acc[ai][bj][m][0], v1 = acc[ai][bj][m][1];
                    u32x4 w; w.x = cvt_pk_bf16(v0[0], v0[1]); w.y = cvt_pk_bf16(v0[2], v0[3]); w.z = cvt_pk_bf16(v1[0], v1[1]); w.w = cvt_pk_bf16(v1[2], v1[3]);
                    *(u32x4*)(base + (size_t)(row0 + ai * HALF + m * 16) * 512 + colt + bj * HALF) = w; }
    }
};
struct MergeOrder : StaticOrder {
    __device__ __forceinline__ bool next(int i, Unit& u) const { Unit t; if (!StaticOrder::next(i >> 2, t)) return false; const int sub = i & 3; u.pm = sub * 65 + t.pm; u.pn = sub * 4 + t.pn; return true; }
    __device__ __forceinline__ bool keep(const Unit& u) const { return u.pn < 4; }
};
struct EpiMerge {
    static constexpr bool PERM = true, AFTER_DRAIN = false;
    const bf16_t* PROJ; bf16_t* MG; bf16_t* MERGED; int noepi;
    __device__ __forceinline__ void operator()(const f32x4 (&acc)[2][2][4][2], const Unit& u, int wr, int wc, int fr, int fq) const {
        const int sub = u.pn >> 2; if (sub == 0 || noepi) return;
        const int pm = u.pm - sub * 65, pn = u.pn & 3, br = sub - 1;
        const int row0 = pm * BM + wr * 64 + fr, col0 = pn * BM + wc * 32 + 8 * fq;
#pragma unroll
        for (int ai = 0; ai < 2; ++ai) {
            u32x4 gw[4][2], pw[4][2];
#pragma unroll
            for (int m = 0; m < 4; ++m)
#pragma unroll
                for (int bj = 0; bj < 2; ++bj) { const size_t row = row0 + ai * HALF + m * 16; const int col = col0 + bj * HALF;
                    gw[m][bj] = *(const u32x4*)(PROJ + row * PW + C_GM + br * DM + col);
                    if (br > 0) pw[m][bj] = *(const u32x4*)(MG + row * DM + col); }
#pragma unroll
            for (int m = 0; m < 4; ++m)
#pragma unroll
                for (int bj = 0; bj < 2; ++bj) { const size_t row = row0 + ai * HALF + m * 16; const int col = col0 + bj * HALF;
                    const u32x4 g = gw[m][bj];
                    f32x4 v0 = acc[ai][bj][m][0] * (f32x4){bflo(g.x), bfhi(g.x), bflo(g.y), bfhi(g.y)}, v1 = acc[ai][bj][m][1] * (f32x4){bflo(g.z), bfhi(g.z), bflo(g.w), bfhi(g.w)};
                    if (br > 0) { const u32x4 q = pw[m][bj]; v0 = v0 + (f32x4){bflo(q.x), bfhi(q.x), bflo(q.y), bfhi(q.y)}; v1 = v1 + (f32x4){bflo(q.z), bfhi(q.z), bflo(q.w), bfhi(q.w)}; }
                    u32x4 w; w.x = cvt_pk_bf16(v0[0], v0[1]); w.y = cvt_pk_bf16(v0[2], v0[3]); w.z = cvt_pk_bf16(v1[0], v1[1]); w.w = cvt_pk_bf16(v1[2], v1[3]);
                    *(u32x4*)((br < 2 ? MG : MERGED) + row * DM + col) = w; }
        }
    }
};
template <bool XBF> struct EpiOut {
    static constexpr bool PERM = false, AFTER_DRAIN = false;
    const float* XPf; const bf16_t* XPb; bf16_t* XO; const float* MODG; const float* BADG;
    __device__ __forceinline__ void operator()(const f32x4 (&acc)[2][2][4][2], const Unit& u, int wr, int wc, int fr, int fq) const {
        const int row0 = u.pm * BM + wr * 64 + fr, col0 = u.pn * BM + wc * 32 + 4 * fq;
        const int cb = (u.pm * BM) >> 11; const float* gr = MODG + (size_t)cb * 3072;
        f32x4 gt[2][2];
#pragma unroll
        for (int bj = 0; bj < 2; ++bj)
#pragma unroll
            for (int n = 0; n < 2; ++n) { const int col = col0 + bj * HALF + n * 16; gt[bj][n] = *(const f32x4*)(gr + col) + *(const f32x4*)(BADG + col); }
#pragma unroll
        for (int aim = 0; aim < 4; ++aim) { const int ai = aim >> 1, mb = (aim & 1) * 2;
            f32x4 xv[4][2][2];
            if constexpr (!XBF) {
#pragma unroll
                for (int m = mb; m < mb + 2; ++m)
#pragma unroll
                    for (int bj = 0; bj < 2; ++bj)
#pragma unroll
                        for (int n = 0; n < 2; ++n) xv[m][bj][n] = *(const f32x4*)(XPf + (size_t)(row0 + ai * HALF + m * 16) * DM + col0 + bj * HALF + n * 16);
            } else {
#pragma unroll
                for (int m = mb; m < mb + 2; ++m)
#pragma unroll
                    for (int bj = 0; bj < 2; ++bj)
#pragma unroll
                        for (int n = 0; n < 2; ++n) { const unsigned long long q = *(const unsigned long long*)(XPb + (size_t)(row0 + ai * HALF + m * 16) * DM + col0 + bj * HALF + n * 16); const unsigned lo = (unsigned)q, hi = (unsigned)(q >> 32);
                            xv[m][bj][n] = (f32x4){__builtin_bit_cast(float, lo << 16), __builtin_bit_cast(float, lo & 0xffff0000u), __builtin_bit_cast(float, hi << 16), __builtin_bit_cast(float, hi & 0xffff0000u)}; }
            }
#pragma unroll
            for (int m = mb; m < mb + 2; ++m)
#pragma unroll
                for (int bj = 0; bj < 2; ++bj)
#pragma unroll
                    for (int n = 0; n < 2; ++n) { const f32x4 o = xv[m][bj][n] + gt[bj][n] * acc[ai][bj][m][n];
                        unsigned long long w = (unsigned long long)cvt_pk_bf16(o[0], o[1]) | ((unsigned long long)cvt_pk_bf16(o[2], o[3]) << 32);
                        *(unsigned long long*)(XO + (size_t)(row0 + ai * HALF + m * 16) * DM + col0 + bj * HALF + n * 16) = w; }
        }
    }
};
}

__device__ __forceinline__ float out_dummy() { return 0.f; }
__device__ __forceinline__ void phase_post(const Args& a, int l, LAS unsigned char* lds, int tid, int lane, int wave) {
    GAS unsigned char* wsg_ = (GAS unsigned char*)a.ws; asm volatile("" : "+s"(wsg_)); unsigned char* ws = (unsigned char*)wsg_;     float* out = a.out;
    const bf16* PROJ = (const bf16*)(ws + WS_PROJ); const bf16* QA = (const bf16*)(ws + WS_QA);
    float* RSQ = (float*)(ws + WS_RSQ); const float* ROPE = (const float*)(ws + WS_ROPE);
    bf16* CKV = (bf16*)(ws + WS_CKV); bf16* KPE = (bf16*)(ws + WS_KPE); bf16* ACONV = (bf16*)(ws + WS_A4) + 2 * A4_STRIDE;
    float* SC = (float*)(ws + WS_SC); float* BONUS = (float*)(ws + WS_BONUS);
    const int c4 = 4 * lane;
    const f32x4 gkv = *(const f32x4*)(INF(I_KVNG) + l * KVL + c4);
    const f32x4 cw0 = *(const f32x4*)(INF(I_CONVW) + (l * 3 + 0) * DC + c4), cw1 = *(const f32x4*)(INF(I_CONVW) + (l * 3 + 1) * DC + c4), cw2 = *(const f32x4*)(INF(I_CONVW) + (l * 3 + 2) * DC + c4);
    const float* mu = INF(I_MU) + l * SW;
    const f32x4 mu_r = *(const f32x4*)(mu + c4), mu_k = *(const f32x4*)(mu + 256 + c4), mu_v = *(const f32x4*)(mu + 512 + c4);
    const float mu_w = mu[768 + lane], mu_a = mu[832 + lane];
    const f32x4 w0v = *(const f32x4*)(INF(I_W0) + l * DR + c4), a0v = *(const f32x4*)(INF(I_A0) + l * DR + c4), kkv = *(const f32x4*)(INF(I_KK) + l * DR + c4),
                kav = *(const f32x4*)(INF(I_KA) + l * DR + c4), rkv = *(const f32x4*)(INF(I_RK) + l * DR + c4);
    constexpr int XS = 144, XB_OFF = 80 * XS, RL_OFF = 2 * 80 * XS, RL_MAT = 65 * 512;
    const unsigned char* wl = ws + WS_W + (size_t)l * LW_STRIDE;
    for (int bk = blockIdx.x; bk < MT / 65; bk += gridDim.x) {
    const int m0 = bk * 65;
    for (int r = wave; r < 80; r += NWAVES) {
        float tw = 0.f, ai = 0.f;
        if (r < 65) { const int m = m0 + r; int b, t, T, cb, pidx; row_info(m, b, t, T, cb, pidx); const bool samp = m >= MP;
            const bf16* R = PROJ + (size_t)m * PW + C_RW; const float* sprev = INF(I_SSHIFT) + (size_t)(l * NB_S + b) * SW;
            const float cwi = bf1(R[768 + lane]), cai = bf1(R[832 + lane]); float pwi = 0.f, pai = 0.f;
            if (t >= 1) { pwi = bf1(R[768 + lane - PW]); pai = bf1(R[832 + lane - PW]); } else if (samp) { pwi = sprev[768 + lane]; pai = sprev[832 + lane]; }
            const float wi = cwi + mu_w * (pwi - cwi); ai = cai + mu_a * (pai - cai); tw = 1.0f - 2.0f * frcp(fexp(2.0f * wi) + 1.0f); }
        *(LAS bf16*)(lds + r * XS + lane * 2) = (bf16)f2bf(tw); *(LAS bf16*)(lds + XB_OFF + r * XS + lane * 2) = (bf16)f2bf(ai);
    }
    __syncthreads();
    { const int fr = lane & 15, fq = lane >> 4;
      bf16x8 wf[2][2][2];
#pragma unroll
      for (int lo = 0; lo < 2; ++lo)
#pragma unroll
          for (int q = 0; q < 2; ++q)
#pragma unroll
              for (int ks = 0; ks < 2; ++ks) wf[lo][q][ks] = *(const bf16x8*)((const bf16*)(wl + (lo ? LW_A2T : LW_W2T)) + (size_t)(16 * (2 * wave + q) + fr) * WL + 32 * ks + 8 * fq);
      for (int rt = 0; rt < 5; ++rt) {
          pg8::f32x4 acc[2][2];
#pragma unroll
          for (int lo = 0; lo < 2; ++lo)
#pragma unroll
              for (int q = 0; q < 2; ++q) acc[lo][q] = (pg8::f32x4){0.f, 0.f, 0.f, 0.f};
#pragma unroll
          for (int ks = 0; ks < 2; ++ks) {
              const bf16x8 xa = *(const LAS bf16x8*)(lds + (16 * rt + fr) * XS + (32 * ks + 8 * fq) * 2), xb = *(const LAS bf16x8*)(lds + XB_OFF + (16 * rt + fr) * XS + (32 * ks + 8 * fq) * 2);
#pragma unroll
              for (int q = 0; q < 2; ++q) { acc[0][q] = __builtin_amdgcn_mfma_f32_16x16x32_bf16(wf[0][q][ks], xa, acc[0][q], 0, 0, 0); acc[1][q] = __builtin_amdgcn_mfma_f32_16x16x32_bf16(wf[1][q][ks], xb, acc[1][q], 0, 0, 0); } }
          const int row = 16 * rt + fr;
          if (row < 65) {
#pragma unroll
              for (int lo = 0; lo < 2; ++lo)
#pragma unroll
                  for (int q = 0; q < 2; ++q) { v2u o; o.x = pk2(acc[lo][q][0], acc[lo][q][1]); o.y = pk2(acc[lo][q][2], acc[lo][q][3]);
                      *(LAS v2u*)(lds + RL_OFF + lo * RL_MAT + row * 512 + (16 * (2 * wave + q) + 4 * fq) * 2) = o; } }
      } }
    __syncthreads();
    struct PostRaw { unsigned qa[3]; v2u kv, cc0, cx0, cc1, cx1, cc2, cx2, cb, zc, r0, k0, v0, r1, k1, v1; float kr1, kr2, cwi, cai, cs, sn; };
    auto load_row = [&](int rowi, PostRaw& w) {
        const int m = m0 + rowi; int b, t, T, cb_, pidx; row_info(m, b, t, T, cb_, pidx);
        const bf16* P = PROJ + (size_t)m * PW; const unsigned* q = (const unsigned*)(QA + (size_t)m * QL);
#pragma unroll
        for (int i = 0; i < 3; ++i) w.qa[i] = q[lane + 64 * i];
        w.kv = *(const v2u*)(P + C_KV + c4);
        w.kr1 = bf1(P[C_KR + (lane & 15)]); w.kr2 = bf1(P[C_KR + 16 + (lane & 15)]); w.cs = ROPE[((size_t)pidx * 16 + (lane & 15)) * 2]; w.sn = ROPE[((size_t)pidx * 16 + (lane & 15)) * 2 + 1];
        w.cc0 = *(const v2u*)(P + C_CC + c4); w.cx0 = *(const v2u*)(P + C_CX + c4); w.cb = *(const v2u*)(P + C_CB + c4); w.zc = *(const v2u*)(P + C_ZC + c4);
        const v2u z2 = {0u, 0u};
        w.cc1 = z2; w.cx1 = z2; w.cc2 = z2; w.cx2 = z2; w.r1 = z2; w.k1 = z2; w.v1 = z2;
        if (t >= 1) { w.cc1 = *(const v2u*)(P - PW + C_CC + c4); w.cx1 = *(const v2u*)(P - PW + C_CX + c4);
            w.r1 = *(const v2u*)(P - PW + C_RW + c4); w.k1 = *(const v2u*)(P - PW + C_RW + 256 + c4); w.v1 = *(const v2u*)(P - PW + C_RW + 512 + c4); }
        if (t >= 2) { w.cc2 = *(const v2u*)(P - 2 * PW + C_CC + c4); w.cx2 = *(const v2u*)(P - 2 * PW + C_CX + c4); }
        w.r0 = *(const v2u*)(P + C_RW + c4); w.k0 = *(const v2u*)(P + C_RW + 256 + c4); w.v0 = *(const v2u*)(P + C_RW + 512 + c4);
        w.cwi = bf1(P[C_RW + 768 + lane]); w.cai = bf1(P[C_RW + 832 + lane]);
    };
#define UNPK(w_) ((f32x4){bflo((w_).x), bfhi((w_).x), bflo((w_).y), bfhi((w_).y)})
    PostRaw nxt; load_row(wave, nxt);
    for (int rowi = wave; rowi < 65; rowi += NWAVES) {
        const PostRaw w = nxt;
        if (rowi + NWAVES < 65) load_row(rowi + NWAVES, nxt);
        const int m = m0 + rowi;
        int b, t, T, cb, pidx; row_info(m, b, t, T, cb, pidx); const bool samp = m >= MP;
        { float ss = 0.f;
#pragma unroll
          for (int i = 0; i < 3; ++i) { const float x = bflo(w.qa[i]), y = bfhi(w.qa[i]); ss += x * x + y * y; }
          ss = wave_sum(ss); if (lane == 0) RSQ[m] = frsq(ss * (1.f / QL) + RMS_EPS); }
        { f32x4 x = UNPK(w.kv);
          const float ss = wave_sum((x.x * x.x + x.y * x.y) + (x.z * x.z + x.w * x.w)); const float rs = frsq(ss * (1.f / KVL) + RMS_EPS);
          x = x * rs * gkv;
          float* o = samp ? out + O_CKVS + ((size_t)l * MS + (m - MP)) * KVL : out + O_CKVP + ((size_t)l * MP + m) * KVL;
          *(f32x4*)(o + c4) = x; v2u ob; ob.x = pk2(x.x, x.y); ob.y = pk2(x.z, x.w); *(v2u*)(CKV + (size_t)m * KVL + c4) = ob; }
        if (lane < 16) { const float o1 = w.kr1 * w.cs - w.kr2 * w.sn, o2 = w.kr2 * w.cs + w.kr1 * w.sn;
          float* o = samp ? out + O_KPES + ((size_t)l * MS + (m - MP)) * QKR : out + O_KPEP + ((size_t)l * MP + m) * QKR;
          o[lane] = o1; o[16 + lane] = o2; KPE[(size_t)m * QKR + lane] = (bf16)f2bf(o1); KPE[(size_t)m * QKR + 16 + lane] = (bf16)f2bf(o2); }
        { const f32x4 p0 = UNPK(w.cc0) * UNPK(w.cx0);
          f32x4 p1 = UNPK(w.cc1) * UNPK(w.cx1), p2 = UNPK(w.cc2) * UNPK(w.cx2);
          if (samp && t < 2) { const float* sconv = INF(I_SCONV) + ((size_t)(l * NB_S + b) * 2) * DC + c4;
              if (t == 0) { p1 = *(const f32x4*)(sconv + DC); p2 = *(const f32x4*)(sconv); } else p2 = *(const f32x4*)(sconv + DC); }
          const f32x4 cv = p2 * cw0 + p1 * cw1 + p0 * cw2;
          const v2u wz = w.zc;
          const f32x4 o = (f32x4){silu(bflo(wz.x)), silu(bfhi(wz.x)), silu(bflo(wz.y)), silu(bfhi(wz.y))} * UNPK(w.cb) * cv;
          v2u ob; ob.x = pk2(o.x, o.y); ob.y = pk2(o.z, o.w); *(v2u*)(ACONV + (size_t)m * DC + c4) = ob;
          if (t >= T - 2) { float* so = samp ? out + O_CONVS + (((size_t)l * NB_S + b) * 2 + (t - (T - 2))) * DC : out + O_CONVP + (((size_t)l * NB_P + b) * 2 + (t - (T - 2))) * DC;
              *(f32x4*)(so + c4) = p0; } }
        { const f32x4 cr = UNPK(w.r0), ck = UNPK(w.k0), cv_ = UNPK(w.v0); const float cwi = w.cwi, cai = w.cai;
          f32x4 pr = UNPK(w.r1), pk = UNPK(w.k1), pv = UNPK(w.v1);
          if (samp && t == 0) { const float* sprev = INF(I_SSHIFT) + (size_t)(l * NB_S + b) * SW; pr = *(const f32x4*)(sprev + c4); pk = *(const f32x4*)(sprev + 256 + c4); pv = *(const f32x4*)(sprev + 512 + c4); }
          if (t == T - 1) { float* so = samp ? out + O_SHS + ((size_t)l * NB_S + b) * SW : out + O_SHP + ((size_t)l * NB_P + b) * SW;
              *(f32x4*)(so + c4) = cr; *(f32x4*)(so + 256 + c4) = ck; *(f32x4*)(so + 512 + c4) = cv_; so[768 + lane] = cwi; so[832 + lane] = cai; }
          const f32x4 r = cr + mu_r * (pr - cr), k = ck + mu_k * (pk - ck), v = cv_ + mu_v * (pv - cv_);
          f32x4 accw = w0v, acca = a0v;
          { const v2u lw = *(const LAS v2u*)(lds + RL_OFF + rowi * 512 + c4 * 2), la = *(const LAS v2u*)(lds + RL_OFF + RL_MAT + rowi * 512 + c4 * 2);
            accw += UNPK(lw); acca += UNPK(la); }
          f32x4 dec, av;
#pragma unroll
          for (int e = 0; e < 4; ++e) { const float x = -accw[e];
              const float sp = fmaxf(x, 0.f) + __logf(1.0f + fexp(-fabsf(x))); const float wlog = -sp - 0.5f; dec[e] = fexp(-fexp(wlog)); av[e] = sigm(acca[e]); }
          f32x4 kk = k * kkv; const float ssq = grp16_sum((kk.x * kk.x + kk.y * kk.y) + (kk.z * kk.z + kk.w * kk.w)); kk = kk * frcp(fmaxf(sqrtf(ssq), 1e-12f));
          const f32x4 k2 = k * ((av - 1.0f) * kav + 1.0f);
          const f32x4 rkk = r * k2 * rkv; const float bon = grp16_sum((rkk.x + rkk.y) + (rkk.z + rkk.w));
          float* sc = SC + (size_t)m * 6 * DR + c4;
          *(f32x4*)(sc) = r; *(f32x4*)(sc + DR) = dec; *(f32x4*)(sc + 2 * DR) = k2; *(f32x4*)(sc + 3 * DR) = v; *(f32x4*)(sc + 4 * DR) = kk; *(f32x4*)(sc + 5 * DR) = kk * av;
          *(f32x4*)(BONUS + (size_t)m * DR + c4) = v * bon; }
    }
#undef UNPK
    __syncthreads();
    }
}

__device__ __forceinline__ void phase_qlat(const Args& a, int l, int lane, int wave) {
    GAS unsigned char* wsg_ = (GAS unsigned char*)a.ws; asm volatile("" : "+s"(wsg_)); unsigned char* ws = (unsigned char*)wsg_;
    const int gw = blockIdx.x * NWAVES + wave, NGW = gridDim.x * NWAVES;
    const float* QS = (const float*)(ws + WS_QS); bf16* QLT = (bf16*)(ws + WS_QLAT); const float* wuk = INF(I_WUK) + (size_t)l * KVL * 512;
    for (int task = gw; task < MS * NH; task += NGW) {
        const int mm = task >> 3, h = task & 7, b = mm >> 3, t = mm & 7, r = t * 8 + h;
        const float* q = QS + (size_t)mm * 768 + h * 96;
        const float qn = q[lane];
        bf16* dst = QLT + ((size_t)b * 64 + r) * 288;
#pragma unroll
        for (int ci = 0; ci < 4; ++ci) { const int c = lane + 64 * ci; const f32x4* wr = (const f32x4*)(wuk + ((size_t)c * NH + h) * 64); float acc = 0.f;
#pragma unroll
            for (int n4 = 0; n4 < 16; ++n4) { const f32x4 w = wr[n4]; acc += w.x * RDL(qn, 4 * n4) + w.y * RDL(qn, 4 * n4 + 1) + w.z * RDL(qn, 4 * n4 + 2) + w.w * RDL(qn, 4 * n4 + 3); }
            dst[c] = (bf16)f2bf(acc * SC2); }
        if (lane < 32) dst[256 + lane] = (bf16)f2bf(q[64 + lane] * SC2);
    }
}

__device__ __forceinline__ void glds16(const void* gsrc, unsigned lds_dst) { unsigned keep;
    asm volatile("s_mov_b32 %0, m0\n\ts_mov_b32 m0, %2\n\ts_nop 0\n\tglobal_load_lds_dwordx4 %1, off\n\ts_mov_b32 m0, %0" : "=&s"(keep) : "v"(gsrc), "s"(lds_dst) : "memory"); }
#define MFMA32(a_, b_, c_) __builtin_amdgcn_mfma_f32_32x32x16_bf16((a_), (b_), (c_), 0, 0, 0)
__device__ __forceinline__ bf16x8 pack8(const f32x16& x, int s) {
    v4u p; p.x = pk2(x[8 * s], x[8 * s + 1]); p.y = pk2(x[8 * s + 2], x[8 * s + 3]); p.z = pk2(x[8 * s + 4], x[8 * s + 5]); p.w = pk2(x[8 * s + 6], x[8 * s + 7]);
    return __builtin_bit_cast(bf16x8, p);
}
__device__ __forceinline__ bf16x8 vt_frag(const LAS unsigned char* p0, int rowstride8) {
    const s16x4 lo = __builtin_bit_cast(s16x4, __builtin_amdgcn_ds_read_tr16_b64_v4i16((LAS v4i16_t*)p0));
    const s16x4 hi = __builtin_bit_cast(s16x4, __builtin_amdgcn_ds_read_tr16_b64_v4i16((LAS v4i16_t*)(p0 + rowstride8)));
    bf16x8 r; r[0] = lo[0]; r[1] = lo[1]; r[2] = lo[2]; r[3] = lo[3]; r[4] = hi[0]; r[5] = hi[1]; r[6] = hi[2]; r[7] = hi[3]; return r;
}

constexpr int PA_KS = 208, PA_VS = 144;
constexpr int PA_KBYTES = 64 * PA_KS, PA_VBYTES = 64 * PA_VS, PA_BUF = PA_KBYTES + PA_VBYTES;
__device__ __forceinline__ void phase_attn_prompt(const Args& a, LAS unsigned char* lds, int tid, int lane, int wave, unsigned* qctr, volatile LAS unsigned* qslot) {
    GAS unsigned char* wsg_ = (GAS unsigned char*)a.ws; asm volatile("" : "+s"(wsg_)); unsigned char* ws = (unsigned char*)wsg_;
    const bf16* Q = (const bf16*)(ws + WS_Q); const bf16* KN = (const bf16*)(ws + WS_KN); const bf16* KPE = (const bf16*)(ws + WS_KPE); const bf16* V = (const bf16*)(ws + WS_V);
    const bf16* PROJ = (const bf16*)(ws + WS_PROJ); bf16* AMLA = (bf16*)(ws + WS_A4);
    const int r32 = lane & 31, h2 = lane >> 5;
    for (;;) {
        {
            if (tid == 0) *qslot = __hip_atomic_fetch_add(qctr, 1u, __ATOMIC_RELAXED, __HIP_MEMORY_SCOPE_AGENT);
            __syncthreads();
            const int u = (int)*qslot;
            __syncthreads();
            if (u >= 512) break;
            const int qb = 7 - (u >> 6), bh = u & 63, b = bh >> 3, h = bh & 7;
            const int q0w = qb * 256 + wave * 32;
            const size_t tok0 = (size_t)b * SEQ;
            bf16x8 Bq[6];
#pragma unroll
            for (int ks = 0; ks < 6; ++ks) Bq[ks] = *(const bf16x8*)(Q + (tok0 + q0w + r32) * 768 + h * 96 + 16 * ks + 8 * h2);
            f32x16 O0, O1;
#pragma unroll
            for (int i = 0; i < 16; ++i) { O0[i] = 0.f; O1[i] = 0.f; }
            float mrun = -INFINITY, lrun = 0.f;
            const int ntile = 4 * qb + 4;
            const int krow = tid >> 3, kch = tid & 7, prow = (tid & 255) >> 2, pch = tid & 3;
            v4u gkA, gpA, gvA, gkB, gpB, gvB;
            auto issue = [&](int kt, v4u& gk, v4u& gp, v4u& gv) { const size_t tk = tok0 + (size_t)kt * 64 + krow;
                gk = *(const v4u*)(KN + tk * 512 + h * 64 + kch * 8); gv = *(const v4u*)(V + tk * 512 + h * 64 + kch * 8); gp = *(const v4u*)(KPE + (tok0 + (size_t)kt * 64 + prow) * QKR + pch * 8); };
            auto stash = [&](int bufi, const v4u& gk, const v4u& gp, const v4u& gv) { LAS unsigned char* kn = lds + bufi * PA_BUF; LAS unsigned char* vn = kn + PA_KBYTES;
                *(LAS v4u*)(kn + krow * PA_KS + kch * 16) = gk; *(LAS v4u*)(vn + krow * PA_VS + kch * 16) = gv; if (tid < 256) *(LAS v4u*)(kn + prow * PA_KS + 128 + pch * 16) = gp; };
#define PA_BAR() do { LDS_WAIT(); __builtin_amdgcn_s_barrier(); asm volatile("" ::: "memory"); } while (0)
            auto compute = [&](int kt, int bufi) {
                const LAS unsigned char* kb = lds + bufi * PA_BUF; const LAS unsigned char* vb = kb + PA_KBYTES;
                if (kt * 64 <= q0w + 31) {
                    f32x16 S0, S1;
#pragma unroll
                    for (int i = 0; i < 16; ++i) { S0[i] = 0.f; S1[i] = 0.f; }
#pragma unroll
                    for (int kh = 0; kh < 2; ++kh) {
                        bf16x8 kf0[3], kf1[3];
#pragma unroll
                        for (int k3 = 0; k3 < 3; ++k3) { const int ks = 3 * kh + k3;
                            kf0[k3] = *(const LAS bf16x8*)(kb + r32 * PA_KS + ks * 32 + h2 * 16); kf1[k3] = *(const LAS bf16x8*)(kb + (32 + r32) * PA_KS + ks * 32 + h2 * 16); }
                        asm volatile("" : "+v"(kf0[0]), "+v"(kf0[1]), "+v"(kf0[2]), "+v"(kf1[0]), "+v"(kf1[1]), "+v"(kf1[2]));
#pragma unroll
                        for (int k3 = 0; k3 < 3; ++k3) { S0 = MFMA32(kf0[k3], Bq[3 * kh + k3], S0); S1 = MFMA32(kf1[k3], Bq[3 * kh + k3], S1); }
                    }
                    if (kt * 64 + 63 > q0w) {
                        const int qq = q0w + r32, kbase = kt * 64 + 4 * h2;
#pragma unroll
                        for (int i = 0; i < 16; ++i) { const int key = kbase + (i & 3) + 8 * (i >> 2); if (key > qq) S0[i] = -INFINITY; if (key + 32 > qq) S1[i] = -INFINITY; }
                    }
                    float mx = S0[0];
#pragma unroll
                    for (int i = 1; i < 16; ++i) mx = fmaxf(mx, S0[i]);
#pragma unroll
                    for (int i = 0; i < 16; ++i) mx = fmaxf(mx, S1[i]);
                    mx = fmaxf(mx, SHX(mx, 32));
                    const float mnew = fmaxf(mrun, mx);
                    if (__builtin_amdgcn_ballot_w64(mnew > mrun)) {
                        const float alpha = __builtin_amdgcn_exp2f(mrun - mnew); mrun = mnew; lrun *= alpha;
#pragma unroll
                        for (int i = 0; i < 16; ++i) { O0[i] *= alpha; O1[i] *= alpha; }
                    }
                    float ps = 0.f;
#pragma unroll
                    for (int i = 0; i < 16; ++i) { S0[i] = __builtin_amdgcn_exp2f(S0[i] - mrun); S1[i] = __builtin_amdgcn_exp2f(S1[i] - mrun); ps += S0[i] + S1[i]; }
                    lrun += ps;
                    const int g = lane >> 4, li = lane & 15, cg = g & 1, tq = li >> 2, tp = li & 3;
                    const LAS unsigned char* vbase = vb + (4 * h2 + tq) * PA_VS + (16 * cg + 4 * tp) * 2;
#pragma unroll
                    for (int sub = 0; sub < 2; ++sub)
                    {   const LAS unsigned char* vp0 = vbase + (32 * sub) * PA_VS; const LAS unsigned char* vp1 = vp0 + 16 * PA_VS;
                        bf16x8 va = vt_frag(vp0, 8 * PA_VS), vb_ = vt_frag(vp0 + 64, 8 * PA_VS), vc = vt_frag(vp1, 8 * PA_VS), vd = vt_frag(vp1 + 64, 8 * PA_VS);
                        const bf16x8 pb0 = pack8(sub == 0 ? S0 : S1, 0), pb1 = pack8(sub == 0 ? S0 : S1, 1);
                        asm volatile("" : "+v"(va), "+v"(vb_), "+v"(vc), "+v"(vd));
                        O0 = MFMA32(va, pb0, O0); O1 = MFMA32(vb_, pb0, O1); O0 = MFMA32(vc, pb1, O0); O1 = MFMA32(vd, pb1, O1);
                    }
                }
            };
            issue(0, gkA, gpA, gvA); issue(1, gkB, gpB, gvB); stash(0, gkA, gpA, gvA); PA_BAR();
            for (int kt = 0; kt < ntile - 2; kt += 2) {
                issue(kt + 2, gkA, gpA, gvA); compute(kt, 0); stash(1, gkB, gpB, gvB); PA_BAR();
                issue(kt + 3, gkB, gpB, gvB); compute(kt + 1, 1); stash(0, gkA, gpA, gvA); PA_BAR();
            }
            compute(ntile - 2, 0); stash(1, gkB, gpB, gvB); PA_BAR();
            compute(ntile - 1, 1);
            const float ltot = lrun + SHX(lrun, 32); const float inv = frcp(ltot);
            const size_t row = tok0 + q0w + r32;
            v2u zz[2][4];
#pragma unroll
            for (int dt = 0; dt < 2; ++dt)
#pragma unroll
                for (int g4 = 0; g4 < 4; ++g4) zz[dt][g4] = *(const v2u*)(PROJ + row * PW + C_ZM + h * 64 + dt * 32 + 8 * g4 + 4 * h2);
#pragma unroll
            for (int dt = 0; dt < 2; ++dt)
#pragma unroll
                for (int g4 = 0; g4 < 4; ++g4) { const int d0 = dt * 32 + 8 * g4 + 4 * h2;
                    const v2u zw = zz[dt][g4];
                    const f32x16& O = dt == 0 ? O0 : O1;
                    const float o0 = O[4 * g4] * inv * silu(bflo(zw.x)), o1 = O[4 * g4 + 1] * inv * silu(bfhi(zw.x)), o2 = O[4 * g4 + 2] * inv * silu(bflo(zw.y)), o3 = O[4 * g4 + 3] * inv * silu(bfhi(zw.y));
                    v2u ob; ob.x = pk2(o0, o1); ob.y = pk2(o2, o3); *(v2u*)(AMLA + (size_t)(h >> 2) * A4_STRIDE + row * 256 + (h & 3) * 64 + d0) = ob; }
        }
    }
}

constexpr int RA_SUB = 8, RA_STEP = 6 * 256, RA_BUF = RA_SUB * RA_STEP;
__device__ __forceinline__ float dpp_xor1(float x) { return __builtin_bit_cast(float, __builtin_amdgcn_update_dpp(0, __builtin_bit_cast(int, x), 0xB1, 0xF, 0xF, true)); }
__device__ __forceinline__ float dpp_xor2(float x) { return __builtin_bit_cast(float, __builtin_amdgcn_update_dpp(0, __builtin_bit_cast(int, x), 0x4E, 0xF, 0xF, true)); }

__device__ __forceinline__ void phase_rwkvA(const Args& a, LAS unsigned char* lds, int tid, int lane, int wave) {
    GAS unsigned char* wsg_ = (GAS unsigned char*)a.ws; asm volatile("" : "+s"(wsg_)); unsigned char* ws = (unsigned char*)wsg_;
    const float* SC = (const float*)(ws + WS_SC); float* YL = (float*)(ws + WS_YL); float* YP = (float*)(ws + WS_YP); float* QC = (float*)(ws + WS_QC); bf16* PC = (bf16*)(ws + WS_PC);
    const int pr = wave >> 1, part = wave & 1;
    const int ib = lane >> 2, jb = lane & 3;
    const int pt = part * 64 + lane;
    LAS unsigned char* mybuf = lds + pr * (2 * RA_BUF);
    for (int bk = blockIdx.x; bk < 8 * RNC; bk += gridDim.x) {
        const int seq = bk / (RNC / 4), c = (bk % (RNC / 4)) * 4 + pr, b = seq >> 2, h = seq & 3;
        const size_t m0 = (size_t)b * SEQ + (size_t)c * RCL;
        f32x2 S[4][8];
#pragma unroll
        for (int r = 0; r < 4; ++r)
#pragma unroll
            for (int pp = 0; pp < 8; ++pp) { S[r][pp].x = (part == 1 && (4 * ib + r) == (16 * jb + 2 * pp)) ? 1.f : 0.f; S[r][pp].y = (part == 1 && (4 * ib + r) == (16 * jb + 2 * pp + 1)) ? 1.f : 0.f; }
        f32x4 stg[6];
        auto stage_load = [&](int sub) {
#pragma unroll
            for (int i = 0; i < 6; ++i) { const int q = pt + 128 * i, st = q / 96, rem = q - st * 96, vec = rem >> 4, ch = rem & 15;
                const int srcv = vec == 0 ? 4 : vec == 1 ? 1 : vec == 2 ? 5 : vec == 3 ? 2 : vec == 4 ? 0 : 3;
                stg[i] = *(const f32x4*)(SC + (m0 + sub * RA_SUB + st) * 6 * DR + srcv * DR + h * 64 + ch * 4); }
        };
        auto stage_store = [&](int buf) {
#pragma unroll
            for (int i = 0; i < 6; ++i) { const int q = pt + 128 * i, st = q / 96, rem = q - st * 96;
                *(LAS f32x4*)(mybuf + buf * RA_BUF + st * RA_STEP + rem * 16) = stg[i]; }
        };
        stage_load(0); stage_store(0); __syncthreads();
        for (int sub = 0; sub < RCL / RA_SUB; ++sub) {
            const bool more = sub + 1 < RCL / RA_SUB;
            if (more) stage_load(sub + 1);
            const LAS unsigned char* cur = mybuf + (sub & 1) * RA_BUF;
            for (int st = 0; st < RA_SUB; ++st) {
                const LAS f32x4* base = (const LAS f32x4*)(cur + st * RA_STEP);
                const LAS f32x2* b2 = (const LAS f32x2*)base;
                f32x2 sa2[4];
#pragma unroll
                for (int r = 0; r < 4; ++r) sa2[r] = (f32x2){0.f, 0.f};
#pragma unroll
                for (int pp = 0; pp < 8; ++pp) { const f32x2 kq = b2[8 * jb + pp];
#pragma unroll
                    for (int r = 0; r < 4; ++r) sa2[r] += S[r][pp] * kq; }
                float sa[4];
#pragma unroll
                for (int r = 0; r < 4; ++r) { float t = -(sa2[r].x + sa2[r].y); t += dpp_xor1(t); t += dpp_xor2(t); sa[r] = t; }
                f32x4 vv = base[80 + ib]; if (part == 1) vv = (f32x4){0.f, 0.f, 0.f, 0.f};
                f32x2 y2[4];
#pragma unroll
                for (int r = 0; r < 4; ++r) y2[r] = (f32x2){0.f, 0.f};
#pragma unroll
                for (int pp = 0; pp < 8; ++pp) { const f32x2 wq = b2[32 + 8 * jb + pp], bq = b2[64 + 8 * jb + pp], kq = b2[96 + 8 * jb + pp], rq = b2[128 + 8 * jb + pp];
#pragma unroll
                    for (int r = 0; r < 4; ++r) { const f32x2 sar = {sa[r], sa[r]}, vr = {vv[r], vv[r]};
                        S[r][pp] = S[r][pp] * wq + (sar * bq + vr * kq); y2[r] += S[r][pp] * rq; } }
                float y[4];
#pragma unroll
                for (int r = 0; r < 4; ++r) { float t = y2[r].x + y2[r].y; t += dpp_xor1(t); t += dpp_xor2(t); y[r] = t; }
                if (jb == 0) { float* yo = (part == 1 ? YP : YL) + (m0 + sub * RA_SUB + st) * DR + h * 64 + 4 * ib; *(f32x4*)yo = (f32x4){y[0], y[1], y[2], y[3]}; }
            }
            if (more) stage_store((sub + 1) & 1);
            __syncthreads();
        }
        const size_t cb = (((size_t)seq * RNC + c) * 64 + 4 * ib) * 64 + 16 * jb;
        if (part == 0) {
#pragma unroll
            for (int r = 0; r < 4; ++r)
#pragma unroll
                for (int q = 0; q < 4; ++q) *(f32x4*)(QC + cb + r * 64 + 4 * q) = (f32x4){S[r][2 * q].x, S[r][2 * q].y, S[r][2 * q + 1].x, S[r][2 * q + 1].y};
        } else {
#pragma unroll
            for (int r = 0; r < 4; ++r)
#pragma unroll
                for (int q = 0; q < 2; ++q) { v4u w; w.x = pk2(S[r][4 * q].x, S[r][4 * q].y); w.y = pk2(S[r][4 * q + 1].x, S[r][4 * q + 1].y); w.z = pk2(S[r][4 * q + 2].x, S[r][4 * q + 2].y); w.w = pk2(S[r][4 * q + 3].x, S[r][4 * q + 3].y);
                    *(v4u*)(PC + cb + r * 64 + 8 * q) = w; }
        }
    }
}

constexpr int RB_BUF = 24576;
__device__ __forceinline__ void rwkv_chain(const Args& a, int l, LAS unsigned char* lds, int lane, int seq) {
    GAS unsigned char* wsg_ = (GAS unsigned char*)a.ws; asm volatile("" : "+s"(wsg_)); unsigned char* ws = (unsigned char*)wsg_;
    const float* QC = (const float*)(ws + WS_QC); const bf16* PC = (const bf16*)(ws + WS_PC); float* SALL = (float*)(ws + WS_SALL);
    const int r32 = lane & 31, h2 = lane >> 5, g = lane >> 4, li = lane & 15, cg = g & 1, tq = li >> 2, tp = li & 3;
    f32x16 St[2][2];
#pragma unroll
    for (int x = 0; x < 2; ++x)
#pragma unroll
        for (int y = 0; y < 2; ++y)
#pragma unroll
            for (int q = 0; q < 16; ++q) St[x][y][q] = 0.f;
    const unsigned lds0 = (unsigned)(uintptr_t)lds;
    auto dma = [&](int c) {
        const size_t cbase = ((size_t)seq * RNC + c) * 4096; const unsigned bb = lds0 + (c % 3) * RB_BUF;
#pragma unroll
        for (int x = 0; x < 8; ++x) glds16(PC + cbase + (size_t)(lane + 64 * x) * 8, (unsigned)__builtin_amdgcn_readfirstlane(bb + x * 1024));
#pragma unroll
        for (int jt = 0; jt < 2; ++jt)
#pragma unroll
            for (int it = 0; it < 2; ++it)
#pragma unroll
                for (int g4 = 0; g4 < 4; ++g4)
                    glds16(QC + cbase + (size_t)(32 * it + r32) * 64 + 32 * jt + 8 * g4 + 4 * h2, (unsigned)__builtin_amdgcn_readfirstlane(bb + 8192 + ((jt * 2 + it) * 4 + g4) * 1024));
    };
    dma(0); dma(1);
    for (int c = 0; c < RNC; ++c) {
        const size_t cbase = ((size_t)seq * RNC + c) * 4096; const LAS unsigned char* bb = lds + (c % 3) * RB_BUF;
        if (c == 0) asm volatile("s_waitcnt vmcnt(24)" ::: "memory"); else if (c == 1) asm volatile("s_waitcnt vmcnt(40)" ::: "memory");
        else if (c == RNC - 1) asm volatile("s_waitcnt vmcnt(32)" ::: "memory"); else asm volatile("s_waitcnt vmcnt(56)" ::: "memory");
        if (c + 2 < RNC) dma(c + 2);
        asm volatile("" ::: "memory");
        f32x16 D[2][2];
#pragma unroll
        for (int jt = 0; jt < 2; ++jt)
#pragma unroll
            for (int it = 0; it < 2; ++it)
#pragma unroll
                for (int g4 = 0; g4 < 4; ++g4) { const size_t off = cbase + (size_t)(32 * it + r32) * 64 + 32 * jt + 8 * g4 + 4 * h2;
                    *(GAS f32x4*)((GAS float*)SALL + off) = (f32x4){St[jt][it][4 * g4], St[jt][it][4 * g4 + 1], St[jt][it][4 * g4 + 2], St[jt][it][4 * g4 + 3]};
                    const f32x4 qv = *(const LAS f32x4*)(bb + 8192 + ((jt * 2 + it) * 4 + g4) * 1024 + lane * 16);
                    D[jt][it][4 * g4] = qv.x; D[jt][it][4 * g4 + 1] = qv.y; D[jt][it][4 * g4 + 2] = qv.z; D[jt][it][4 * g4 + 3] = qv.w; }
#pragma unroll
        for (int kt = 0; kt < 2; ++kt)
#pragma unroll
            for (int s = 0; s < 2; ++s) {
                const bf16x8 b0 = pack8(St[kt][0], s), b1 = pack8(St[kt][1], s);
                const LAS unsigned char* pp = bb + (32 * kt + 16 * s + 4 * h2 + tq) * 128 + (16 * cg + 4 * tp) * 2;
                const bf16x8 a0 = vt_frag(pp, 8 * 128), a1 = vt_frag(pp + 64, 8 * 128);
                D[0][0] = MFMA32(a0, b0, D[0][0]); D[0][1] = MFMA32(a0, b1, D[0][1]); D[1][0] = MFMA32(a1, b0, D[1][0]); D[1][1] = MFMA32(a1, b1, D[1][1]);
            }
        LDS_WAIT(); asm volatile("" ::: "memory");
#pragma unroll
        for (int x = 0; x < 2; ++x)
#pragma unroll
            for (int y = 0; y < 2; ++y) St[x][y] = D[x][y];
    }
    const int b = seq >> 2, h = seq & 3;
    float* so = a.out + O_RWP + ((((size_t)l * NB_P + b) * RH + h) * RN) * RN;
#pragma unroll
    for (int jt = 0; jt < 2; ++jt)
#pragma unroll
        for (int it = 0; it < 2; ++it)
#pragma unroll
            for (int g4 = 0; g4 < 4; ++g4) *(f32x4*)(so + (size_t)(32 * it + r32) * 64 + 32 * jt + 8 * g4 + 4 * h2) = (f32x4){St[jt][it][4 * g4], St[jt][it][4 * g4 + 1], St[jt][it][4 * g4 + 2], St[jt][it][4 * g4 + 3]};
}

__device__ __forceinline__ void phase_rwkvC(const Args& a, int l, LAS unsigned char* lds, int lane, int wave) {
    GAS unsigned char* wsg_ = (GAS unsigned char*)a.ws; asm volatile("" : "+s"(wsg_)); unsigned char* ws = (unsigned char*)wsg_;
    const float* YL = (const float*)(ws + WS_YL); const float* YP = (const float*)(ws + WS_YP); const float* SALL = (const float*)(ws + WS_SALL);
    const float* BONUS = (const float*)(ws + WS_BONUS); const bf16* PROJ = (const bf16*)(ws + WS_PROJ); bf16* ARW = (bf16*)(ws + WS_A4) + 3 * A4_STRIDE;
    const int r32 = lane & 31, h2 = lane >> 5;
    for (int item = blockIdx.x * NWAVES + wave; item < 2048; item += gridDim.x * NWAVES) {
        const int seq = item >> 6, c = item & 63, b = seq >> 2, h = seq & 3;
        const size_t m = (size_t)b * SEQ + (size_t)c * RCL + r32;
        const float* sc = SALL + ((size_t)seq * RNC + c) * 4096;
        f32x16 D[2];
#pragma unroll
        for (int it = 0; it < 2; ++it)
#pragma unroll
            for (int g4 = 0; g4 < 4; ++g4) { const f32x4 yl = *(const f32x4*)(YL + m * DR + h * 64 + 32 * it + 8 * g4 + 4 * h2);
                D[it][4 * g4] = yl.x; D[it][4 * g4 + 1] = yl.y; D[it][4 * g4 + 2] = yl.z; D[it][4 * g4 + 3] = yl.w; }
#pragma unroll
        for (int ks = 0; ks < 4; ++ks) {
            const f32x4* yp = (const f32x4*)(YP + m * DR + h * 64 + 16 * ks + 8 * h2); const f32x4 y0 = yp[0], y1 = yp[1];
            v4u bw; bw.x = pk2(y0.x, y0.y); bw.y = pk2(y0.z, y0.w); bw.z = pk2(y1.x, y1.y); bw.w = pk2(y1.z, y1.w);
            const bf16x8 bfr = __builtin_bit_cast(bf16x8, bw);
#pragma unroll
            for (int it = 0; it < 2; ++it) { const f32x4* sp = (const f32x4*)(sc + (size_t)(32 * it + r32) * 64 + 16 * ks + 8 * h2); const f32x4 s0 = sp[0], s1 = sp[1];
                v4u aw; aw.x = pk2(s0.x, s0.y); aw.y = pk2(s0.z, s0.w); aw.z = pk2(s1.x, s1.y); aw.w = pk2(s1.z, s1.w);
                D[it] = MFMA32(__builtin_bit_cast(bf16x8, aw), bfr, D[it]); }
        }
        f32x4 gg[2][4], gb[2][4], bo[2][4]; v2u zw[2][4];
#pragma unroll
        for (int it = 0; it < 2; ++it)
#pragma unroll
            for (int g4 = 0; g4 < 4; ++g4) { const int i0 = h * 64 + 32 * it + 8 * g4 + 4 * h2;
                gg[it][g4] = *(const f32x4*)(INF(I_GNG) + l * DR + i0); gb[it][g4] = *(const f32x4*)(INF(I_GNB) + l * DR + i0); bo[it][g4] = *(const f32x4*)(BONUS + m * DR + i0);
                zw[it][g4] = *(const v2u*)(PROJ + m * PW + C_ZR + i0); }
        float s1 = 0.f;
#pragma unroll
        for (int it = 0; it < 2; ++it)
#pragma unroll
            for (int q = 0; q < 16; ++q) s1 += D[it][q];
        const float mu = (s1 + SHX(s1, 32)) * (1.f / 64.f);
        float s2 = 0.f;
#pragma unroll
        for (int it = 0; it < 2; ++it)
#pragma unroll
            for (int q = 0; q < 16; ++q) { const float d = D[it][q] - mu; s2 += d * d; }
        const float rs = frsq((s2 + SHX(s2, 32)) * (1.f / 64.f) + GN_EPS);
#pragma unroll
        for (int it = 0; it < 2; ++it)
#pragma unroll
            for (int g4 = 0; g4 < 4; ++g4) { const int i0 = h * 64 + 32 * it + 8 * g4 + 4 * h2;
                const f32x4 G = gg[it][g4], B = gb[it][g4], O = bo[it][g4]; const v2u z = zw[it][g4];
                const float o0 = ((D[it][4 * g4] - mu) * rs * G.x + B.x + O.x) * silu(bflo(z.x)), o1 = ((D[it][4 * g4 + 1] - mu) * rs * G.y + B.y + O.y) * silu(bfhi(z.x)),
                            o2 = ((D[it][4 * g4 + 2] - mu) * rs * G.z + B.z + O.z) * silu(bflo(z.y)), o3 = ((D[it][4 * g4 + 3] - mu) * rs * G.w + B.w + O.w) * silu(bfhi(z.y));
                v2u ob; ob.x = pk2(o0, o1); ob.y = pk2(o2, o3); *(v2u*)(ARW + m * DR + i0) = ob; }
    }
}

template <int KSTEPS>
__device__ __forceinline__ void thin_acc(const bf16* A, int lda, const bf16* Bt, int ldb, int n0, int lane, int wave, LAS unsigned char* lds, pg8::f32x4& acc) {
    const int fr = lane & 15, fq = lane >> 4; constexpr int kper = KSTEPS * 32;
    const bf16* bp = Bt + (size_t)(n0 + fr) * ldb + wave * kper + 8 * fq; const bf16* ap = A + (size_t)fr * lda + wave * kper + 8 * fq;
    bf16x8 bfr[KSTEPS], af[KSTEPS][8];
#pragma unroll
    for (int ks = 0; ks < KSTEPS; ++ks) { bfr[ks] = *(const bf16x8*)(bp + 32 * ks);
#pragma unroll
        for (int rt = 0; rt < 8; ++rt) af[ks][rt] = *(const bf16x8*)(ap + (size_t)rt * 16 * lda + 32 * ks); }
    pg8::f32x4 part[8];
#pragma unroll
    for (int rt = 0; rt < 8; ++rt) part[rt] = (pg8::f32x4){0.f, 0.f, 0.f, 0.f};
#pragma unroll
    for (int ks = 0; ks < KSTEPS; ++ks)
#pragma unroll
        for (int rt = 0; rt < 8; ++rt) part[rt] = __builtin_amdgcn_mfma_f32_16x16x32_bf16(bfr[ks], af[ks][rt], part[rt], 0, 0, 0);
    LAS pg8::f32x4* red = (LAS pg8::f32x4*)lds;
#pragma unroll
    for (int rt = 0; rt < 8; ++rt) red[(wave * 8 + rt) * 64 + lane] = part[rt];
    __syncthreads();
#pragma unroll
    for (int w2 = 0; w2 < 8; ++w2) acc += red[(w2 * 8 + wave) * 64 + lane];
    __syncthreads();
}
__device__ __forceinline__ void thin_merge_sample(const Args& a, int l, LAS unsigned char* lds, int lane, int wave, int unit) {
    GAS unsigned char* wsg_ = (GAS unsigned char*)a.ws; asm volatile("" : "+s"(wsg_)); unsigned char* ws = (unsigned char*)wsg_;
    const int slice = unit & 63, rh = unit >> 6;
    const bf16* A4 = (const bf16*)(ws + WS_A4) + (size_t)(MP + rh * 128) * 256; const bf16* B4 = (const bf16*)(ws + WS_W + (size_t)l * LW_STRIDE + LW_MLA);
    const bf16* PROJ = (const bf16*)(ws + WS_PROJ); bf16* MERGED = (bf16*)(ws + WS_MERGED);
    const int n0 = 16 * slice, fr = lane & 15, fq = lane >> 4;
    const size_t m = (size_t)MP + rh * 128 + wave * 16 + fr; const int n = n0 + 4 * fq;
    v2u gw[3];
#pragma unroll
    for (int br = 0; br < 3; ++br) gw[br] = *(const v2u*)(PROJ + m * PW + C_GM + br * DM + n);
    pg8::f32x4 acc[3];
#pragma unroll
    for (int br = 0; br < 3; ++br) acc[br] = (pg8::f32x4){0.f, 0.f, 0.f, 0.f};
    thin_acc<1>(A4, 256, B4, 256, n0, lane, wave, lds, acc[0]);
    thin_acc<1>(A4 + A4_STRIDE, 256, B4 + (size_t)DM * 256, 256, n0, lane, wave, lds, acc[0]);
    thin_acc<1>(A4 + 2 * A4_STRIDE, 256, B4 + (size_t)2 * DM * 256, 256, n0, lane, wave, lds, acc[1]);
    thin_acc<1>(A4 + 3 * A4_STRIDE, 256, B4 + (size_t)3 * DM * 256, 256, n0, lane, wave, lds, acc[2]);
    pg8::f32x4 o = {0.f, 0.f, 0.f, 0.f};
#pragma unroll
    for (int br = 0; br < 3; ++br) o += acc[br] * (pg8::f32x4){bflo(gw[br].x), bfhi(gw[br].x), bflo(gw[br].y), bfhi(gw[br].y)};
    v2u ob; ob.x = pk2(o[0], o[1]); ob.y = pk2(o[2], o[3]); *(v2u*)(MERGED + m * DM + n) = ob;
}
__device__ __forceinline__ void thin_out_sample(const Args& a, int l, LAS unsigned char* lds, int lane, int wave, int unit) {
    GAS unsigned char* wsg_ = (GAS unsigned char*)a.ws; asm volatile("" : "+s"(wsg_)); unsigned char* ws = (unsigned char*)wsg_;
    const int slice = unit & 63, rh = unit >> 6;
    const bf16* A = (const bf16*)(ws + WS_MERGED) + (size_t)(MP + rh * 128) * DM; const bf16* Bt = (const bf16*)(ws + WS_W + (size_t)l * LW_STRIDE + LW_OUT);
    const float* xin = INF(I_XS); const bf16* xinb = (const bf16*)(ws + WS_X1) + (size_t)MP * DM; bf16* xo = (bf16*)(ws + (l == 0 ? WS_X1 : WS_X2)) + (size_t)MP * DM;
    const float* modg = (const float*)(ws + WS_MOD) + (size_t)l * NCB * 3072 + 2048; const float* badg = INF(I_BADA) + l * 3072 + 2048;
    const int n0 = 16 * slice, fr = lane & 15, fq = lane >> 4;
    const int mm = rh * 128 + wave * 16 + fr, n = n0 + 4 * fq, cb = NB_P + (mm >> 3);
    const pg8::f32x4 gt = *(const pg8::f32x4*)(modg + (size_t)cb * 3072 + n) + *(const pg8::f32x4*)(badg + n);
    pg8::f32x4 xv;
    if (l == 0) xv = *(const pg8::f32x4*)(xin + (size_t)mm * DM + n); else { const v2u q = *(const v2u*)(xinb + (size_t)mm * DM + n); xv = (pg8::f32x4){bflo(q.x), bfhi(q.x), bflo(q.y), bfhi(q.y)}; }
    pg8::f32x4 acc = {0.f, 0.f, 0.f, 0.f};
    thin_acc<4>(A, DM, Bt, DM, n0, lane, wave, lds, acc);
    { const pg8::f32x4 o = xv + gt * acc; v2u ob; ob.x = pk2(o[0], o[1]); ob.y = pk2(o[2], o[3]); *(v2u*)(xo + (size_t)mm * DM + n) = ob; }
}

constexpr int UT_LDS = 29184;
__device__ __forceinline__ void phase_rwkvA_ut(const Args& a, LAS unsigned char* lds, int lane, int wave) {
    if (wave >= 4) return;
    GAS unsigned char* wsg_ = (GAS unsigned char*)a.ws; asm volatile("" : "+s"(wsg_)); unsigned char* ws = (unsigned char*)wsg_;
    const float* SC = (const float*)(ws + WS_SC); float* YL = (float*)(ws + WS_YL); float* YP = (float*)(ws + WS_YP); float* QC = (float*)(ws + WS_QC); bf16* PC = (bf16*)(ws + WS_PC);
    LAS unsigned char* L = lds + wave * UT_LDS;
    LAS unsigned char* IKa = L, *IB = L + 4096, *IKt = L + 8192, *IR = L + 12288, *IV = L + 16384, *IW = L + 20480, *IU = L + 24576;
    LAS float* MB = (LAS float*)(L + 0); LAS float* MVI = (LAS float*)(L + 20480); LAS float* GC = (LAS float*)(L + 28672);
    const int r32 = lane & 31, h2 = lane >> 5, g = lane >> 4, li = lane & 15, cg = g & 1, tq = li >> 2, tp = li & 3;
    for (int ch = (int)blockIdx.x * 4 + wave; ch < 32 * RNC; ch += (int)gridDim.x * 4) {
        const int seq = ch / RNC, c = ch - seq * RNC, b = seq >> 2, h = seq & 3;
        const size_t m0 = (size_t)b * SEQ + (size_t)c * RCL;
        float ka[32];
        { const float* sp = SC + m0 * 6 * DR + h * 64 + lane; float Gt[32], tmp[32];
#pragma unroll
          for (int t = 0; t < 32; ++t) Gt[t] = sp[(size_t)t * 6 * DR + DR];
#pragma unroll
          for (int t = 0; t < 32; ++t) tmp[t] = sp[(size_t)t * 6 * DR + 4 * DR];
          { float G = 1.f;
#pragma unroll
            for (int t = 0; t < 32; ++t) { ka[t] = tmp[t] * G; G *= Gt[t]; Gt[t] = G; *(LAS bf16*)(IKa + t * 128 + lane * 2) = (bf16)f2bf(ka[t]); } }
#pragma unroll
          for (int t = 0; t < 32; ++t) tmp[t] = sp[(size_t)t * 6 * DR];
#pragma unroll
          for (int t = 0; t < 32; ++t) *(LAS bf16*)(IR + t * 128 + lane * 2) = (bf16)f2bf(tmp[t] * Gt[t]);
#pragma unroll
          for (int t = 0; t < 32; ++t) tmp[t] = sp[(size_t)t * 6 * DR + 3 * DR];
#pragma unroll
          for (int t = 0; t < 32; ++t) *(LAS bf16*)(IV + t * 128 + lane * 2) = (bf16)f2bf(tmp[t]);
          GC[lane] = Gt[31];
#pragma unroll
          for (int t = 0; t < 32; ++t) Gt[t] = frcp(Gt[t]);
#pragma unroll
          for (int t = 0; t < 32; ++t) tmp[t] = sp[(size_t)t * 6 * DR + 5 * DR];
#pragma unroll
          for (int t = 0; t < 32; ++t) *(LAS bf16*)(IB + t * 128 + lane * 2) = (bf16)f2bf(tmp[t] * Gt[t]);
#pragma unroll
          for (int t = 0; t < 32; ++t) tmp[t] = sp[(size_t)t * 6 * DR + 2 * DR];
#pragma unroll
          for (int t = 0; t < 32; ++t) *(LAS bf16*)(IKt + t * 128 + lane * 2) = (bf16)f2bf(tmp[t] * Gt[t]);
        }
        LDS_WAIT(); asm volatile("" ::: "memory");
        f32x16 MbT, MkT, AbT, AkT;
#pragma unroll
        for (int q = 0; q < 16; ++q) { MbT[q] = 0.f; MkT[q] = 0.f; AbT[q] = 0.f; AkT[q] = 0.f; }
#pragma unroll
        for (int ks = 0; ks < 4; ++ks) { const int off = r32 * 128 + (16 * ks + 8 * h2) * 2;
            const bf16x8 fb = *(const LAS bf16x8*)(IB + off), fk = *(const LAS bf16x8*)(IKt + off), fa = *(const LAS bf16x8*)(IKa + off), fr_ = *(const LAS bf16x8*)(IR + off);
            MbT = MFMA32(fb, fa, MbT); MkT = MFMA32(fk, fa, MkT); AbT = MFMA32(fb, fr_, AbT); AkT = MFMA32(fk, fr_, AkT); }
#pragma unroll
        for (int q = 0; q < 16; ++q) { const int s = (q & 3) + 8 * (q >> 2) + 4 * h2;
            if (s >= r32) { MbT[q] = 0.f; MkT[q] = 0.f; } if (s > r32) { AbT[q] = 0.f; AkT[q] = 0.f; } }
        LDS_WAIT(); asm volatile("" ::: "memory");
#pragma unroll
        for (int g4 = 0; g4 < 4; ++g4) *(LAS f32x4*)(MB + r32 * 32 + 8 * g4 + 4 * h2) = (f32x4){MbT[4 * g4], MbT[4 * g4 + 1], MbT[4 * g4 + 2], MbT[4 * g4 + 3]};
        { f32x16 mv[2];
#pragma unroll
          for (int it = 0; it < 2; ++it)
#pragma unroll
              for (int q = 0; q < 16; ++q) mv[it][q] = 0.f;
#pragma unroll
          for (int ks = 0; ks < 2; ++ks) { const bf16x8 pb = pack8(MkT, ks);
#pragma unroll
              for (int it = 0; it < 2; ++it) mv[it] = MFMA32(vt_frag(IV + (16 * ks + 4 * h2 + tq) * 128 + (32 * it + 16 * cg + 4 * tp) * 2, 8 * 128), pb, mv[it]); }
#pragma unroll
          for (int it = 0; it < 2; ++it)
#pragma unroll
              for (int g4 = 0; g4 < 4; ++g4) *(LAS f32x4*)(MVI + r32 * 64 + 32 * it + 8 * g4 + 4 * h2) = (f32x4){mv[it][4 * g4], mv[it][4 * g4 + 1], mv[it][4 * g4 + 2], mv[it][4 * g4 + 3]}; }
        LDS_WAIT(); asm volatile("" ::: "memory");
        { float x1[32], x2[32];
#pragma unroll
          for (int t = 0; t < 32; ++t) x2[t] = -MVI[t * 64 + lane];
          LDS_WAIT(); asm volatile("" ::: "memory");
#pragma unroll
          for (int t = 0; t < 32; ++t) { float a1 = -ka[t], a2 = x2[t];
#pragma unroll
              for (int s4 = 0; s4 < 32; s4 += 4) { if (s4 < t) { const f32x4 mq = *(const LAS f32x4*)(MB + t * 32 + s4);
                  a1 -= mq.x * x1[s4]; a2 -= mq.x * x2[s4];
                  if (s4 + 1 < t) { a1 -= mq.y * x1[s4 + 1]; a2 -= mq.y * x2[s4 + 1]; }
                  if (s4 + 2 < t) { a1 -= mq.z * x1[s4 + 2]; a2 -= mq.z * x2[s4 + 2]; }
                  if (s4 + 3 < t) { a1 -= mq.w * x1[s4 + 3]; a2 -= mq.w * x2[s4 + 3]; } } }
              x1[t] = a1; x2[t] = a2;
              *(LAS bf16*)(IW + t * 128 + lane * 2) = (bf16)f2bf(a1); *(LAS bf16*)(IU + t * 128 + lane * 2) = (bf16)f2bf(a2); } }
        LDS_WAIT(); asm volatile("" ::: "memory");
        const size_t cbase = ((size_t)seq * RNC + c) * 4096;
#pragma unroll
        for (int jt = 0; jt < 2; ++jt) {
            f32x16 pt[2], qt[2];
#pragma unroll
            for (int x = 0; x < 2; ++x)
#pragma unroll
                for (int q = 0; q < 16; ++q) { pt[x][q] = 0.f; qt[x][q] = 0.f; }
#pragma unroll
            for (int ks = 0; ks < 2; ++ks) { const int ro = (16 * ks + 4 * h2 + tq) * 128, co = (16 * cg + 4 * tp) * 2;
                const bf16x8 ab = vt_frag(IB + ro + 64 * jt + co, 8 * 128), ak = vt_frag(IKt + ro + 64 * jt + co, 8 * 128);
#pragma unroll
                for (int x = 0; x < 2; ++x) { const bf16x8 bw = vt_frag(IW + ro + 64 * x + co, 8 * 128), bu = vt_frag(IU + ro + 64 * x + co, 8 * 128), bv = vt_frag(IV + ro + 64 * x + co, 8 * 128);
                    pt[x] = MFMA32(ab, bw, pt[x]); qt[x] = MFMA32(ab, bu, qt[x]); qt[x] = MFMA32(ak, bv, qt[x]); } }
#pragma unroll
            for (int g4 = 0; g4 < 4; ++g4) { const int j0 = 32 * jt + 8 * g4 + 4 * h2; const f32x4 gc = *(const LAS f32x4*)(GC + j0);
#pragma unroll
                for (int x = 0; x < 2; ++x) { const int kcol = 32 * x + r32;
                    f32x4 pv = {pt[x][4 * g4], pt[x][4 * g4 + 1], pt[x][4 * g4 + 2], pt[x][4 * g4 + 3]};
#pragma unroll
                    for (int e = 0; e < 4; ++e) if (j0 + e == kcol) pv[e] += 1.f;
                    pv = pv * gc; v2u pw; pw.x = pk2(pv.x, pv.y); pw.y = pk2(pv.z, pv.w);
                    *(v2u*)(PC + cbase + (size_t)kcol * 64 + j0) = pw;
                    *(f32x4*)(QC + cbase + (size_t)kcol * 64 + j0) = (f32x4){qt[x][4 * g4], qt[x][4 * g4 + 1], qt[x][4 * g4 + 2], qt[x][4 * g4 + 3]} * gc; } }
        }
        { f32x16 yp[2], yl[2];
#pragma unroll
          for (int x = 0; x < 2; ++x)
#pragma unroll
              for (int q = 0; q < 16; ++q) { yp[x][q] = 0.f; yl[x][q] = 0.f; }
#pragma unroll
          for (int ks = 0; ks < 2; ++ks) { const bf16x8 pab = pack8(AbT, ks), pak = pack8(AkT, ks); const int ro = (16 * ks + 4 * h2 + tq) * 128, co = (16 * cg + 4 * tp) * 2;
#pragma unroll
              for (int x = 0; x < 2; ++x) { yp[x] = MFMA32(vt_frag(IW + ro + 64 * x + co, 8 * 128), pab, yp[x]);
                  yl[x] = MFMA32(vt_frag(IU + ro + 64 * x + co, 8 * 128), pab, yl[x]); yl[x] = MFMA32(vt_frag(IV + ro + 64 * x + co, 8 * 128), pak, yl[x]); } }
          const size_t mrow = (m0 + r32) * DR + h * 64;
#pragma unroll
          for (int x = 0; x < 2; ++x)
#pragma unroll
              for (int g4 = 0; g4 < 4; ++g4) { const int j0 = 32 * x + 8 * g4 + 4 * h2; const v2u rw = *(const LAS v2u*)(IR + r32 * 128 + j0 * 2);
                  *(f32x4*)(YP + mrow + j0) = (f32x4){yp[x][4 * g4] + bflo(rw.x), yp[x][4 * g4 + 1] + bfhi(rw.x), yp[x][4 * g4 + 2] + bflo(rw.y), yp[x][4 * g4 + 3] + bfhi(rw.y)};
                  *(f32x4*)(YL + mrow + j0) = (f32x4){yl[x][4 * g4], yl[x][4 * g4 + 1], yl[x][4 * g4 + 2], yl[x][4 * g4 + 3]}; } }
        LDS_WAIT(); asm volatile("" ::: "memory");
    }
}

constexpr int SA_RS = 592;
constexpr int SA_BUF = 64 * SA_RS;
__device__ __forceinline__ void phase_attn_sample(const Args& a, int l, LAS unsigned char* lds, int tid, int lane, int wave, unsigned* sctr, volatile LAS unsigned* qslot) {
    GAS unsigned char* wsg_ = (GAS unsigned char*)a.ws; asm volatile("" : "+s"(wsg_)); unsigned char* ws = (unsigned char*)wsg_;
    const bf16* QLT = (const bf16*)(ws + WS_QLAT); const bf16* CKVn = (const bf16*)(ws + WS_CKV) + (size_t)MP * KVL; const bf16* KPEn = (const bf16*)(ws + WS_KPE) + (size_t)MP * QKR;
    float* PO = (float*)(ws + WS_PO); float* PM = (float*)(ws + WS_PM); float* PL = (float*)(ws + WS_PL);
    const float* cckv = INF(I_CCKV) + (size_t)l * NPOOL * PAGE * KVL; const float* ckpe = INF(I_CKPE) + (size_t)l * NPOOL * PAGE * QKR; const int* pt = (const int*)a.in[I_PT];
    const int r32 = lane & 31, h2 = lane >> 5, rt = wave & 1, ch = (wave >> 1) & 1, kp = wave >> 2;
    const int g = lane >> 4, li = lane & 15, cg = g & 1, tq = li >> 2, tp = li & 3;
    for (;;) {
        if (tid == 0) *qslot = __hip_atomic_fetch_add(sctr, 1u, __ATOMIC_RELAXED, __HIP_MEMORY_SCOPE_AGENT);
        __syncthreads();
        const int unit = (int)*qslot;
        __syncthreads();
        if (unit >= NB_S * 8) break;
        const int b = unit >> 3, split = unit & 7;
        LAS unsigned char* xbuf = lds + 2 * SA_BUF;
        bf16x8 Bq[9];
#pragma unroll
        for (int ks = 0; ks < 9; ++ks) Bq[ks] = *(const bf16x8*)(QLT + ((size_t)b * 64 + rt * 32 + r32) * 288 + 16 * (9 * ch + ks) + 8 * h2);
        f32x16 O[4];
#pragma unroll
        for (int ct = 0; ct < 4; ++ct)
#pragma unroll
            for (int i = 0; i < 16; ++i) O[ct][i] = 0.f;
        float mrun = -INFINITY, lrun = 0.f;
        constexpr int NP = 32;
        const bool has_new = (split == 7);
        const int mypool = pt[b * NPAGES + split * 16 + (lane & 15)];
        const unsigned vo_c = (unsigned)(tid >> 6) * (KVL * 4u) + (unsigned)(tid & 63) * 16u, vo_p = (unsigned)(tid >> 3) * (QKR * 4u) + (unsigned)(tid & 7) * 16u;
        const int so_c = (tid >> 6) * SA_RS + (tid & 63) * 8, so_p = (tid >> 3) * SA_RS + 512 + (tid & 7) * 8;
        f32x4 gA[8], pA, gB[8], pB;
        auto load_tile = [&](int j, f32x4 (&gc)[8], f32x4& gp) {
            const int pool = __builtin_amdgcn_readlane(mypool, j >> 1);
            const char* src = (const char*)(cckv + ((size_t)pool * PAGE + (j & 1) * 64) * KVL); const char* srp = (const char*)(ckpe + ((size_t)pool * PAGE + (j & 1) * 64) * QKR);
#pragma unroll
            for (int i = 0; i < 8; ++i) gc[i] = __builtin_nontemporal_load((const f32x4*)(src + (vo_c + (unsigned)i * (8u * KVL * 4u))));
            gp = __builtin_nontemporal_load((const f32x4*)(srp + vo_p));
        };
        auto store_tile = [&](LAS unsigned char* buf, const f32x4 (&gc)[8], const f32x4& gp) {
            LAS unsigned char* d = buf + so_c;
#pragma unroll
            for (int i = 0; i < 8; ++i) { v2u w; w.x = pk2(gc[i].x, gc[i].y); w.y = pk2(gc[i].z, gc[i].w); *(LAS v2u*)(d + i * (8 * SA_RS)) = w; }
            { v2u w; w.x = pk2(gp.x, gp.y); w.y = pk2(gp.z, gp.w); *(LAS v2u*)(buf + so_p) = w; }
        };
        auto store_new = [&](LAS unsigned char* buf) {
            for (int q = tid; q < 32 * 36; q += NTHR) { const int key = q / 36, c16 = q - key * 36; v4u w = {0u, 0u, 0u, 0u};
                if (key < 8) w = (c16 < 32) ? *(const v4u*)(CKVn + ((size_t)b * 8 + key) * KVL + c16 * 8) : *(const v4u*)(KPEn + ((size_t)b * 8 + key) * QKR + (c16 - 32) * 8);
                *(LAS v4u*)(buf + key * SA_RS + c16 * 16) = w; }
        };
        auto compute = [&](const LAS unsigned char* tb, bool isnew) {
            f32x16 S0;
#pragma unroll
            for (int i = 0; i < 16; ++i) S0[i] = 0.f;
            const LAS unsigned char* kb = tb + r32 * SA_RS + h2 * 16 + ch * (9 * 32);
#pragma unroll
            for (int ks = 0; ks < 9; ++ks) { const bf16x8 k0 = *(const LAS bf16x8*)(kb + ks * 32); S0 = MFMA32(k0, Bq[ks], S0); }
            {   LAS f32x4* xw = (LAS f32x4*)(xbuf + wave * 4096) + lane; const LAS f32x4* xr = (const LAS f32x4*)(xbuf + (wave ^ 2) * 4096) + lane;
#pragma unroll
                for (int q4 = 0; q4 < 4; ++q4) xw[q4 * 64] = (f32x4){S0[4 * q4], S0[4 * q4 + 1], S0[4 * q4 + 2], S0[4 * q4 + 3]};
                LDS_WAIT(); __builtin_amdgcn_s_barrier(); asm volatile("" ::: "memory");
#pragma unroll
                for (int q4 = 0; q4 < 4; ++q4) { const f32x4 o = xr[q4 * 64]; S0[4 * q4] += o.x; S0[4 * q4 + 1] += o.y; S0[4 * q4 + 2] += o.z; S0[4 * q4 + 3] += o.w; }
            }
            if (isnew) {
                const int tq_ = (rt * 32 + r32) >> 3;
#pragma unroll
                for (int i = 0; i < 16; ++i) { const int key = 32 * kp + 4 * h2 + (i & 3) + 8 * (i >> 2); if (key > tq_) S0[i] = -INFINITY; }
            }
            float mx = S0[0];
#pragma unroll
            for (int i = 1; i < 16; ++i) mx = fmaxf(mx, S0[i]);
            mx = fmaxf(mx, SHX(mx, 32));
            const float mnew = fmaxf(mrun, mx);
            if (__builtin_amdgcn_ballot_w64(mnew > mrun)) {
                const float alpha = __builtin_amdgcn_exp2f(mrun - mnew); mrun = mnew; lrun *= alpha;
#pragma unroll
                for (int ct = 0; ct < 4; ++ct)
#pragma unroll
                    for (int i = 0; i < 16; ++i) O[ct][i] *= alpha;
            }
            float ps = 0.f;
#pragma unroll
            for (int i = 0; i < 16; ++i) { S0[i] = __builtin_amdgcn_exp2f(S0[i] - mrun); ps += S0[i]; }
            lrun += ps;
            const LAS unsigned char* vbase = tb + (4 * h2 + tq) * SA_RS + (ch * 128 + 16 * cg + 4 * tp) * 2;
#pragma unroll
            for (int s = 0; s < 2; ++s) {
                const bf16x8 pb = pack8(S0, s);
                const LAS unsigned char* vp = vbase + (16 * s) * SA_RS;
                bf16x8 va = vt_frag(vp, 8 * SA_RS), vb_ = vt_frag(vp + 64, 8 * SA_RS), vc = vt_frag(vp + 128, 8 * SA_RS), vd = vt_frag(vp + 192, 8 * SA_RS);
                asm volatile("" : "+v"(va), "+v"(vb_), "+v"(vc), "+v"(vd));
                O[0] = MFMA32(va, pb, O[0]); O[1] = MFMA32(vb_, pb, O[1]); O[2] = MFMA32(vc, pb, O[2]); O[3] = MFMA32(vd, pb, O[3]);
            }
        };
#define SA_BAR() do { LDS_WAIT(); __builtin_amdgcn_s_barrier(); asm volatile("" ::: "memory"); } while (0)
        load_tile(0, gA, pA); load_tile(1, gB, pB); store_tile(lds, gA, pA); SA_BAR();
        for (int j = 0; j < NP - 2; j += 2) {
            load_tile(j + 2, gA, pA);
            compute(lds + kp * 32 * SA_RS, false);
            store_tile(lds + SA_BUF, gB, pB);
            SA_BAR();
            load_tile(j + 3, gB, pB);
            compute(lds + SA_BUF + kp * 32 * SA_RS, false);
            store_tile(lds, gA, pA);
            SA_BAR();
        }
        compute(lds + kp * 32 * SA_RS, false);
        store_tile(lds + SA_BUF, gB, pB);
        SA_BAR();
        compute(lds + SA_BUF + kp * 32 * SA_RS, false);
        if (has_new) store_new(lds);
        __syncthreads();
        if (has_new) compute(lds + kp * 32 * SA_RS, true);
        __syncthreads();
        const float ltot = lrun + SHX(lrun, 32);
        LAS float* xb = (LAS float*)(lds + (wave & 3) * 17408);
        if (kp == 1) {
#pragma unroll
            for (int ct = 0; ct < 4; ++ct)
#pragma unroll
                for (int i = 0; i < 16; ++i) xb[(ct * 16 + i) * 64 + lane] = O[ct][i];
            xb[4096 + lane] = mrun; xb[4160 + lane] = ltot;
        }
        __syncthreads();
        if (kp == 0) {
            const float m1 = xb[4096 + lane], l1 = xb[4160 + lane];
            const float mm = fmaxf(mrun, m1); const float a0 = __builtin_amdgcn_exp2f(mrun - mm), a1 = __builtin_amdgcn_exp2f(m1 - mm);
            const int row = rt * 32 + r32; const size_t pbase = ((size_t)b * 8 + split) * 64 + row;
#pragma unroll
            for (int ct = 0; ct < 4; ++ct)
#pragma unroll
                for (int g4 = 0; g4 < 4; ++g4) { const int c0 = ch * 128 + ct * 32 + 8 * g4 + 4 * h2;
                    f32x4 o;
#pragma unroll
                    for (int e = 0; e < 4; ++e) o[e] = O[ct][4 * g4 + e] * a0 + xb[(ct * 16 + 4 * g4 + e) * 64 + lane] * a1;
                    *(f32x4*)(PO + pbase * 256 + c0) = o; }
            if (ch == 0 && h2 == 0) { PM[pbase] = mm; PL[pbase] = ltot * a0 + l1 * a1; }
        }
        __syncthreads();
    }
}

__device__ __forceinline__ void phase_combine(const Args& a, int l, LAS unsigned char* lds, int lane, int wave) {
    GAS unsigned char* wsg_ = (GAS unsigned char*)a.ws; asm volatile("" : "+s"(wsg_)); unsigned char* ws = (unsigned char*)wsg_;
    const int gw = blockIdx.x * NWAVES + wave, NGW = gridDim.x * NWAVES;
    const float* PO = (const float*)(ws + WS_PO); const float* PM = (const float*)(ws + WS_PM); const float* PL = (const float*)(ws + WS_PL);
    const float* wuv = INF(I_WUV) + (size_t)l * KVL * 512; const bf16* PROJ = (const bf16*)(ws + WS_PROJ); bf16* AMLA = (bf16*)(ws + WS_A4);
    LAS float* ol = (LAS float*)(lds + 65536 + wave * 1024);
    for (int task = gw; task < MS * NH; task += NGW) {
        const int mm = task >> 3, h = task & 7, b = mm >> 3, t = mm & 7, r = t * 8 + h;
        float ms[8], mmax = -INFINITY;
#pragma unroll
        for (int s = 0; s < 8; ++s) { ms[s] = PM[((size_t)b * 8 + s) * 64 + r]; mmax = fmaxf(mmax, ms[s]); }
        float L = 0.f, wsc[8];
#pragma unroll
        for (int s = 0; s < 8; ++s) { wsc[s] = __builtin_amdgcn_exp2f(ms[s] - mmax); L += wsc[s] * PL[((size_t)b * 8 + s) * 64 + r]; }
        const float invL = frcp(L);
#pragma unroll
        for (int ci = 0; ci < 4; ++ci) { const int c = lane + 64 * ci; float acc = 0.f;
#pragma unroll
            for (int s = 0; s < 8; ++s) acc += wsc[s] * PO[(((size_t)b * 8 + s) * 64 + r) * 256 + c];
            ol[c] = acc * invL; }
        LDS_WAIT(); asm volatile("" ::: "memory");
        float o = 0.f;
#pragma unroll 8
        for (int c = 0; c < 256; ++c) o += ol[c] * wuv[((size_t)c * NH + h) * 64 + lane];
        const size_t m = (size_t)MP + mm;
        const float z = bf1(PROJ[m * PW + C_ZM + h * 64 + lane]);
        AMLA[(size_t)(h >> 2) * A4_STRIDE + m * 256 + (h & 3) * 64 + lane] = (bf16)f2bf(o * silu(z));
        LDS_WAIT(); asm volatile("" ::: "memory");
    }
}

constexpr int SCAN_TS = 32;
__device__ __forceinline__ void scan_sample(const Args& a, int l, LAS unsigned char* lds, int lane, int sidx) {
    GAS unsigned char* wsg_ = (GAS unsigned char*)a.ws; asm volatile("" : "+s"(wsg_)); unsigned char* ws = (unsigned char*)wsg_;
    const float* SC = (const float*)(ws + WS_SC); const float* BONUS = (const float*)(ws + WS_BONUS); const bf16* PROJ = (const bf16*)(ws + WS_PROJ); bf16* ARW = (bf16*)(ws + WS_A4) + 3 * A4_STRIDE;
    LAS float* st = (LAS float*)lds;
    { const int seq = NB_P * RH + sidx;
        const bool samp = seq >= NB_P * RH; const int sb = samp ? seq - NB_P * RH : seq; const int b = sb >> 2, h = sb & 3;
        const int T = samp ? TSMP : SEQ; const size_t m0 = samp ? (size_t)MP + b * TSMP : (size_t)b * SEQ;
        float S[64];
        if (samp) { const f32x4* s0 = (const f32x4*)(INF(I_SRWKV) + ((((size_t)l * NB_S + b) * RH + h) * RN + lane) * RN);
#pragma unroll
            for (int j = 0; j < 16; ++j) { const f32x4 v = s0[j]; S[4 * j] = v.x; S[4 * j + 1] = v.y; S[4 * j + 2] = v.z; S[4 * j + 3] = v.w; } }
        else {
#pragma unroll
            for (int j = 0; j < 64; ++j) S[j] = 0.f; }
        const float gng = INF(I_GNG)[l * DR + h * 64 + lane], gnb = INF(I_GNB)[l * DR + h * 64 + lane];
        for (int t0 = 0; t0 < T; t0 += SCAN_TS) {
            const int nt = (T - t0) < SCAN_TS ? (T - t0) : SCAN_TS;
            for (int tt = 0; tt < nt; ++tt) { const float* sc = SC + (m0 + t0 + tt) * 6 * DR + h * 64 + lane; LAS float* d = st + tt * 320 + lane;
                d[0] = sc[0]; d[64] = sc[DR]; d[128] = sc[2 * DR]; d[192] = sc[4 * DR]; d[256] = sc[5 * DR]; }
            LDS_WAIT(); asm volatile("" ::: "memory");
            float vn = SC[(m0 + t0) * 6 * DR + 3 * DR + h * 64 + lane], bon = BONUS[(m0 + t0) * DR + h * 64 + lane], zn = bf1(PROJ[(m0 + t0) * PW + C_ZR + h * 64 + lane]);
            for (int tt = 0; tt < nt; ++tt) {
                const size_t m = m0 + t0 + tt;
                const float v = vn, bo_c = bon, z_c = zn;
                if (tt + 1 < nt) { vn = SC[(m + 1) * 6 * DR + 3 * DR + h * 64 + lane]; bon = BONUS[(m + 1) * DR + h * 64 + lane]; zn = bf1(PROJ[(m + 1) * PW + C_ZR + h * 64 + lane]); }
                const LAS f32x4* vr = (const LAS f32x4*)(st + tt * 320); const LAS f32x4* vw = vr + 16; const LAS f32x4* vk = vr + 32; const LAS f32x4* vkk = vr + 48; const LAS f32x4* vb = vr + 64;
                float sa = 0.f;
#pragma unroll
                for (int j = 0; j < 16; ++j) { const f32x4 q = vkk[j]; sa -= S[4 * j] * q.x + S[4 * j + 1] * q.y + S[4 * j + 2] * q.z + S[4 * j + 3] * q.w; }
                float y = 0.f;
#pragma unroll
                for (int j = 0; j < 16; ++j) { const f32x4 w = vw[j], bb = vb[j], kq = vk[j], rq = vr[j];
                    S[4 * j] = S[4 * j] * w.x + sa * bb.x + v * kq.x; S[4 * j + 1] = S[4 * j + 1] * w.y + sa * bb.y + v * kq.y;
                    S[4 * j + 2] = S[4 * j + 2] * w.z + sa * bb.z + v * kq.z; S[4 * j + 3] = S[4 * j + 3] * w.w + sa * bb.w + v * kq.w;
                    y += S[4 * j] * rq.x + S[4 * j + 1] * rq.y + S[4 * j + 2] * rq.z + S[4 * j + 3] * rq.w; }
                const float mu = wave_sum(y) * (1.f / 64.f); const float d = y - mu; const float var = wave_sum(d * d) * (1.f / 64.f);
                const float yn = d * (frsq(var + GN_EPS)) * gng + gnb;
                const float o = yn + bo_c;
                const float z = z_c;
                ARW[m * DR + h * 64 + lane] = (bf16)f2bf(o * silu(z));
            }
            LDS_WAIT(); asm volatile("" ::: "memory");
        }
        float* so = samp ? a.out + O_RWS + ((((size_t)l * NB_S + b) * RH + h) * RN + lane) * RN : a.out + O_RWP + ((((size_t)l * NB_P + b) * RH + h) * RN + lane) * RN;
#pragma unroll
        for (int j = 0; j < 16; ++j) *(f32x4*)(so + 4 * j) = (f32x4){S[4 * j], S[4 * j + 1], S[4 * j + 2], S[4 * j + 3]};
    }
}

__device__ __forceinline__ void phase_final(const Args& a, int lane, int wave) {
    GAS unsigned char* wsg_ = (GAS unsigned char*)a.ws; asm volatile("" : "+s"(wsg_)); unsigned char* ws = (unsigned char*)wsg_;
    const int gw = blockIdx.x * NWAVES + wave, NGW = gridDim.x * NWAVES;
    const bf16* X = (const bf16*)(ws + WS_X2); const float* fg = INF(I_FNG);
    f32x4 g[4];
#pragma unroll
    for (int j = 0; j < 4; ++j) g[j] = *(const f32x4*)(fg + 4 * lane + 256 * j);
    for (int grp = gw; grp < MT / 8; grp += NGW) {
        const int mbase = grp * 8;
        v2u nr[4];
        auto load_row = [&](int mr) { const v2u* xr = (const v2u*)(X + (size_t)mr * DM) + lane;
#pragma unroll
            for (int j = 0; j < 4; ++j) nr[j] = xr[64 * j]; };
        load_row(mbase);
        for (int r = 0; r < 8; ++r) {
            const int m = mbase + r;
            f32x4 v[4];
#pragma unroll
            for (int j = 0; j < 4; ++j) v[j] = (f32x4){bflo(nr[j].x), bfhi(nr[j].x), bflo(nr[j].y), bfhi(nr[j].y)};
            if (r + 1 < 8) load_row(m + 1);
            float ss = 0.f;
#pragma unroll
            for (int j = 0; j < 4; ++j) ss += (v[j].x * v[j].x + v[j].y * v[j].y) + (v[j].z * v[j].z + v[j].w * v[j].w);
            const float rs = frsq(wave_sum(ss) * (1.f / DM) + RMS_EPS);
            float* o = (m < MP) ? a.out + O_YP + (size_t)m * DM : a.out + O_YS + (size_t)(m - MP) * DM;
#pragma unroll
            for (int j = 0; j < 4; ++j) *(f32x4*)(o + 4 * lane + 256 * j) = v[j] * rs * g[j];
        }
    }
}

#if defined(ONLY)
#define PH_EN(k) (ONLY == (k))
#elif defined(SKIPA)
#define PH_EN(k) ((k) != SKIPA && (k) != SKIPB && (k) != SKIPC)
#else
#define PH_EN(k) 1
#endif
#ifndef PROBE_DBL
#define PROBE_DBL 0
#endif
#define REP(k) for (int rep_ = 0; rep_ < (((PROBE_DBL >> (k)) & 1) ? 2 : 1); ++rep_)
constexpr int NS_FIRST = 128;
constexpr int PH_PER_LAYER = 8, N_PHASES = 1 + DEPTH * PH_PER_LAYER + 1;
__global__ void __launch_bounds__(NTHR, 2) fwd(Args a) {
    extern __shared__ __attribute__((aligned(16))) unsigned char lds_raw[];
    LAS unsigned char* lds = (LAS unsigned char*)lds_raw;
    const int wave0 = __builtin_amdgcn_readfirstlane(threadIdx.x >> 6);
    int tid = threadIdx.x, lane = tid & 63, wave = wave0;
#define RETID() do { int w_ = wave0, l_; asm volatile("" : "+s"(w_)); asm volatile("v_mbcnt_lo_u32_b32 %0, -1, 0\n\tv_mbcnt_hi_u32_b32 %0, -1, %0" : "=v"(l_)); wave = w_; lane = l_; tid = wave * 64 + lane; } while (0)
    volatile LAS unsigned* MISC = (volatile LAS unsigned*)(lds + MISC_OFF);
    for (int u = tid; u < (LDS_BYTES - LDSCTL_OFF) / 4; u += NTHR) ((LAS unsigned*)(lds + LDSCTL_OFF))[u] = 0u;
    __syncthreads();
    const bool fused = (a.ph_hi - a.ph_lo) > 1;
    XcdBarrier bar; bar.bar = (unsigned*)(a.ws + WS_CTL) + CW_BAR; bar.x = 0; bar.st = nullptr;
    if (fused) bar = xcd_barrier_post((unsigned*)(a.ws + WS_CTL) + CW_BAR, MISC + 8);
    const int lo = a.ph_lo, hi = a.ph_hi;
#define IN(k) (lo <= (k) && (k) < hi)
#define SEAM(k) do { if (IN(k) && IN((k) + 1)) { xcd_barrier(bar); if ((PROBE_DBL >> 20) & 1) xcd_barrier(bar); } } while (0)
    if (IN(0)) {
#if PH_EN(0)
 RETID(); phase_prologue(a, lds, tid, lane, wave);
#endif
 }
    SEAM(0);
    for (int l = 0; l < DEPTH; ++l) {
        const int pb = 1 + l * PH_PER_LAYER;
        if (IN(pb + 0)) {
#if PH_EN(1)
 REP(1) { RETID(); phase_modulate(a, l, lane, wave); }
#endif
 }
        SEAM(pb + 0);
        if (IN(pb + 1) && PH_EN(2)) REP(2) {
            GAS unsigned char* wsg_ = (GAS unsigned char*)a.ws; asm volatile("" : "+s"(wsg_)); unsigned char* ws = (unsigned char*)wsg_;     unsigned char* wl = ws + WS_W + (size_t)l * LW_STRIDE;
            pg8::Gemm g{(const bf16*)(ws + WS_U), (const bf16*)(wl + LW_IN), MT, NPROJ, DM}; pg8::StaticOrder S; S.init(MT, NPROJ, gridDim.x, blockIdx.x);
            if ((PROBE_DBL >> 27) & 1) { pg8::EpiProj E0{(bf16*)(ws + WS_QA), (bf16*)(ws + WS_PROJ), 1}; pg8::gemm_phase<pg8::EpiProj, pg8::StaticOrder, true, true>(lds + RING_OFF, g, S, E0, wave0); }
            pg8::EpiProj E{(bf16*)(ws + WS_QA), (bf16*)(ws + WS_PROJ), 0};
            pg8::gemm_phase<pg8::EpiProj, pg8::StaticOrder, true, true>(lds + RING_OFF, g, S, E, wave0);
            if (l == 0 && blockIdx.x >= 154) { RETID(); convert_weights(a, ws, lds, lane, wave, 1, ((int)blockIdx.x - 154) * NWAVES + wave, ((int)gridDim.x - 154) * NWAVES); }
        }
        SEAM(pb + 1);
        if (IN(pb + 2)) {
#if PH_EN(3)
 REP(3) { RETID(); phase_post(a, l, lds, tid, lane, wave); }
#endif
 }
        SEAM(pb + 2);
        if (IN(pb + 3) && PH_EN(4)) REP(4) {
            GAS unsigned char* wsg_ = (GAS unsigned char*)a.ws; asm volatile("" : "+s"(wsg_)); unsigned char* ws = (unsigned char*)wsg_;     unsigned char* wl = ws + WS_W + (size_t)l * LW_STRIDE;
            { pg8::Gemm g{(const bf16*)(ws + WS_QA), (const bf16*)(wl + LW_Q), MT, 768, QL}; pg8::StaticOrder S; S.init(MT, 768, gridDim.x, blockIdx.x);
              pg8::EpiQ E{(const float*)(ws + WS_RSQ), (const float*)(ws + WS_ROPE), (bf16*)(ws + WS_Q), (float*)(ws + WS_QS)};
              pg8::gemm_phase<pg8::EpiQ, pg8::StaticOrder, true, true>(lds + RING_OFF, g, S, E, wave0); }
            { pg8::Gemm g{(const bf16*)(ws + WS_CKV), (const bf16*)(wl + LW_KV), MP, 1024, KVL}; pg8::StaticOrder S; S.init(MP, 1024, gridDim.x, (blockIdx.x + 195) % gridDim.x);
              pg8::EpiKV E{(bf16*)(ws + WS_KN), (bf16*)(ws + WS_V)};
              pg8::gemm_phase<pg8::EpiKV, pg8::StaticOrder, true, true>(lds + RING_OFF, g, S, E, wave0); }
        }
        if (IN(pb + 3)) { REP(5) { RETID(); phase_rwkvA_ut(a, lds, lane, wave); } }
        SEAM(pb + 3);
        if (IN(pb + 4)) REP(6) {
            unsigned* cw = (unsigned*)(a.ws + WS_CTL) + 64 + 64 * (l * 2 + rep_);
            RETID(); phase_qlat(a, l, lane, wave);
            asm volatile("s_waitcnt vmcnt(0)" ::: "memory");
            __syncthreads();
            if (threadIdx.x == 0) { __builtin_amdgcn_fence(__ATOMIC_RELEASE, "agent"); asm volatile("s_waitcnt vmcnt(0)" ::: "memory"); (void)xb_add(cw + 32, 1u); }
            RETID();
            if (blockIdx.x < 32) {
                if (wave == 0) rwkv_chain(a, l, lds, lane, (int)blockIdx.x);
                else if (wave <= 4) scan_sample(a, l, lds + 73728 + (wave - 1) * 10240, lane, (int)blockIdx.x * 4 + (wave - 1));
                __syncthreads();
            }
            const bool sfirst = (int)blockIdx.x >= NS_FIRST;
#pragma nounroll
            for (int pass = 0; pass < 2; ++pass) {
                if ((pass == 0) == sfirst) {
                    if (threadIdx.x == 0) { XB_SPIN(xb_ld(cw + 32) < gridDim.x, bar.bar); __builtin_amdgcn_fence(__ATOMIC_ACQUIRE, "agent"); asm volatile("s_waitcnt vmcnt(0)" ::: "memory"); }
                    __syncthreads();
                    RETID(); phase_attn_sample(a, l, lds, tid, lane, wave, cw + 16, MISC + 16);
                } else { RETID(); phase_attn_prompt(a, lds, tid, lane, wave, cw, MISC + 16); }
            }
        }
        SEAM(pb + 4);
        if (IN(pb + 5)) {
 REP(8) { RETID(); phase_combine(a, l, lds, lane, wave); }
 REP(13) { RETID(); phase_rwkvC(a, l, lds, lane, wave); }
 }
        SEAM(pb + 5);
        if (IN(pb + 6) && PH_EN(9)) REP(9) {
            GAS unsigned char* wsg_ = (GAS unsigned char*)a.ws; asm volatile("" : "+s"(wsg_)); unsigned char* ws = (unsigned char*)wsg_;     unsigned char* wl = ws + WS_W + (size_t)l * LW_STRIDE;
            if (blockIdx.x >= 128) for (int r2_ = 0; r2_ < (((PROBE_DBL >> 26) & 1) ? 2 : 1); ++r2_) { RETID(); thin_merge_sample(a, l, lds, lane, wave, (int)blockIdx.x - 128); }
            pg8::Gemm g{(const bf16*)(ws + WS_A4), (const bf16*)(wl + LW_MLA), 4 * MT, 4 * DM, 256}; pg8::MergeOrder S; S.init(MP, DM, gridDim.x, blockIdx.x);
            if ((PROBE_DBL >> 24) & 1) { pg8::EpiMerge E0{(const bf16*)(ws + WS_PROJ), (bf16*)(ws + WS_MG), (bf16*)(ws + WS_MERGED), 1}; pg8::gemm_phase<pg8::EpiMerge, pg8::MergeOrder, true, true>(lds + RING_OFF, g, S, E0, wave0); }
            pg8::EpiMerge E{(const bf16*)(ws + WS_PROJ), (bf16*)(ws + WS_MG), (bf16*)(ws + WS_MERGED), 0};
            pg8::gemm_phase<pg8::EpiMerge, pg8::MergeOrder, true, true>(lds + RING_OFF, g, S, E, wave0);
        }
        SEAM(pb + 6);
        if (IN(pb + 7) && PH_EN(10)) REP(10) {
            GAS unsigned char* wsg_ = (GAS unsigned char*)a.ws; asm volatile("" : "+s"(wsg_)); unsigned char* ws = (unsigned char*)wsg_;     unsigned char* wl = ws + WS_W + (size_t)l * LW_STRIDE;
            if (blockIdx.x >= 128) for (int r2_ = 0; r2_ < (((PROBE_DBL >> 25) & 1) ? 2 : 1); ++r2_) { RETID(); thin_out_sample(a, l, lds, lane, wave, (int)blockIdx.x - 128); }
            pg8::Gemm g{(const bf16*)(ws + WS_MERGED), (const bf16*)(wl + LW_OUT), MP, DM, DM}; pg8::StaticOrder S; S.init(MP, DM, gridDim.x, blockIdx.x);
            if (l == 0) { pg8::EpiOut<false> E{INF(I_XP), nullptr, (bf16*)(ws + WS_X1), (const float*)(ws + WS_MOD) + 2048, INF(I_BADA) + 2048};
                pg8::gemm_phase<pg8::EpiOut<false>, pg8::StaticOrder, true, true>(lds + RING_OFF, g, S, E, wave0); }
            else { pg8::EpiOut<true> E{nullptr, (const bf16*)(ws + WS_X1), (bf16*)(ws + WS_X2), (const float*)(ws + WS_MOD) + (size_t)NCB * 3072 + 2048, INF(I_BADA) + 3072 + 2048};
                pg8::gemm_phase<pg8::EpiOut<true>, pg8::StaticOrder, true, true>(lds + RING_OFF, g, S, E, wave0); }
        }
        SEAM(pb + 7);
    }
    if (IN(N_PHASES - 1)) {
#if PH_EN(11)
 REP(11) { RETID(); phase_final(a, lane, wave); }
#endif
 }
#undef IN
#undef SEAM
}

#ifndef N_LAUNCH_MODE
#define N_LAUNCH_MODE 1
#endif
extern "C" void kernel_launch(void* const* d_in, const int* in_sizes, int n_in, void* d_out, int out_size, void* d_ws, size_t ws_size, hipStream_t stream) {
    static int grid = 0;
    if (grid == 0) {
        if (n_in != 35 || out_size != (int)O_END || ws_size < WS_END) { fprintf(stderr, "kernel_launch: unexpected sizes n_in %d out %d ws %zu (need %zu)\n", n_in, out_size, ws_size, (size_t)WS_END); grid = -1; return; }
        int dev = 0, cus = 0, per_cu = 0;
        if (hipGetDevice(&dev) != hipSuccess || hipDeviceGetAttribute(&cus, hipDeviceAttributeMultiprocessorCount, dev) != hipSuccess) { grid = -1; return; }
        if (hipFuncSetAttribute((const void*)fwd, hipFuncAttributeMaxDynamicSharedMemorySize, LDS_BYTES) != hipSuccess) { fprintf(stderr, "kernel_launch: hipFuncSetAttribute failed\n"); grid = -1; return; }
        if (hipOccupancyMaxActiveBlocksPerMultiprocessor(&per_cu, (const void*)fwd, NTHR, LDS_BYTES) != hipSuccess || per_cu < 1) fprintf(stderr, "kernel_launch: occupancy query says %d\n", per_cu);
        (void)hipGetLastError();
        grid = cus;
    }
    if (grid < 0) return;
    if (hipMemsetAsync((char*)d_ws + WS_CTL, 0, WS_ZERO_BYTES, stream) != hipSuccess) return;
    Args a{};
    for (int i = 0; i < 35; ++i) a.in[i] = d_in[i];
    a.out = (float*)d_out; a.ws = (unsigned char*)d_ws;
#if N_LAUNCH_MODE == 1
    a.ph_lo = 0; a.ph_hi = N_PHASES;
    hipLaunchKernelGGL(fwd, dim3(grid), dim3(NTHR), LDS_BYTES, stream, a);
#else
    for (int p = 0; p < N_PHASES; ++p) { a.ph_lo = p; a.ph_hi = p + 1; hipLaunchKernelGGL(fwd, dim3(grid), dim3(NTHR), LDS_BYTES, stream, a); }
#endif
}
```

```cpp
#include <hip/hip_runtime.h>
#include <cstdio>
#include <cstdint>
namespace pg8 {
#define PG8_LAS __attribute__((address_space(3)))
typedef unsigned short bf16_t;
typedef short bf16x8 __attribute__((ext_vector_type(8)));
typedef float f32x4 __attribute__((ext_vector_type(4)));
typedef unsigned u32x4 __attribute__((ext_vector_type(4)));
constexpr int BM = 256, BK = 64, HALF = 128, HTB = HALF * BK * 2  , STAGE_BYTES = 8 * HTB, NXCD = 8, WGM = 8;

__host__ __device__ __forceinline__ int lds_byte(int r, int c) { const int st = (r >> 4) * 2 + (c >> 5), rr = r & 15, cc = c & 31, ob = rr * 64 + cc * 2; return st * 1024 + (ob ^ (((ob >> 9) & 1) << 5)); }
__host__ __device__ __forceinline__ void stage_rc(int b, int& R, int& C) { const int st = b / 1024, sb = b % 1024, swz = sb ^ (((sb >> 9) & 1) << 5); R = (st >> 1) * 16 + swz / 64; C = (st & 1) * 32 + (swz % 64) / 2; }
__host__ __device__ __forceinline__ int perm32(int rho) { const int n = rho >> 4, i = rho & 15; return 8 * (i >> 2) + 4 * n + (i & 3); }

struct Unit { int pm, pn; };
struct Gemm { const bf16_t* A; const bf16_t* Bt; int M, N, K; };

struct StaticOrder {
    int nM, nN, nwg, G, c;
    __host__ __device__ void init(int M, int N, int G_, int c_) { nM = M / BM; nN = N / BM; nwg = nM * nN; G = G_; c = c_; }
    __host__ __device__ bool next(int i, Unit& u) const {
        const long L = (long)i * G + c; if (L >= nwg) return false;
        int wgid = (int)L; { const int q = nwg / NXCD, r = nwg % NXCD, xcd = wgid % NXCD, off = wgid / NXCD; wgid = (xcd < r ? xcd * (q + 1) : r * (q + 1) + (xcd - r) * q) + off; }
        const int nig = WGM * nN, gid = wgid / nig, fm = gid * WGM, gsz = (nM - fm) < WGM ? (nM - fm) : WGM;
        u.pm = fm + ((wgid % nig) % gsz); u.pn = (wgid % nig) / gsz; return true;
    }
    __device__ __forceinline__ void a_ready(const Unit&) const {}
    __device__ __forceinline__ void done(const Unit&) const {}
    __device__ __forceinline__ bool keep(const Unit&) const { return false; }
};
__device__ __forceinline__ unsigned cvt_pk_bf16(float lo, float hi) { unsigned r; asm volatile("v_cvt_pk_bf16_f32 %0, %1, %2" : "=v"(r) : "v"(lo), "v"(hi)); return r; }
typedef float f32x2 __attribute__((ext_vector_type(2)));
template <class Epi, class Sched, bool ALIGN_EPI = false, bool SP2 = false>
__device__ __forceinline__ void gemm_phase(PG8_LAS unsigned char* lds, const Gemm g, const Sched& S, const Epi& E, int wave0) {
    int lane_l, wid_l = wave0; asm volatile("v_mbcnt_lo_u32_b32 %0, -1, 0\n\tv_mbcnt_hi_u32_b32 %0, -1, %0" : "=v"(lane_l)); asm volatile("" : "+s"(wid_l)); const int wid = wid_l, lane = lane_l, tid = wid * 64 + lane, wr = wid >> 2, wc = wid & 3, fr = lane & 15, fq = lane >> 4;
    int K_l = g.K; asm volatile("" : "+s"(K_l)); const int K = K_l, nt = K / BK;
    unsigned voffA[2], voffB[2];
#pragma unroll
    for (int i = 0; i < 2; ++i) { int R, C; stage_rc(tid * 16 + i * 8192, R, C); const int Rb = Epi::PERM ? ((R & ~31) + perm32(R & 31)) : R;
        voffA[i] = (unsigned)(R * K + C) * 2u; voffB[i] = (unsigned)(Rb * K + C) * 2u; }
    const size_t kstep = (size_t)(BK * 2);
    const size_t hstep = (size_t)HALF * K * 2;
    const size_t tstep = 2 * hstep;
    const unsigned ldsw = (unsigned)wid * 1024u;
    const int aoff = lds_byte(wr * 64 + fr, fq * 8), boff = lds_byte(wc * 32 + fr, fq * 8);
#define PG8_SA(b, h) (((b) * 2 + (h)) * HTB)
#define PG8_SB(b, h) ((4 + (b) * 2 + (h)) * HTB)
#define PG8_STAGE(bufoff, gbase, voff) do { _Pragma("unroll") for (int _i = 0; _i < 2; ++_i) \
        __builtin_amdgcn_global_load_lds((const unsigned*)((const char*)(gbase) + (voff)[_i]), (PG8_LAS unsigned*)(lds + (bufoff) + ldsw + _i * 8192), 16, 0, 0); } while (0)
#define PG8_LDA(dst, b, h) do { _Pragma("unroll") for (int m = 0; m < 4; ++m) _Pragma("unroll") for (int k = 0; k < 2; ++k) dst[m][k] = *(const PG8_LAS bf16x8*)(lds + PG8_SA(b, h) + aoff + m * 2048 + k * 1024); } while (0)
#define PG8_LDB(dst, b, h) do { _Pragma("unroll") for (int n = 0; n < 2; ++n) _Pragma("unroll") for (int k = 0; k < 2; ++k) dst[n][k] = *(const PG8_LAS bf16x8*)(lds + PG8_SB(b, h) + boff + n * 2048 + k * 1024); } while (0)
#define PG8_MMA(ai, bj, At, Bt) do { __builtin_amdgcn_s_setprio(1); _Pragma("unroll") for (int m = 0; m < 4; ++m) _Pragma("unroll") for (int n = 0; n < 2; ++n) _Pragma("unroll") for (int k = 0; k < 2; ++k) \
        acc[ai][bj][m][n] = __builtin_amdgcn_mfma_f32_16x16x32_bf16(Bt[n][k], At[m][k], acc[ai][bj][m][n], 0, 0, 0); __builtin_amdgcn_s_setprio(0); } while (0)
#define PG8_WAIT_V(n) asm volatile("s_waitcnt vmcnt(" #n ")" ::: "memory")
#define PG8_WAIT_L(n) asm volatile("s_waitcnt lgkmcnt(" #n ")" ::: "memory")
#define PG8_BAR __builtin_amdgcn_s_barrier()
#define PG8_SCHED __builtin_amdgcn_sched_barrier(0)
    Unit cur, nxt; int ui = 0;
    if (!S.next(0, cur)) return;
    f32x4 acc[2][2][4][2];
#pragma unroll
    for (int a = 0; a < 2; ++a)
#pragma unroll
        for (int b = 0; b < 2; ++b)
#pragma unroll
            for (int m = 0; m < 4; ++m)
#pragma unroll
                for (int n = 0; n < 2; ++n) acc[a][b][m][n] = (f32x4){0.f, 0.f, 0.f, 0.f};
    bf16x8 At[4][2], B0[2][2], B1[2][2];
    const char* cA = (const char*)g.A + (size_t)cur.pm * tstep; const char* cB = (const char*)g.Bt + (size_t)cur.pn * tstep;
    S.a_ready(cur);
    if constexpr (SP2) {
        PG8_STAGE(PG8_SB(0, 0), cB, voffB); PG8_STAGE(PG8_SB(0, 1), cB + hstep, voffB); PG8_STAGE(PG8_SA(0, 0), cA, voffA); PG8_STAGE(PG8_SA(0, 1), cA + hstep, voffA);
        if (wr == 1) PG8_BAR;
        PG8_WAIT_V(2); PG8_BAR;
        PG8_STAGE(PG8_SB(1, 0), cB + kstep, voffB); PG8_STAGE(PG8_SA(1, 0), cA + kstep, voffA); PG8_STAGE(PG8_SB(1, 1), cB + hstep + kstep, voffB);
        PG8_WAIT_V(6); PG8_BAR;
    } else {
        PG8_STAGE(PG8_SB(0, 0), cB, voffB); PG8_STAGE(PG8_SA(0, 0), cA, voffA); PG8_STAGE(PG8_SB(0, 1), cB + hstep, voffB); PG8_STAGE(PG8_SA(0, 1), cA + hstep, voffA);
        if (wr == 1) PG8_BAR;
        PG8_WAIT_V(4); PG8_BAR;
        PG8_STAGE(PG8_SB(1, 0), cB + kstep, voffB); PG8_STAGE(PG8_SA(1, 0), cA + kstep, voffA); PG8_STAGE(PG8_SB(1, 1), cB + hstep + kstep, voffB);
        PG8_WAIT_V(6); PG8_BAR;
    }
    for (;;) {
        const bool has_next = S.next(ui + 1, nxt);
        const char* nA = has_next ? (const char*)g.A + (size_t)nxt.pm * tstep : cA; const char* nB = has_next ? (const char*)g.Bt + (size_t)nxt.pn * tstep : cB;
        for (int t = 0; t < nt; t += 2) {
            const bool last = (t == nt - 2);
            const char* a1 = cA + (size_t)(t + 1) * kstep;
            const char* a2 = last ? nA : cA + (size_t)(t + 2) * kstep; const char* b2 = last ? nB : cB + (size_t)(t + 2) * kstep;
            const char* a3 = a2 + kstep; const char* b3 = b2 + kstep;
            if (last && has_next) S.a_ready(nxt);
            if constexpr (SP2) {
            PG8_LDB(B0, 0, 0); PG8_LDB(B1, 0, 1); PG8_SCHED; PG8_LDA(At, 0, 0); PG8_STAGE(PG8_SA(1, 1), a1 + hstep, voffA);
            PG8_WAIT_V(8); PG8_WAIT_L(0); PG8_BAR; PG8_MMA(0, 0, At, B0); PG8_MMA(0, 1, At, B1); PG8_BAR; PG8_SCHED;
            PG8_LDA(At, 0, 1); PG8_STAGE(PG8_SB(0, 0), b2, voffB); PG8_STAGE(PG8_SB(0, 1), b2 + hstep, voffB); PG8_STAGE(PG8_SA(0, 0), a2, voffA);
            PG8_WAIT_V(8); PG8_WAIT_L(0); PG8_BAR; PG8_MMA(1, 0, At, B0); PG8_MMA(1, 1, At, B1); PG8_BAR; PG8_SCHED;
            PG8_LDB(B0, 1, 0); PG8_LDB(B1, 1, 1); PG8_SCHED; PG8_LDA(At, 1, 0); PG8_STAGE(PG8_SA(0, 1), a2 + hstep, voffA);
            PG8_WAIT_V(8); PG8_WAIT_L(0); PG8_BAR; PG8_MMA(0, 0, At, B0); PG8_MMA(0, 1, At, B1); PG8_BAR; PG8_SCHED;
            PG8_LDA(At, 1, 1); PG8_STAGE(PG8_SB(1, 0), b3, voffB); PG8_STAGE(PG8_SB(1, 1), b3 + hstep, voffB); PG8_STAGE(PG8_SA(1, 0), a3, voffA);
            PG8_WAIT_V(8); PG8_WAIT_L(0); PG8_BAR; PG8_MMA(1, 0, At, B0); PG8_MMA(1, 1, At, B1); PG8_BAR; PG8_SCHED;
            } else {
            PG8_LDB(B0, 0, 0); PG8_SCHED; PG8_LDA(At, 0, 0); PG8_STAGE(PG8_SA(1, 1), a1 + hstep, voffA);
            PG8_WAIT_L(8); PG8_BAR; PG8_WAIT_L(0); PG8_MMA(0, 0, At, B0); PG8_BAR; PG8_SCHED;
            PG8_LDB(B1, 0, 1); PG8_STAGE(PG8_SB(0, 0), b2, voffB);
            PG8_BAR; PG8_WAIT_L(0); PG8_MMA(0, 1, At, B1); PG8_BAR;
            PG8_LDA(At, 0, 1); PG8_STAGE(PG8_SA(0, 0), a2, voffA);
            PG8_BAR; PG8_WAIT_L(0); PG8_MMA(1, 0, At, B0); PG8_BAR; PG8_SCHED;
            PG8_STAGE(PG8_SB(0, 1), b2 + hstep, voffB);
            PG8_WAIT_V(6); PG8_BAR; PG8_MMA(1, 1, At, B1); PG8_BAR;
            PG8_LDB(B0, 1, 0); PG8_SCHED; PG8_LDA(At, 1, 0); PG8_STAGE(PG8_SA(0, 1), a2 + hstep, voffA);
            PG8_WAIT_L(8); PG8_BAR; PG8_WAIT_L(0); PG8_MMA(0, 0, At, B0); PG8_BAR; PG8_SCHED;
            PG8_LDB(B1, 1, 1); PG8_STAGE(PG8_SB(1, 0), b3, voffB);
            PG8_BAR; PG8_WAIT_L(0); PG8_MMA(0, 1, At, B1); PG8_BAR;
            PG8_LDA(At, 1, 1); PG8_STAGE(PG8_SA(1, 0), a3, voffA);
            PG8_BAR; PG8_WAIT_L(0); PG8_MMA(1, 0, At, B0); PG8_BAR; PG8_SCHED;
            PG8_STAGE(PG8_SB(1, 1), b3 + hstep, voffB);
            PG8_WAIT_V(6); PG8_BAR; PG8_MMA(1, 1, At, B1); PG8_BAR;
            }
        }
        if constexpr (ALIGN_EPI) { if (wr == 0) PG8_BAR; }
        if constexpr (!Epi::AFTER_DRAIN) { E(acc, cur, wr, wc, fr, fq); S.done(cur); }
        if (!has_next) break;
        if (!S.keep(cur))
#pragma unroll
        for (int a = 0; a < 2; ++a)
#pragma unroll
            for (int b = 0; b < 2; ++b)
#pragma unroll
                for (int m = 0; m < 4; ++m)
#pragma unroll
                    for (int n = 0; n < 2; ++n) acc[a][b][m][n] = (f32x4){0.f, 0.f, 0.f, 0.f};
        cur = nxt; cA = nA; cB = nB; ++ui;
        if constexpr (ALIGN_EPI) { if (wr == 1) PG8_BAR; }
    }
    PG8_WAIT_V(0);
    if constexpr (!ALIGN_EPI) { if (wr == 0) PG8_BAR; }
    PG8_BAR;
    if constexpr (Epi::AFTER_DRAIN) { E.fused(acc, cur, wr, wc, fr, fq, lds, wid, lane); S.done(cur); }
#undef PG8_SA
#undef PG8_SB
#undef PG8_STAGE
#undef PG8_LDA
#undef PG8_LDB
#undef PG8_MMA
#undef PG8_WAIT_V
#undef PG8_WAIT_L
#undef PG8_BAR
#undef PG8_SCHED
}
}

constexpr int NWAVES = 8, NTHR = 512;
constexpr int DM = 1024, NB_P = 8, SEQ = 2048, NB_S = 32, TSMP = 8, DEPTH = 2;
constexpr int MP = NB_P * SEQ, MS = NB_S * TSMP, MT = MP + MS;
constexpr int PAST = 16384, PAGE = 128, NPAGES = 128, NPOOL = 5120;
constexpr int NH = 8, QKN = 64, QKR = 32, DQK = 96, VH = 64, QL = 384, KVL = 256, DMLA = 512;
constexpr int DC = 256, RH = 4, RN = 64, DR = 256, SW = 896, WL = 64;
constexpr int PROJ_SRC = 6432, NPROJ = 6656, PW = 6144;
constexpr int C_KV = 0, C_KR = 256, C_ZM = 384, C_CB = 896, C_CC = 1152, C_CX = 1408, C_ZC = 1664, C_RW = 1920, C_ZR = 2816, C_GM = 3072;
constexpr int NCB = NB_P + NB_S;
constexpr float RMS_EPS = 1e-6f, GN_EPS = 64e-5f;
constexpr float SC2 = 0.10206207261596577f * 1.4426950408889634f;
constexpr int NROPE = SEQ + TSMP;

constexpr size_t O_YP = 0, O_YS = O_YP + (size_t)MP * DM, O_CKVP = O_YS + (size_t)MS * DM, O_KPEP = O_CKVP + (size_t)DEPTH * MP * KVL,
    O_CONVP = O_KPEP + (size_t)DEPTH * MP * QKR, O_SHP = O_CONVP + (size_t)DEPTH * NB_P * 2 * DC, O_RWP = O_SHP + (size_t)DEPTH * NB_P * SW,
    O_CKVS = O_RWP + (size_t)DEPTH * NB_P * RH * RN * RN, O_KPES = O_CKVS + (size_t)DEPTH * MS * KVL, O_CONVS = O_KPES + (size_t)DEPTH * MS * QKR,
    O_SHS = O_CONVS + (size_t)DEPTH * NB_S * 2 * DC, O_RWS = O_SHS + (size_t)DEPTH * NB_S * SW, O_END = O_RWS + (size_t)DEPTH * NB_S * RH * RN * RN;
static_assert(O_END == 28047360, "output size");

constexpr size_t MiB = 1u << 20;
constexpr size_t al256(size_t x) { return (x + 255) & ~(size_t)255; }
constexpr size_t WS_CTL = 0;
constexpr size_t WS_MOD = 1 * MiB;
constexpr size_t WS_ZERO_BYTES = 2 * MiB;
static_assert((size_t)DEPTH * NCB * 3072 * 4 <= MiB, "MOD fits");
constexpr size_t WS_ROPE = 2 * MiB;
constexpr size_t WS_RSQ = WS_ROPE + al256((size_t)NROPE * 32 * 4);
constexpr size_t WS_W = 3 * MiB;
constexpr size_t LW_IN = 0, LW_Q = LW_IN + (size_t)NPROJ * DM * 2, LW_KV = LW_Q + (size_t)768 * QL * 2, LW_MLA = LW_KV + (size_t)1024 * KVL * 2,
    LW_CONV = LW_MLA + (size_t)DM * DMLA * 2, LW_RW = LW_CONV + (size_t)DM * DC * 2, LW_OUT = LW_RW + (size_t)DM * DR * 2, LW_W2T = LW_OUT + (size_t)DM * DM * 2, LW_A2T = LW_W2T + (size_t)DR * WL * 2, LW_STRIDE = LW_A2T + (size_t)DR * WL * 2;
constexpr size_t WS_U = al256(WS_W + 2 * LW_STRIDE);
constexpr size_t WS_QA = WS_U + (size_t)MT * DM * 2;
constexpr size_t WS_PROJ = WS_QA + (size_t)MT * QL * 2;
constexpr size_t WS_CKV = WS_PROJ + (size_t)MT * PW * 2;
constexpr size_t WS_KPE = WS_CKV + (size_t)MT * KVL * 2;
constexpr size_t WS_A4 = WS_KPE + (size_t)MT * QKR * 2;
constexpr size_t A4_STRIDE = (size_t)MT * 256;
constexpr size_t WS_SC = WS_A4 + 4 * A4_STRIDE * 2;
constexpr size_t WS_BONUS = WS_SC + (size_t)MT * 6 * DR * 4;
constexpr size_t WS_Q = WS_BONUS + (size_t)MT * DR * 4;
constexpr size_t WS_QS = WS_Q + (size_t)MP * 768 * 2;
constexpr size_t WS_KN = WS_QS + (size_t)MS * 768 * 4;
constexpr size_t WS_V = WS_KN + (size_t)MP * 512 * 2;
constexpr size_t WS_QLAT = WS_V + (size_t)MP * 512 * 2;
constexpr size_t WS_PO = WS_QLAT + (size_t)NB_S * 64 * 288 * 2;
constexpr size_t WS_PM = WS_PO + (size_t)NB_S * 8 * 64 * 256 * 4;
constexpr size_t WS_PL = WS_PM + (size_t)NB_S * 8 * 64 * 4;
constexpr size_t WS_MG = WS_PL + (size_t)NB_S * 8 * 64 * 4;
constexpr size_t WS_MERGED = WS_MG + (size_t)MT * DM * 2;
constexpr size_t WS_X1 = WS_MERGED + (size_t)MT * DM * 2;
constexpr size_t WS_X2 = WS_X1 + (size_t)MT * DM * 4;
constexpr size_t WS_YL = WS_X2 + (size_t)MT * DM * 4;
constexpr size_t WS_YP = WS_YL + (size_t)MP * DR * 4;
constexpr size_t WS_QC = WS_YP + (size_t)MP * DR * 4;
constexpr int RCL = 32, RNC = SEQ / RCL;
constexpr size_t WS_PC = WS_QC + (size_t)32 * RNC * 4096 * 4;
constexpr size_t WS_SALL = WS_PC + (size_t)32 * RNC * 4096 * 2;
constexpr size_t WS_END = WS_SALL + (size_t)32 * RNC * 4096 * 4;
constexpr int CW_BAR = 4096;

constexpr int RING_OFF = 0, RING_BYTES = 131072;
constexpr int LDSCTL_OFF = RING_BYTES, MISC_OFF = LDSCTL_OFF + 320;
constexpr int LDS_BYTES = 147456;

#define GAS __attribute__((address_space(1)))
#define LAS __attribute__((address_space(3)))
typedef unsigned short bf16;
typedef unsigned v4u __attribute__((ext_vector_type(4)));
typedef unsigned v2u __attribute__((ext_vector_type(2)));
typedef float f32x4 __attribute__((ext_vector_type(4)));
typedef float f32x2 __attribute__((ext_vector_type(2)));
typedef float f32x16 __attribute__((ext_vector_type(16)));
typedef short bf16x8 __attribute__((ext_vector_type(8)));
typedef short s16x4 __attribute__((ext_vector_type(4)));
typedef short v4i16_t __attribute__((ext_vector_type(4)));
#define LDS_WAIT() asm volatile("s_waitcnt lgkmcnt(0)" ::: "memory")
#define VM_WAIT() asm volatile("s_waitcnt vmcnt(0)" ::: "memory")
typedef float f32x2_t __attribute__((ext_vector_type(2)));
typedef __bf16 bf16x2_t __attribute__((ext_vector_type(2)));
__device__ __forceinline__ unsigned pk2(float lo, float hi) { f32x2_t v = {lo, hi}; bf16x2_t b = __builtin_convertvector(v, bf16x2_t); return __builtin_bit_cast(unsigned, b); }
__device__ __forceinline__ unsigned f2bf(float f) { return pk2(f, 0.f) & 0xffffu; }
__device__ __forceinline__ float bflo(unsigned u) { return __builtin_bit_cast(float, u << 16); }
__device__ __forceinline__ float bfhi(unsigned u) { return __builtin_bit_cast(float, u & 0xffff0000u); }
__device__ __forceinline__ float bf1(bf16 b) { return __builtin_bit_cast(float, ((unsigned)b) << 16); }
#define SHX(x, o) __builtin_bit_cast(float, __builtin_amdgcn_ds_bpermute(((lane) ^ (o)) << 2, __builtin_bit_cast(int, (float)(x))))
__device__ __forceinline__ float wave_sum_l(float v, int lane) {
#pragma unroll
    for (int o = 1; o < 64; o <<= 1) v += SHX(v, o);
    return v;
}
__device__ __forceinline__ float grp16_sum_l(float v, int lane) {
#pragma unroll
    for (int o = 1; o < 16; o <<= 1) v += SHX(v, o);
    return v;
}
#define RDL(x, k) __builtin_bit_cast(float, __builtin_amdgcn_readlane(__builtin_bit_cast(int, (float)(x)), (k)))
#define wave_sum(v) wave_sum_l((v), lane)
#define grp16_sum(v) grp16_sum_l((v), lane)
__device__ __forceinline__ float fexp(float x) { return __builtin_amdgcn_exp2f(x * 1.4426950408889634f); }
__device__ __forceinline__ float frcp(float x) { return __builtin_amdgcn_rcpf(x); }
__device__ __forceinline__ float frsq(float x) { return __builtin_amdgcn_rsqf(x); }
__device__ __forceinline__ float sigm(float x) { return frcp(1.f + fexp(-x)); }
__device__ __forceinline__ float silu(float x) { return x * frcp(1.f + fexp(-x)); }
__device__ __forceinline__ void row_info(int m, int& b, int& t, int& T, int& cb, int& pidx) {
    if (m < MP) { b = m >> 11; t = m & 2047; T = SEQ; cb = b; pidx = t; }
    else { const int mm = m - MP; b = mm >> 3; t = mm & 7; T = TSMP; cb = NB_P + b; pidx = SEQ + t; }
}
#define XB_TMO      128
#define XB_XCNT(j)  (256  + 64 * (j))
#define XB_XSUB(j)  (1280 + 64 * (j))
#define XB_XGEN(j)  (2304 + 64 * (j))
#define XB_TOP      3328
#define XB_TOPGEN   3392
#define XCD_BAR_WORDS 3456
#define XB_SPIN_CAP (1u << 18)

__device__ __forceinline__ unsigned xb_ld(unsigned* p)              { return __hip_atomic_load(p, __ATOMIC_RELAXED, __HIP_MEMORY_SCOPE_AGENT); }
__device__ __forceinline__ unsigned xb_add(unsigned* p, unsigned v) { return __hip_atomic_fetch_add(p, v, __ATOMIC_RELAXED, __HIP_MEMORY_SCOPE_AGENT); }
__device__ __forceinline__ unsigned xb_xcc_id() { return (unsigned)__builtin_amdgcn_s_getreg((3 << 11) | 20) & 0xFu; }
#define XB_SPIN(cond, bar) do { unsigned _sp = 0; while (cond) { __builtin_amdgcn_s_sleep(1); \
    if ((++_sp & 255u) == 0u) { if (xb_ld(&(bar)[XB_TMO])) break; if (_sp > XB_SPIN_CAP) { atomicAdd(&(bar)[XB_TMO], 1u); break; } } } } while (0)

struct XcdBarrier {
    unsigned* bar; unsigned x;
    volatile LAS unsigned* st;
};

__device__ __forceinline__ XcdBarrier xcd_barrier_post(unsigned* bar, volatile LAS unsigned* st) {
    XcdBarrier b; b.bar = bar; b.x = xb_xcc_id(); b.st = st;
    if (threadIdx.x == 0) (void)xb_add(&bar[XB_XCNT(b.x)], 1u);
    return b;
}
__device__ __forceinline__ void xcd_barrier_complete(unsigned* bar, unsigned x, unsigned& nloc, unsigned& nx) {
    const unsigned G = gridDim.x * gridDim.y * gridDim.z;
    unsigned sum, cnt, mine, sp = 0u;
    for (;;) {
        sum = 0u; cnt = 0u; mine = 0u;
#pragma unroll
        for (unsigned j = 0; j < 16; ++j) { const unsigned c = xb_ld(&bar[XB_XCNT(j)]); sum += c; cnt += (c > 0u) ? 1u : 0u; mine = (j == x) ? c : mine; }
        if (sum == G) break;
        __builtin_amdgcn_s_sleep(1);
        if ((++sp & 255u) == 0u) { if (xb_ld(&bar[XB_TMO])) break; if (sp > XB_SPIN_CAP) { atomicAdd(&bar[XB_TMO], 1u); break; } }
    }
    nloc = mine > 0u ? mine : 1u; nx = cnt > 0u ? cnt : 1u;
}

__device__ __forceinline__ void xcd_barrier(const XcdBarrier& b) {
    asm volatile("s_waitcnt vmcnt(0)" ::: "memory");
    __syncthreads();
    if (threadIdx.x == 0) {
        unsigned* bar = b.bar;
        __builtin_amdgcn_s_waitcnt(0);
        unsigned nloc = b.st[0], nx = b.st[1];
        if (nloc == 0u) { xcd_barrier_complete(bar, b.x, nloc, nx); b.st[0] = nloc; b.st[1] = nx; }
        const unsigned old = xb_add(&bar[XB_XSUB(b.x)], 1u);
        const unsigned gen = old / nloc;
        if (old + 1u == (gen + 1u) * nloc) {
            __builtin_amdgcn_fence(__ATOMIC_RELEASE, "agent");
            asm volatile("s_waitcnt vmcnt(0)" ::: "memory");
            const unsigned og = xb_add(&bar[XB_TOP], 1u);
            const unsigned tg = og / nx;
            if (og + 1u == (tg + 1u) * nx) xb_add(&bar[XB_TOPGEN], 1u);
            else XB_SPIN(xb_ld(&bar[XB_TOPGEN]) == tg, bar);
            __builtin_amdgcn_fence(__ATOMIC_ACQUIRE, "agent");
            xb_add(&bar[XB_XGEN(b.x)], 1u);
            asm volatile("s_waitcnt vmcnt(0)" ::: "memory");
        } else {
            XB_SPIN(xb_ld(&bar[XB_XGEN(b.x)]) == gen, bar);
            __builtin_amdgcn_fence(__ATOMIC_ACQUIRE, "agent");
            asm volatile("s_waitcnt vmcnt(0)" ::: "memory");
        }
    }
    __syncthreads();
}

#ifndef PROBE_DBL
#define PROBE_DBL 0
#endif
struct Args { const void* in[35]; float* out; unsigned char* ws; int ph_lo, ph_hi; };
enum { I_XP = 0, I_XS, I_CCKV, I_CKPE, I_SCONV, I_SSHIFT, I_SRWKV, I_PT, I_CP, I_CS, I_NORMG, I_WADA, I_BADA, I_WIN, I_QNG, I_WQB, I_KVNG, I_WUK, I_WUV, I_WMLA,
       I_CONVW, I_WCONV, I_MU, I_W0, I_W2, I_A0, I_A2, I_KK, I_KA, I_RK, I_GNG, I_GNB, I_WRW, I_WOUT, I_FNG };
#define INF(i) ((const float*)a.in[i])

struct ColIdent { int off; __device__ __forceinline__ int operator()(int d) const { return d + off; } };
struct ColWin { __device__ __forceinline__ int operator()(int d) const {
    if (d < 384) return d; if (d < 512) return -1; const int pc = d - 512;
    if (pc < 256) return 384 + pc;
    if (pc < 384) return (pc - 256 < 32) ? 640 + pc - 256 : -1;
    if (pc < 896) return 672 + pc - 384;
    if (pc < 1920) return 1184 + pc - 896;
    if (pc < 2816) return 2208 + pc - 1920;
    if (pc < 3072) return 3104 + pc - 2816;
    return 3360 + pc - 3072; } };
struct ColWq { __device__ __forceinline__ int operator()(int d) const { const int h = d / 96, j = d - h * 96; if (j < 64) return d; const int i = (j - 64) >> 1, par = (j - 64) & 1; return h * 96 + 64 + par * 16 + i; } };

template <class SrcCol>
__device__ __forceinline__ void tr_item(const float* __restrict__ W, int K, int Nsrc, bf16* WT, LAS float* scr, int item, int nblk, int lane, SrcCol sc, const float* __restrict__ kscale) {
    const int kb = item / nblk, nb = item - kb * nblk, k0 = 64 * kb, n0 = 32 * nb;
    const int srcc = sc(n0 + (lane & 31));
    float tv[32];
#pragma unroll
    for (int i = 0; i < 32; ++i) { const int kk = 2 * i + (lane >> 5); float v = 0.f; if (srcc >= 0) v = W[(size_t)(k0 + kk) * Nsrc + srcc]; if (kscale) v *= kscale[k0 + kk]; tv[i] = v; }
#pragma unroll
    for (int i = 0; i < 32; ++i) { const int kk = 2 * i + (lane >> 5); scr[kk * 33 + (lane & 31)] = tv[i]; }
    LDS_WAIT(); asm volatile("" ::: "memory");
    const int c = lane & 7;
#pragma unroll
    for (int j = 0; j < 4; ++j) { const int n = (lane >> 3) + 8 * j; const LAS float* s = scr + (8 * c) * 33 + n;
        v4u o; o.x = pk2(s[0], s[33]); o.y = pk2(s[66], s[99]); o.z = pk2(s[132], s[165]); o.w = pk2(s[198], s[231]);
        *(GAS v4u*)(WT + (size_t)(n0 + n) * K + k0 + 8 * c) = o; }
    LDS_WAIT(); asm volatile("" ::: "memory");
}

__device__ __forceinline__ void convert_weights(const Args& a, unsigned char* ws, LAS unsigned char* lds, int lane, int wave, int l, int gw, int NGW) {
    LAS float* scr = (LAS float*)(lds + wave * 16384);
    constexpr int I_IN = (DM / 64) * (NPROJ / 32), I_Q = (QL / 64) * (768 / 32), I_K = (KVL / 64) * (512 / 32), I_MLA = (DMLA / 64) * (DM / 32), I_C = (DC / 64) * (DM / 32), I_O = (DM / 64) * (DM / 32);
    constexpr int I_L = (WL / 64) * (DR / 32);
    constexpr int PER_L = I_IN + I_Q + 2 * I_K + I_MLA + 2 * I_C + I_O + 2 * I_L;
    unsigned char* wl = ws + WS_W + (size_t)l * LW_STRIDE;
    for (int rep_ = 0; rep_ < (((PROBE_DBL >> 21) & 1) ? 2 : 1); ++rep_)
    for (int it = gw; it < PER_L; it += NGW) {
        int r = it;
        if (r < I_IN) { tr_item(INF(I_WIN) + (size_t)l * DM * PROJ_SRC, DM, PROJ_SRC, (bf16*)(wl + LW_IN), scr, r, NPROJ / 32, lane, ColWin{}, nullptr); continue; } r -= I_IN;
        if (r < I_Q) { tr_item(INF(I_WQB) + (size_t)l * QL * 768, QL, 768, (bf16*)(wl + LW_Q), scr, r, 768 / 32, lane, ColWq{}, INF(I_QNG) + l * QL); continue; } r -= I_Q;
        if (r < I_K) { tr_item(INF(I_WUK) + (size_t)l * KVL * 512, KVL, 512, (bf16*)(wl + LW_KV), scr, r, 512 / 32, lane, ColIdent{0}, nullptr); continue; } r -= I_K;
        if (r < I_K) { tr_item(INF(I_WUV) + (size_t)l * KVL * 512, KVL, 512, (bf16*)(wl + LW_KV) + (size_t)512 * KVL, scr, r, 512 / 32, lane, ColIdent{0}, nullptr); continue; } r -= I_K;
        if (r < I_MLA) { const int hfm = r >= I_MLA / 2;
            tr_item(INF(I_WMLA) + (size_t)l * DMLA * DM + (size_t)hfm * 256 * DM, 256, DM, (bf16*)(wl + LW_MLA) + (size_t)hfm * DM * 256, scr, r - hfm * (I_MLA / 2), DM / 32, lane, ColIdent{0}, nullptr); continue; } r -= I_MLA;
        if (r < I_C) { tr_item(INF(I_WCONV) + (size_t)l * DC * DM, DC, DM, (bf16*)(wl + LW_CONV), scr, r, DM / 32, lane, ColIdent{0}, nullptr); continue; } r -= I_C;
        if (r < I_C) { tr_item(INF(I_WRW) + (size_t)l * DR * DM, DR, DM, (bf16*)(wl + LW_RW), scr, r, DM / 32, lane, ColIdent{0}, nullptr); continue; } r -= I_C;
        if (r < I_O) { tr_item(INF(I_WOUT) + (size_t)l * DM * DM, DM, DM, (bf16*)(wl + LW_OUT), scr, r, DM / 32, lane, ColIdent{0}, nullptr); continue; } r -= I_O;
        if (r < I_L) { tr_item(INF(I_W2) + (size_t)l * WL * DR, WL, DR, (bf16*)(wl + LW_W2T), scr, r, DR / 32, lane, ColIdent{0}, nullptr); continue; } r -= I_L;
        tr_item(INF(I_A2) + (size_t)l * WL * DR, WL, DR, (bf16*)(wl + LW_A2T), scr, r, DR / 32, lane, ColIdent{0}, nullptr);
    }
}

__device__ __forceinline__ void phase_prologue(const Args& a, LAS unsigned char* lds, int tid, int lane, int wave) {
    GAS unsigned char* wsg_ = (GAS unsigned char*)a.ws; asm volatile("" : "+s"(wsg_)); unsigned char* ws = (unsigned char*)wsg_;
    for (int arep_ = 0; arep_ < (((PROBE_DBL >> 22) & 1) ? 2 : 1); ++arep_)
    if (blockIdx.x < 192) {
        const int task = blockIdx.x, l = task / 96, rem = task - l * 96, kc = rem / 12, cc = rem - kc * 12;
        LAS float* tab = (LAS float*)lds;
        for (int i = 0; i < 10; ++i) { const int idx = tid + 512 * i, k = idx / 40, b = idx - k * 40;
            const float cv = (b < NB_P) ? INF(I_CP)[b * DM + kc * 128 + k] : INF(I_CS)[(b - NB_P) * DM + kc * 128 + k]; tab[idx] = silu(cv); }
        __syncthreads();
        const int j = cc * 256 + (tid & 255), half = tid >> 8;
        float acc[20];
#pragma unroll
        for (int q = 0; q < 20; ++q) acc[q] = 0.f;
        const float* wp = INF(I_WADA) + ((size_t)l * DM + kc * 128) * 3072 + j;
        for (int kb = 0; kb < 128; kb += 32) {
            float wv[32];
#pragma unroll
            for (int k = 0; k < 32; ++k) wv[k] = wp[(size_t)(kb + k) * 3072];
#pragma unroll
            for (int k = 0; k < 32; ++k) { const float w = wv[k]; const LAS f32x4* tr = (const LAS f32x4*)(tab + (kb + k) * 40 + half * 20);
#pragma unroll
                for (int q = 0; q < 5; ++q) { const f32x4 t4 = tr[q]; acc[4 * q] += t4.x * w; acc[4 * q + 1] += t4.y * w; acc[4 * q + 2] += t4.z * w; acc[4 * q + 3] += t4.w * w; } }
        }
        float* mod = (float*)(ws + WS_MOD) + ((size_t)l * NCB + half * 20) * 3072 + j;
#pragma unroll
        for (int q = 0; q < 20; ++q) unsafeAtomicAdd(mod + (size_t)q * 3072, ((PROBE_DBL >> 22) & 1) ? 0.5f * acc[q] : acc[q]);
        __syncthreads();
    }
    { const int gid = blockIdx.x * NTHR + tid;
      if (gid < NROPE * 16) { const int pidx = gid >> 4, i = gid & 15; const int pos = pidx < SEQ ? pidx : PAST + (pidx - SEQ);
        const double invd[16] = {1.0, 0.5623413251903491, 0.31622776601683794, 0.1778279410038923, 0.1, 0.05623413251903491, 0.03162277660168379, 0.01778279410038923,
                                 0.01, 0.005623413251903491, 0.0031622776601683794, 0.0017782794100389228, 0.001, 0.0005623413251903491, 0.00031622776601683794, 0.00017782794100389227};
        double iv = 1.0;
#pragma unroll
        for (int q = 0; q < 16; ++q) iv = (i == q) ? invd[q] : iv;
        const float ang = (float)pos * (float)iv;
        const double rev = (double)ang * 0.15915494309189535; double fr = rev - floor(rev); if (fr > 0.5) fr -= 1.0;
        const float r = (float)(fr * 6.283185307179586);
        float* rp = (float*)(ws + WS_ROPE) + (size_t)gid * 2; rp[0] = __cosf(r); rp[1] = __sinf(r); } }
    convert_weights(a, ws, lds, lane, wave, 0, blockIdx.x * NWAVES + wave, gridDim.x * NWAVES);
}

__device__ __forceinline__ const float* xrow_ptr(const Args& a, unsigned char* ws, int l, int m) {
    if (l == 0) return (m < MP) ? INF(I_XP) + (size_t)m * DM : INF(I_XS) + (size_t)(m - MP) * DM;
    return (const float*)(ws + WS_X1) + (size_t)m * DM;
}
__device__ __forceinline__ void phase_modulate(const Args& a, int l, int lane, int wave) {
    GAS unsigned char* wsg_ = (GAS unsigned char*)a.ws; asm volatile("" : "+s"(wsg_)); unsigned char* ws = (unsigned char*)wsg_;
    const int gw = blockIdx.x * NWAVES + wave, NGW = gridDim.x * NWAVES;
    const float* mod = (const float*)(ws + WS_MOD) + (size_t)l * NCB * 3072; const float* bada = INF(I_BADA) + l * 3072; const float* ng = INF(I_NORMG) + l * DM;
    bf16* U = (bf16*)(ws + WS_U);
    for (int grp = gw; grp < MT / 8; grp += NGW) {
        const int mbase = grp * 8; int b, t, T, cb, pidx; row_info(mbase, b, t, T, cb, pidx);
        const float* mrow = mod + (size_t)cb * 3072;
        f32x4 g[4], sh[4], sc[4];
#pragma unroll
        for (int j = 0; j < 4; ++j) { const int col = 4 * lane + 256 * j; g[j] = *(const f32x4*)(ng + col); sh[j] = *(const f32x4*)(mrow + col) + *(const f32x4*)(bada + col);
            sc[j] = *(const f32x4*)(mrow + DM + col) + *(const f32x4*)(bada + DM + col) + 1.0f; }
        f32x4 nx[4]; v2u nr[4];
        auto load_row = [&](int mr) {
            if (l == 0) { const f32x4* xr = (const f32x4*)xrow_ptr(a, ws, 0, mr) + lane;
#pragma unroll
                for (int j = 0; j < 4; ++j) nx[j] = xr[64 * j]; }
            else { const v2u* xr = (const v2u*)((const bf16*)(ws + WS_X1) + (size_t)mr * DM) + lane;
#pragma unroll
                for (int j = 0; j < 4; ++j) nr[j] = xr[64 * j]; } };
        load_row(mbase);
        for (int r = 0; r < 8; ++r) {
            const int m = mbase + r;
            f32x4 v[4];
            if (l == 0) {
#pragma unroll
                for (int j = 0; j < 4; ++j) v[j] = nx[j]; }
            else {
#pragma unroll
                for (int j = 0; j < 4; ++j) v[j] = (f32x4){bflo(nr[j].x), bfhi(nr[j].x), bflo(nr[j].y), bfhi(nr[j].y)}; }
            if (r + 1 < 8) load_row(m + 1);
            float ss = 0.f;
#pragma unroll
            for (int j = 0; j < 4; ++j) ss += (v[j].x * v[j].x + v[j].y * v[j].y) + (v[j].z * v[j].z + v[j].w * v[j].w);
            const float rs = frsq(wave_sum(ss) * (1.f / DM) + RMS_EPS);
#pragma unroll
            for (int j = 0; j < 4; ++j) { const int col = 4 * lane + 256 * j;
                const f32x4 u = v[j] * rs * g[j] * sc[j] + sh[j];
                v2u o; o.x = pk2(u.x, u.y); o.y = pk2(u.z, u.w); *(v2u*)(U + (size_t)m * DM + col) = o; }
        }
    }
}

namespace pg8 {
struct EpiProj {
    static constexpr bool PERM = true, AFTER_DRAIN = false;
    bf16_t* QA; bf16_t* PROJ; int noepi;
    __device__ __forceinline__ void operator()(const f32x4 (&acc)[2][2][4][2], const Unit& u, int wr, int wc, int fr, int fq) const {
        if (noepi) return;
        const int row0 = u.pm * BM + wr * 64 + fr;
#pragma unroll
        for (int bj = 0; bj < 2; ++bj) {
            const int blk = u.pn * 2 + bj; if (blk == 3) continue;
            bf16_t* base; int ld, c0; if (blk < 3) { base = QA; ld = QL; c0 = blk * 128; } else { base = PROJ; ld = PW; c0 = blk * 128 - 512; }
            const int col = c0 + wc * 32 + 8 * fq;
#pragma unroll
            for (int ai = 0; ai < 2; ++ai)
#pragma unroll
                for (int m = 0; m < 4; ++m) { f32x4 v0 = acc[ai][bj][m][0], v1 = acc[ai][bj][m][1];
                    if (blk >= 28) {
#pragma unroll
                        for (int e = 0; e < 4; ++e) { v0[e] = sigm(v0[e]); v1[e] = sigm(v1[e]); } }
                    u32x4 w; w.x = cvt_pk_bf16(v0[0], v0[1]); w.y = cvt_pk_bf16(v0[2], v0[3]); w.z = cvt_pk_bf16(v1[0], v1[1]); w.w = cvt_pk_bf16(v1[2], v1[3]);
                    *(u32x4*)(base + (size_t)(row0 + ai * HALF + m * 16) * ld + col) = w; }
        }
    }
};
struct EpiQ {
    static constexpr bool PERM = true, AFTER_DRAIN = false;
    const float* RSQ; const float* ROPE; bf16_t* Q; float* QS;
    __device__ __forceinline__ void operator()(const f32x4 (&acc)[2][2][4][2], const Unit& u, int wr, int wc, int fr, int fq) const {
        const int row0 = u.pm * BM + wr * 64 + fr;
#pragma unroll
        for (int aim = 0; aim < 4; ++aim) { const int ai = aim >> 1, mb = (aim & 1) * 2;
        float rsv[4]; f32x4 csa[4][2], csb[4][2];
#pragma unroll
            for (int m = mb; m < mb + 2; ++m) { const int row = row0 + ai * HALF + m * 16; rsv[m] = RSQ[row]; const int pidx = row >= MP ? SEQ + ((row - MP) & 7) : (row & 2047);
#pragma unroll
                for (int bj = 0; bj < 2; ++bj) { const int col = u.pn * BM + bj * HALF + wc * 32 + 8 * fq; const int h = col / 96, j = col - h * 96;
                    const int i0 = j < 64 ? 0 : (j - 64) >> 1; const float* rp = ROPE + ((size_t)pidx * 16 + i0) * 2; csa[m][bj] = *(const f32x4*)rp; csb[m][bj] = *(const f32x4*)(rp + 4); } }
#pragma unroll
            for (int m = mb; m < mb + 2; ++m) {
                const int row = row0 + ai * HALF + m * 16; const float rs = rsv[m];
                const bool samp = row >= MP;
#pragma unroll
                for (int bj = 0; bj < 2; ++bj) {
                    const int col = u.pn * BM + bj * HALF + wc * 32 + 8 * fq; const int h = col / 96, j = col - h * 96;
                    float v[8];
#pragma unroll
                    for (int e = 0; e < 4; ++e) { v[e] = acc[ai][bj][m][0][e] * rs; v[4 + e] = acc[ai][bj][m][1][e] * rs; }
                    if (j < 64) {
                        if (!samp) { u32x4 w; w.x = cvt_pk_bf16(v[0] * SC2, v[1] * SC2); w.y = cvt_pk_bf16(v[2] * SC2, v[3] * SC2); w.z = cvt_pk_bf16(v[4] * SC2, v[5] * SC2); w.w = cvt_pk_bf16(v[6] * SC2, v[7] * SC2);
                            *(u32x4*)(Q + (size_t)row * 768 + col) = w; }
                        else { float* d = QS + (size_t)(row - MP) * 768 + col; *(f32x4*)d = (f32x4){v[0], v[1], v[2], v[3]}; *(f32x4*)(d + 4) = (f32x4){v[4], v[5], v[6], v[7]}; }
                    } else {
                        const int i0 = (j - 64) >> 1;
                        const f32x4 cs0 = csa[m][bj], cs1 = csb[m][bj];
                        float o1[4], o2[4];
                        o1[0] = v[0] * cs0.x - v[1] * cs0.y; o2[0] = v[1] * cs0.x + v[0] * cs0.y;
                        o1[1] = v[2] * cs0.z - v[3] * cs0.w; o2[1] = v[3] * cs0.z + v[2] * cs0.w;
                        o1[2] = v[4] * cs1.x - v[5] * cs1.y; o2[2] = v[5] * cs1.x + v[4] * cs1.y;
                        o1[3] = v[6] * cs1.z - v[7] * cs1.w; o2[3] = v[7] * cs1.z + v[6] * cs1.w;
                        const int cb = h * 96 + 64 + i0;
                        if (!samp) { unsigned* d = (unsigned*)(Q + (size_t)row * 768 + cb);
                            d[0] = cvt_pk_bf16(o1[0] * SC2, o1[1] * SC2); d[1] = cvt_pk_bf16(o1[2] * SC2, o1[3] * SC2);
                            d[8] = cvt_pk_bf16(o2[0] * SC2, o2[1] * SC2); d[9] = cvt_pk_bf16(o2[2] * SC2, o2[3] * SC2); }
                        else { float* d = QS + (size_t)(row - MP) * 768 + cb; *(f32x4*)d = (f32x4){o1[0], o1[1], o1[2], o1[3]}; *(f32x4*)(d + 16) = (f32x4){o2[0], o2[1], o2[2], o2[3]}; }
                    }
                }
            }
        }
    }
};
struct EpiKV {
    static constexpr bool PERM = true, AFTER_DRAIN = false;
    bf16_t* KN; bf16_t* V;
    __device__ __forceinline__ void operator()(const f32x4 (&acc)[2][2][4][2], const Unit& u, int wr, int wc, int fr, int fq) const {
        const int row0 = u.pm * BM + wr * 64 + fr; bf16_t* base = (u.pn < 2) ? KN : V; const int colt = (u.pn & 1) * BM + wc * 32 + 8 * fq;
#pragma unroll
        for (int ai = 0; ai < 2; ++ai)
#pragma unroll
            for (int m = 0; m < 4; ++m)
#pragma unroll
                for (int bj = 0; bj < 2; ++bj) { const f32x4 v0 = acc[ai][bj][m][0], v1 = acc[ai][bj][m][1];
                    u32x4 w; w.x = cvt_pk_bf16(v0[0], v0[1]); w.y = cvt_pk_bf16(v0[2], v0[3]); w.z = cvt_pk_bf16(v1[0], v1[1]); w.w = cvt_pk_bf16(v1[2], v1[3]);
                    *(u32x4*)(base + (size_t)(row0 + ai * HALF + m * 16) * 512 + colt + bj * HALF) = w; }
    }
};
struct MergeOrder : StaticOrder {
    __device__ __forceinline__ bool next(int i, Unit& u) const { Unit t; if (!StaticOrder::next(i >> 2, t)) return false; const int sub = i & 3; u.pm = sub * 65 + t.pm; u.pn = sub * 4 + t.pn; return true; }
    __device__ __forceinline__ bool keep(const Unit& u) const { return u.pn < 4; }
};
struct EpiMerge {
    static constexpr bool PERM = true, AFTER_DRAIN = false;
    const bf16_t* PROJ; bf16_t* MG; bf16_t* MERGED; int noepi;
    __device__ __forceinline__ void operator()(const f32x4 (&acc)[2][2][4][2], const Unit& u, int wr, int wc, int fr, int fq) const {
        const int sub = u.pn >> 2; if (sub == 0 || noepi) return;
        const int pm = u.pm - sub * 65, pn = u.pn & 3, br = sub - 1;
        const int row0 = pm * BM + wr * 64 + fr, col0 = pn * BM + wc * 32 + 8 * fq;
#pragma unroll
        for (int ai = 0; ai < 2; ++ai) {
            u32x4 gw[4][2], pw[4][2];
#pragma unroll
            for (int m = 0; m < 4; ++m)
#pragma unroll
                for (int bj = 0; bj < 2; ++bj) { const size_t row = row0 + ai * HALF + m * 16; const int col = col0 + bj * HALF;
                    gw[m][bj] = *(const u32x4*)(PROJ + row * PW + C_GM + br * DM + col);
                    if (br > 0) pw[m][bj] = *(const u32x4*)(MG + row * DM + col); }
#pragma unroll
            for (int m = 0; m < 4; ++m)
#pragma unroll
                for (int bj = 0; bj < 2; ++bj) { const size_t row = row0 + ai * HALF + m * 16; const int col = col0 + bj * HALF;
                    const u32x4 g = gw[m][bj];
                    f32x4 v0 = acc[ai][bj][m][0] * (f32x4){bflo(g.x), bfhi(g.x), bflo(g.y), bfhi(g.y)}, v1 = acc[ai][bj][m][1] * (f32x4){bflo(g.z), bfhi(g.z), bflo(g.w), bfhi(g.w)};
                    if (br > 0) { const u32x4 q = pw[m][bj]; v0 = v0 + (f32x4){bflo(q.x), bfhi(q.x), bflo(q.y), bfhi(q.y)}; v1 = v1 + (f32x4){bflo(q.z), bfhi(q.z), bflo(q.w), bfhi(q.w)}; }
                    u32x4 w; w.x = cvt_pk_bf16(v0[0], v0[1]); w.y = cvt_pk_bf16(v0[2], v0[3]); w.z = cvt_pk_bf16(v1[0], v1[1]); w.w = cvt_pk_bf16(v1[2], v1[3]);
                    *(u32x4*)((br < 2 ? MG : MERGED) + row * DM + col) = w; }
        }
    }
};
template <bool XBF> struct EpiOut {
    static constexpr bool PERM = false, AFTER_DRAIN = false;
    const float* XPf; const bf16_t* XPb; bf16_t* XO; const float* MODG; const float* BADG;
    __device__ __forceinline__ void operator()(const f32x4 (&acc)[2][2][4][2], const Unit& u, int wr, int wc, int fr, int fq) const {
        const int row0 = u.pm * BM + wr * 64 + fr, col0 = u.pn * BM + wc * 32 + 4 * fq;
        const int cb = (u.pm * BM) >> 11; const float* gr = MODG + (size_t)cb * 3072;
        f32x4 gt[2][2];
#pragma unroll
        for (int bj = 0; bj < 2; ++bj)
#pragma unroll
            for (int n = 0; n < 2; ++n) { const int col = col0 + bj * HALF + n * 16; gt[bj][n] = *(const f32x4*)(gr + col) + *(const f32x4*)(BADG + col); }
#pragma unroll
        for (int aim = 0; aim < 4; ++aim) { const int ai = aim >> 1, mb = (aim & 1) * 2;
            f32x4 xv[4][2][2];
            if constexpr (!XBF) {
#pragma unroll
                for (int m = mb; m < mb + 2; ++m)
#pragma unroll
                    for (int bj = 0; bj < 2; ++bj)
#pragma unroll
                        for (int n = 0; n < 2; ++n) xv[m][bj][n] = *(const f32x4*)(XPf + (size_t)(row0 + ai * HALF + m * 16) * DM + col0 + bj * HALF + n * 16);
            } else {
#pragma unroll
                for (int m = mb; m < mb + 2; ++m)
#pragma unroll
                    for (int bj = 0; bj < 2; ++bj)
#pragma unroll
                        for (int n = 0; n < 2; ++n) { const unsigned long long q = *(const unsigned long long*)(XPb + (size_t)(row0 + ai * HALF + m * 16) * DM + col0 + bj * HALF + n * 16); const unsigned lo = (unsigned)q, hi = (unsigned)(q >> 32);
                            xv[m][bj][n] = (f32x4){__builtin_bit_cast(float, lo << 16), __builtin_bit_cast(float, lo & 0xffff0000u), __builtin_bit_cast(float, hi << 16), __builtin_bit_cast(float, hi & 0xffff0000u)}; }
            }
#pragma unroll
            for (int m = mb; m < mb + 2; ++m)
#pragma unroll
                for (int bj = 0; bj < 2; ++bj)
#pragma unroll
                    for (int n = 0; n < 2; ++n) { const f32x4 o = xv[m][bj][n] + gt[bj][n] * acc[ai][bj][m][n];
                        unsigned long long w = (unsigned long long)cvt_pk_bf16(o[0], o[1]) | ((unsigned long long)cvt_pk_bf16(o[2], o[3]) << 32);
                        *(unsigned long long*)(XO + (size_t)(row0 + ai * HALF + m * 16) * DM + col0 + bj * HALF + n * 16) = w; }
        }
    }
};
}

__device__ __forceinline__ float out_dummy() { return 0.f; }
__device__ __forceinline__ void phase_post(const Args& a, int l, LAS unsigned char* lds, int tid, int lane, int wave) {
    GAS unsigned char* wsg_ = (GAS unsigned char*)a.ws; asm volatile("" : "+s"(wsg_)); unsigned char* ws = (unsigned char*)wsg_;     float* out = a.out;
    const bf16* PROJ = (const bf16*)(ws + WS_PROJ); const bf16* QA = (const bf16*)(ws + WS_QA);
    float* RSQ = (float*)(ws + WS_RSQ); const float* ROPE = (const float*)(ws + WS_ROPE);
    bf16* CKV = (bf16*)(ws + WS_CKV); bf16* KPE = (bf16*)(ws + WS_KPE); bf16* ACONV = (bf16*)(ws + WS_A4) + 2 * A4_STRIDE;
    float* SC = (float*)(ws + WS_SC); float* BONUS = (float*)(ws + WS_BONUS);
    const int c4 = 4 * lane;
    const f32x4 gkv = *(const f32x4*)(INF(I_KVNG) + l * KVL + c4);
    const f32x4 cw0 = *(const f32x4*)(INF(I_CONVW) + (l * 3 + 0) * DC + c4), cw1 = *(const f32x4*)(INF(I_CONVW) + (l * 3 + 1) * DC + c4), cw2 = *(const f32x4*)(INF(I_CONVW) + (l * 3 + 2) * DC + c4);
    const float* mu = INF(I_MU) + l * SW;
    const f32x4 mu_r = *(const f32x4*)(mu + c4), mu_k = *(const f32x4*)(mu + 256 + c4), mu_v = *(const f32x4*)(mu + 512 + c4);
    const float mu_w = mu[768 + lane], mu_a = mu[832 + lane];
    const f32x4 w0v = *(const f32x4*)(INF(I_W0) + l * DR + c4), a0v = *(const f32x4*)(INF(I_A0) + l * DR + c4), kkv = *(const f32x4*)(INF(I_KK) + l * DR + c4),
                kav = *(const f32x4*)(INF(I_KA) + l * DR + c4), rkv = *(const f32x4*)(INF(I_RK) + l * DR + c4);
    constexpr int XS = 144, XB_OFF = 80 * XS, RL_OFF = 2 * 80 * XS, RL_MAT = 65 * 512;
    const unsigned char* wl = ws + WS_W + (size_t)l * LW_STRIDE;
    for (int bk = blockIdx.x; bk < MT / 65; bk += gridDim.x) {
    const int m0 = bk * 65;
    for (int r = wave; r < 80; r += NWAVES) {
        float tw = 0.f, ai = 0.f;
        if (r < 65) { const int m = m0 + r; int b, t, T, cb, pidx; row_info(m, b, t, T, cb, pidx); const bool samp = m >= MP;
            const bf16* R = PROJ + (size_t)m * PW + C_RW; const float* sprev = INF(I_SSHIFT) + (size_t)(l * NB_S + b) * SW;
            const float cwi = bf1(R[768 + lane]), cai = bf1(R[832 + lane]); float pwi = 0.f, pai = 0.f;
            if (t >= 1) { pwi = bf1(R[768 + lane - PW]); pai = bf1(R[832 + lane - PW]); } else if (samp) { pwi = sprev[768 + lane]; pai = sprev[832 + lane]; }
            const float wi = cwi + mu_w * (pwi - cwi); ai = cai + mu_a * (pai - cai); tw = 1.0f - 2.0f * frcp(fexp(2.0f * wi) + 1.0f); }
        *(LAS bf16*)(lds + r * XS + lane * 2) = (bf16)f2bf(tw); *(LAS bf16*)(lds + XB_OFF + r * XS + lane * 2) = (bf16)f2bf(ai);
    }
    __syncthreads();
    { const int fr = lane & 15, fq = lane >> 4;
      bf16x8 wf[2][2][2];
#pragma unroll
      for (int lo = 0; lo < 2; ++lo)
#pragma unroll
          for (int q = 0; q < 2; ++q)
#pragma unroll
              for (int ks = 0; ks < 2; ++ks) wf[lo][q][ks] = *(const bf16x8*)((const bf16*)(wl + (lo ? LW_A2T : LW_W2T)) + (size_t)(16 * (2 * wave + q) + fr) * WL + 32 * ks + 8 * fq);
      for (int rt = 0; rt < 5; ++rt) {
          pg8::f32x4 acc[2][2];
#pragma unroll
          for (int lo = 0; lo < 2; ++lo)
#pragma unroll
              for (int q = 0; q < 2; ++q) acc[lo][q] = (pg8::f32x4){0.f, 0.f, 0.f, 0.f};
#pragma unroll
          for (int ks = 0; ks < 2; ++ks) {
              const bf16x8 xa = *(const LAS bf16x8*)(lds + (16 * rt + fr) * XS + (32 * ks + 8 * fq) * 2), xb = *(const LAS bf16x8*)(lds + XB_OFF + (16 * rt + fr) * XS + (32 * ks + 8 * fq) * 2);
#pragma unroll
              for (int q = 0; q < 2; ++q) { acc[0][q] = __builtin_amdgcn_mfma_f32_16x16x32_bf16(wf[0][q][ks], xa, acc[0][q], 0, 0, 0); acc[1][q] = __builtin_amdgcn_mfma_f32_16x16x32_bf16(wf[1][q][ks], xb, acc[1][q], 0, 0, 0); } }
          const int row = 16 * rt + fr;
          if (row < 65) {
#pragma unroll
              for (int lo = 0; lo < 2; ++lo)
#pragma unroll
                  for (int q = 0; q < 2; ++q) { v2u o; o.x = pk2(acc[lo][q][0], acc[lo][q][1]); o.y = pk2(acc[lo][q][2], acc[lo][q][3]);
                      *(LAS v2u*)(lds + RL_OFF + lo * RL_MAT + row * 512 + (16 * (2 * wave + q) + 4 * fq) * 2) = o; } }
      } }
    __syncthreads();
    struct PostRaw { unsigned qa[3]; v2u kv, cc0, cx0, cc1, cx1, cc2, cx2, cb, zc, r0, k0, v0, r1, k1, v1; float kr1, kr2, cwi, cai, cs, sn; };
    auto load_row = [&](int rowi, PostRaw& w) {
        const int m = m0 + rowi; int b, t, T, cb_, pidx; row_info(m, b, t, T, cb_, pidx);
        const bf16* P = PROJ + (size_t)m * PW; const unsigned* q = (const unsigned*)(QA + (size_t)m * QL);
#pragma unroll
        for (int i = 0; i < 3; ++i) w.qa[i] = q[lane + 64 * i];
        w.kv = *(const v2u*)(P + C_KV + c4);
        w.kr1 = bf1(P[C_KR + (lane & 15)]); w.kr2 = bf1(P[C_KR + 16 + (lane & 15)]); w.cs = ROPE[((size_t)pidx * 16 + (lane & 15)) * 2]; w.sn = ROPE[((size_t)pidx * 16 + (lane & 15)) * 2 + 1];
        w.cc0 = *(const v2u*)(P + C_CC + c4); w.cx0 = *(const v2u*)(P + C_CX + c4); w.cb = *(const v2u*)(P + C_CB + c4); w.zc = *(const v2u*)(P + C_ZC + c4);
        const v2u z2 = {0u, 0u};
        w.cc1 = z2; w.cx1 = z2; w.cc2 = z2; w.cx2 = z2; w.r1 = z2; w.k1 = z2; w.v1 = z2;
        if (t >= 1) { w.cc1 = *(const v2u*)(P - PW + C_CC + c4); w.cx1 = *(const v2u*)(P - PW + C_CX + c4);
            w.r1 = *(const v2u*)(P - PW + C_RW + c4); w.k1 = *(const v2u*)(P - PW + C_RW + 256 + c4); w.v1 = *(const v2u*)(P - PW + C_RW + 512 + c4); }
        if (t >= 2) { w.cc2 = *(const v2u*)(P - 2 * PW + C_CC + c4); w.cx2 = *(const v2u*)(P - 2 * PW + C_CX + c4); }
        w.r0 = *(const v2u*)(P + C_RW + c4); w.k0 = *(const v2u*)(P + C_RW + 256 + c4); w.v0 = *(const v2u*)(P + C_RW + 512 + c4);
        w.cwi = bf1(P[C_RW + 768 + lane]); w.cai = bf1(P[C_RW + 832 + lane]);
    };
#define UNPK(w_) ((f32x4){bflo((w_).x), bfhi((w_).x), bflo((w_).y), bfhi((w_).y)})
    PostRaw nxt; load_row(wave, nxt);
    for (int rowi = wave; rowi < 65; rowi += NWAVES) {
        const PostRaw w = nxt;
        if (rowi + NWAVES < 65) load_row(rowi + NWAVES, nxt);
        const int m = m0 + rowi;
        int b, t, T, cb, pidx; row_info(m, b, t, T, cb, pidx); const bool samp = m >= MP;
        { float ss = 0.f;
#pragma unroll
          for (int i = 0; i < 3; ++i) { const float x = bflo(w.qa[i]), y = bfhi(w.qa[i]); ss += x * x + y * y; }
          ss = wave_sum(ss); if (lane == 0) RSQ[m] = frsq(ss * (1.f / QL) + RMS_EPS); }
        { f32x4 x = UNPK(w.kv);
          const float ss = wave_sum((x.x * x.x + x.y * x.y) + (x.z * x.z + x.w * x.w)); const float rs = frsq(ss * (1.f / KVL) + RMS_EPS);
          x = x * rs * gkv;
          float* o = samp ? out + O_CKVS + ((size_t)l * MS + (m - MP)) * KVL : out + O_CKVP + ((size_t)l * MP + m) * KVL;
          *(f32x4*)(o + c4) = x; v2u ob; ob.x = pk2(x.x, x.y); ob.y = pk2(x.z, x.w); *(v2u*)(CKV + (size_t)m * KVL + c4) = ob; }
        if (lane < 16) { const float o1 = w.kr1 * w.cs - w.kr2 * w.sn, o2 = w.kr2 * w.cs + w.kr1 * w.sn;
          float* o = samp ? out + O_KPES + ((size_t)l * MS + (m - MP)) * QKR : out + O_KPEP + ((size_t)l * MP + m) * QKR;
          o[lane] = o1; o[16 + lane] = o2; KPE[(size_t)m * QKR + lane] = (bf16)f2bf(o1); KPE[(size_t)m * QKR + 16 + lane] = (bf16)f2bf(o2); }
        { const f32x4 p0 = UNPK(w.cc0) * UNPK(w.cx0);
          f32x4 p1 = UNPK(w.cc1) * UNPK(w.cx1), p2 = UNPK(w.cc2) * UNPK(w.cx2);
          if (samp && t < 2) { const float* sconv = INF(I_SCONV) + ((size_t)(l * NB_S + b) * 2) * DC + c4;
              if (t == 0) { p1 = *(const f32x4*)(sconv + DC); p2 = *(const f32x4*)(sconv); } else p2 = *(const f32x4*)(sconv + DC); }
          const f32x4 cv = p2 * cw0 + p1 * cw1 + p0 * cw2;
          const v2u wz = w.zc;
          const f32x4 o = (f32x4){silu(bflo(wz.x)), silu(bfhi(wz.x)), silu(bflo(wz.y)), silu(bfhi(wz.y))} * UNPK(w.cb) * cv;
          v2u ob; ob.x = pk2(o.x, o.y); ob.y = pk2(o.z, o.w); *(v2u*)(ACONV + (size_t)m * DC + c4) = ob;
          if (t >= T - 2) { float* so = samp ? out + O_CONVS + (((size_t)l * NB_S + b) * 2 + (t - (T - 2))) * DC : out + O_CONVP + (((size_t)l * NB_P + b) * 2 + (t - (T - 2))) * DC;
              *(f32x4*)(so + c4) = p0; } }
        { const f32x4 cr = UNPK(w.r0), ck = UNPK(w.k0), cv_ = UNPK(w.v0); const float cwi = w.cwi, cai = w.cai;
          f32x4 pr = UNPK(w.r1), pk = UNPK(w.k1), pv = UNPK(w.v1);
          if (samp && t == 0) { const float* sprev = INF(I_SSHIFT) + (size_t)(l * NB_S + b) * SW; pr = *(const f32x4*)(sprev + c4); pk = *(const f32x4*)(sprev + 256 + c4); pv = *(const f32x4*)(sprev + 512 + c4); }
          if (t == T - 1) { float* so = samp ? out + O_SHS + ((size_t)l * NB_S + b) * SW : out + O_SHP + ((size_t)l * NB_P + b) * SW;
              *(f32x4*)(so + c4) = cr; *(f32x4*)(so + 256 + c4) = ck; *(f32x4*)(so + 512 + c4) = cv_; so[768 + lane] = cwi; so[832 + lane] = cai; }
          const f32x4 r = cr + mu_r * (pr - cr), k = ck + mu_k * (pk - ck), v = cv_ + mu_v * (pv - cv_);
          f32x4 accw = w0v, acca = a0v;
          { const v2u lw = *(const LAS v2u*)(lds + RL_OFF + rowi * 512 + c4 * 2), la = *(const LAS v2u*)(lds + RL_OFF + RL_MAT + rowi * 512 + c4 * 2);
            accw += UNPK(lw); acca += UNPK(la); }
          f32x4 dec, av;
#pragma unroll
          for (int e = 0; e < 4; ++e) { const float x = -accw[e];
              const float sp = fmaxf(x, 0.f) + __logf(1.0f + fexp(-fabsf(x))); const float wlog = -sp - 0.5f; dec[e] = fexp(-fexp(wlog)); av[e] = sigm(acca[e]); }
          f32x4 kk = k * kkv; const float ssq = grp16_sum((kk.x * kk.x + kk.y * kk.y) + (kk.z * kk.z + kk.w * kk.w)); kk = kk * frcp(fmaxf(sqrtf(ssq), 1e-12f));
          const f32x4 k2 = k * ((av - 1.0f) * kav + 1.0f);
          const f32x4 rkk = r * k2 * rkv; const float bon = grp16_sum((rkk.x + rkk.y) + (rkk.z + rkk.w));
          float* sc = SC + (size_t)m * 6 * DR + c4;
          *(f32x4*)(sc) = r; *(f32x4*)(sc + DR) = dec; *(f32x4*)(sc + 2 * DR) = k2; *(f32x4*)(sc + 3 * DR) = v; *(f32x4*)(sc + 4 * DR) = kk; *(f32x4*)(sc + 5 * DR) = kk * av;
          *(f32x4*)(BONUS + (size_t)m * DR + c4) = v * bon; }
    }
#undef UNPK
    __syncthreads();
    }
}

__device__ __forceinline__ void phase_qlat(const Args& a, int l, int lane, int wave) {
    GAS unsigned char* wsg_ = (GAS unsigned char*)a.ws; asm volatile("" : "+s"(wsg_)); unsigned char* ws = (unsigned char*)wsg_;
    const int gw = blockIdx.x * NWAVES + wave, NGW = gridDim.x * NWAVES;
    const float* QS = (const float*)(ws + WS_QS); bf16* QLT = (bf16*)(ws + WS_QLAT); const float* wuk = INF(I_WUK) + (size_t)l * KVL * 512;
    for (int task = gw; task < MS * NH; task += NGW) {
        const int mm = task >> 3, h = task & 7, b = mm >> 3, t = mm & 7, r = t * 8 + h;
        const float* q = QS + (size_t)mm * 768 + h * 96;
        const float qn = q[lane];
        bf16* dst = QLT + ((size_t)b * 64 + r) * 288;
#pragma unroll
        for (int ci = 0; ci < 4; ++ci) { const int c = lane + 64 * ci; const f32x4* wr = (const f32x4*)(wuk + ((size_t)c * NH + h) * 64); float acc = 0.f;
#pragma unroll
            for (int n4 = 0; n4 < 16; ++n4) { const f32x4 w = wr[n4]; acc += w.x * RDL(qn, 4 * n4) + w.y * RDL(qn, 4 * n4 + 1) + w.z * RDL(qn, 4 * n4 + 2) + w.w * RDL(qn, 4 * n4 + 3); }
            dst[c] = (bf16)f2bf(acc * SC2); }
        if (lane < 32) dst[256 + lane] = (bf16)f2bf(q[64 + lane] * SC2);
    }
}

__device__ __forceinline__ void glds16(const void* gsrc, unsigned lds_dst) { unsigned keep;
    asm volatile("s_mov_b32 %0, m0\n\ts_mov_b32 m0, %2\n\ts_nop 0\n\tglobal_load_lds_dwordx4 %1, off\n\ts_mov_b32 m0, %0" : "=&s"(keep) : "v"(gsrc), "s"(lds_dst) : "memory"); }
#define MFMA32(a_, b_, c_) __builtin_amdgcn_mfma_f32_32x32x16_bf16((a_), (b_), (c_), 0, 0, 0)
__device__ __forceinline__ bf16x8 pack8(const f32x16& x, int s) {
    v4u p; p.x = pk2(x[8 * s], x[8 * s + 1]); p.y = pk2(x[8 * s + 2], x[8 * s + 3]); p.z = pk2(x[8 * s + 4], x[8 * s + 5]); p.w = pk2(x[8 * s + 6], x[8 * s + 7]);
    return __builtin_bit_cast(bf16x8, p);
}
__device__ __forceinline__ bf16x8 vt_frag(const LAS unsigned char* p0, int rowstride8) {
    const s16x4 lo = __builtin_bit_cast(s16x4, __builtin_amdgcn_ds_read_tr16_b64_v4i16((LAS v4i16_t*)p0));
    const s16x4 hi = __builtin_bit_cast(s16x4, __builtin_amdgcn_ds_read_tr16_b64_v4i16((LAS v4i16_t*)(p0 + rowstride8)));
    bf16x8 r; r[0] = lo[0]; r[1] = lo[1]; r[2] = lo[2]; r[3] = lo[3]; r[4] = hi[0]; r[5] = hi[1]; r[6] = hi[2]; r[7] = hi[3]; return r;
}

constexpr int PA_KS = 208, PA_VS = 144;
constexpr int PA_KBYTES = 64 * PA_KS, PA_VBYTES = 64 * PA_VS, PA_BUF = PA_KBYTES + PA_VBYTES;
__device__ __forceinline__ void phase_attn_prompt(const Args& a, LAS unsigned char* lds, int tid, int lane, int wave, unsigned* qctr, volatile LAS unsigned* qslot) {
    GAS unsigned char* wsg_ = (GAS unsigned char*)a.ws; asm volatile("" : "+s"(wsg_)); unsigned char* ws = (unsigned char*)wsg_;
    const bf16* Q = (const bf16*)(ws + WS_Q); const bf16* KN = (const bf16*)(ws + WS_KN); const bf16* KPE = (const bf16*)(ws + WS_KPE); const bf16* V = (const bf16*)(ws + WS_V);
    const bf16* PROJ = (const bf16*)(ws + WS_PROJ); bf16* AMLA = (bf16*)(ws + WS_A4);
    const int r32 = lane & 31, h2 = lane >> 5;
    for (;;) {
        {
            if (tid == 0) *qslot = __hip_atomic_fetch_add(qctr, 1u, __ATOMIC_RELAXED, __HIP_MEMORY_SCOPE_AGENT);
            __syncthreads();
            const int u = (int)*qslot;
            __syncthreads();
            if (u >= 512) break;
            const int qb = 7 - (u >> 6), bh = u & 63, b = bh >> 3, h = bh & 7;
            const int q0w = qb * 256 + wave * 32;
            const size_t tok0 = (size_t)b * SEQ;
            bf16x8 Bq[6];
#pragma unroll
            for (int ks = 0; ks < 6; ++ks) Bq[ks] = *(const bf16x8*)(Q + (tok0 + q0w + r32) * 768 + h * 96 + 16 * ks + 8 * h2);
            f32x16 O0, O1;
#pragma unroll
            for (int i = 0; i < 16; ++i) { O0[i] = 0.f; O1[i] = 0.f; }
            float mrun = -INFINITY, lrun = 0.f;
            const int ntile = 4 * qb + 4;
            const int krow = tid >> 3, kch = tid & 7, prow = (tid & 255) >> 2, pch = tid & 3;
            v4u gkA, gpA, gvA, gkB, gpB, gvB;
            auto issue = [&](int kt, v4u& gk, v4u& gp, v4u& gv) { const size_t tk = tok0 + (size_t)kt * 64 + krow;
                gk = *(const v4u*)(KN + tk * 512 + h * 64 + kch * 8); gv = *(const v4u*)(V + tk * 512 + h * 64 + kch * 8); gp = *(const v4u*)(KPE + (tok0 + (size_t)kt * 64 + prow) * QKR + pch * 8); };
            auto stash = [&](int bufi, const v4u& gk, const v4u& gp, const v4u& gv) { LAS unsigned char* kn = lds + bufi * PA_BUF; LAS unsigned char* vn = kn + PA_KBYTES;
                *(LAS v4u*)(kn + krow * PA_KS + kch * 16) = gk; *(LAS v4u*)(vn + krow * PA_VS + kch * 16) = gv; if (tid < 256) *(LAS v4u*)(kn + prow * PA_KS + 128 + pch * 16) = gp; };
#define PA_BAR() do { LDS_WAIT(); __builtin_amdgcn_s_barrier(); asm volatile("" ::: "memory"); } while (0)
            auto compute = [&](int kt, int bufi) {
                const LAS unsigned char* kb = lds + bufi * PA_BUF; const LAS unsigned char* vb = kb + PA_KBYTES;
                if (kt * 64 <= q0w + 31) {
                    f32x16 S0, S1;
#pragma unroll
                    for (int i = 0; i < 16; ++i) { S0[i] = 0.f; S1[i] = 0.f; }
#pragma unroll
                    for (int kh = 0; kh < 2; ++kh) {
                        bf16x8 kf0[3], kf1[3];
#pragma unroll
                        for (int k3 = 0; k3 < 3; ++k3) { const int ks = 3 * kh + k3;
                            kf0[k3] = *(const LAS bf16x8*)(kb + r32 * PA_KS + ks * 32 + h2 * 16); kf1[k3] = *(const LAS bf16x8*)(kb + (32 + r32) * PA_KS + ks * 32 + h2 * 16); }
                        asm volatile("" : "+v"(kf0[0]), "+v"(kf0[1]), "+v"(kf0[2]), "+v"(kf1[0]), "+v"(kf1[1]), "+v"(kf1[2]));
#pragma unroll
                        for (int k3 = 0; k3 < 3; ++k3) { S0 = MFMA32(kf0[k3], Bq[3 * kh + k3], S0); S1 = MFMA32(kf1[k3], Bq[3 * kh + k3], S1); }
                    }
                    if (kt * 64 + 63 > q0w) {
                        const int qq = q0w + r32, kbase = kt * 64 + 4 * h2;
#pragma unroll
                        for (int i = 0; i < 16; ++i) { const int key = kbase + (i & 3) + 8 * (i >> 2); if (key > qq) S0[i] = -INFINITY; if (key + 32 > qq) S1[i] = -INFINITY; }
                    }
                    float mx = S0[0];
#pragma unroll
                    for (int i = 1; i < 16; ++i) mx = fmaxf(mx, S0[i]);
#pragma unroll
                    for (int i = 0; i < 16; ++i) mx = fmaxf(mx, S1[i]);
                    mx = fmaxf(mx, SHX(mx, 32));
                    const float mnew = fmaxf(mrun, mx);
                    if (__builtin_amdgcn_ballot_w64(mnew > mrun)) {
                        const float alpha = __builtin_amdgcn_exp2f(mrun - mnew); mrun = mnew; lrun *= alpha;
#pragma unroll
                        for (int i = 0; i < 16; ++i) { O0[i] *= alpha; O1[i] *= alpha; }
                    }
                    float ps = 0.f;
#pragma unroll
                    for (int i = 0; i < 16; ++i) { S0[i] = __builtin_amdgcn_exp2f(S0[i] - mrun); S1[i] = __builtin_amdgcn_exp2f(S1[i] - mrun); ps += S0[i] + S1[i]; }
                    lrun += ps;
                    const int g = lane >> 4, li = lane & 15, cg = g & 1, tq = li >> 2, tp = li & 3;
                    const LAS unsigned char* vbase = vb + (4 * h2 + tq) * PA_VS + (16 * cg + 4 * tp) * 2;
#pragma unroll
                    for (int sub = 0; sub < 2; ++sub)
                    {   const LAS unsigned char* vp0 = vbase + (32 * sub) * PA_VS; const LAS unsigned char* vp1 = vp0 + 16 * PA_VS;
                        bf16x8 va = vt_frag(vp0, 8 * PA_VS), vb_ = vt_frag(vp0 + 64, 8 * PA_VS), vc = vt_frag(vp1, 8 * PA_VS), vd = vt_frag(vp1 + 64, 8 * PA_VS);
                        const bf16x8 pb0 = pack8(sub == 0 ? S0 : S1, 0), pb1 = pack8(sub == 0 ? S0 : S1, 1);
                        asm volatile("" : "+v"(va), "+v"(vb_), "+v"(vc), "+v"(vd));
                        O0 = MFMA32(va, pb0, O0); O1 = MFMA32(vb_, pb0, O1); O0 = MFMA32(vc, pb1, O0); O1 = MFMA32(vd, pb1, O1);
                    }
                }
            };
            issue(0, gkA, gpA, gvA); issue(1, gkB, gpB, gvB); stash(0, gkA, gpA, gvA); PA_BAR();
            for (int kt = 0; kt < ntile - 2; kt += 2) {
                issue(kt + 2, gkA, gpA, gvA); compute(kt, 0); stash(1, gkB, gpB, gvB); PA_BAR();
                issue(kt + 3, gkB, gpB, gvB); compute(kt + 1, 1); stash(0, gkA, gpA, gvA); PA_BAR();
            }
            compute(ntile - 2, 0); stash(1, gkB, gpB, gvB); PA_BAR();
            compute(ntile - 1, 1);
            const float ltot = lrun + SHX(lrun, 32); const float inv = frcp(ltot);
            const size_t row = tok0 + q0w + r32;
            v2u zz[2][4];
#pragma unroll
            for (int dt = 0; dt < 2; ++dt)
#pragma unroll
                for (int g4 = 0; g4 < 4; ++g4) zz[dt][g4] = *(const v2u*)(PROJ + row * PW + C_ZM + h * 64 + dt * 32 + 8 * g4 + 4 * h2);
#pragma unroll
            for (int dt = 0; dt < 2; ++dt)
#pragma unroll
                for (int g4 = 0; g4 < 4; ++g4) { const int d0 = dt * 32 + 8 * g4 + 4 * h2;
                    const v2u zw = zz[dt][g4];
                    const f32x16& O = dt == 0 ? O0 : O1;
                    const float o0 = O[4 * g4] * inv * silu(bflo(zw.x)), o1 = O[4 * g4 + 1] * inv * silu(bfhi(zw.x)), o2 = O[4 * g4 + 2] * inv * silu(bflo(zw.y)), o3 = O[4 * g4 + 3] * inv * silu(bfhi(zw.y));
                    v2u ob; ob.x = pk2(o0, o1); ob.y = pk2(o2, o3); *(v2u*)(AMLA + (size_t)(h >> 2) * A4_STRIDE + row * 256 + (h & 3) * 64 + d0) = ob; }
        }
    }
}

constexpr int RA_SUB = 8, RA_STEP = 6 * 256, RA_BUF = RA_SUB * RA_STEP;
__device__ __forceinline__ float dpp_xor1(float x) { return __builtin_bit_cast(float, __builtin_amdgcn_update_dpp(0, __builtin_bit_cast(int, x), 0xB1, 0xF, 0xF, true)); }
__device__ __forceinline__ float dpp_xor2(float x) { return __builtin_bit_cast(float, __builtin_amdgcn_update_dpp(0, __builtin_bit_cast(int, x), 0x4E, 0xF, 0xF, true)); }

__device__ __forceinline__ void phase_rwkvA(const Args& a, LAS unsigned char* lds, int tid, int lane, int wave) {
    GAS unsigned char* wsg_ = (GAS unsigned char*)a.ws; asm volatile("" : "+s"(wsg_)); unsigned char* ws = (unsigned char*)wsg_;
    const float* SC = (const float*)(ws + WS_SC); float* YL = (float*)(ws + WS_YL); float* YP = (float*)(ws + WS_YP); float* QC = (float*)(ws + WS_QC); bf16* PC = (bf16*)(ws + WS_PC);
    const int pr = wave >> 1, part = wave & 1;
    const int ib = lane >> 2, jb = lane & 3;
    const int pt = part * 64 + lane;
    LAS unsigned char* mybuf = lds + pr * (2 * RA_BUF);
    for (int bk = blockIdx.x; bk < 8 * RNC; bk += gridDim.x) {
        const int seq = bk / (RNC / 4), c = (bk % (RNC / 4)) * 4 + pr, b = seq >> 2, h = seq & 3;
        const size_t m0 = (size_t)b * SEQ + (size_t)c * RCL;
        f32x2 S[4][8];
#pragma unroll
        for (int r = 0; r < 4; ++r)
#pragma unroll
            for (int pp = 0; pp < 8; ++pp) { S[r][pp].x = (part == 1 && (4 * ib + r) == (16 * jb + 2 * pp)) ? 1.f : 0.f; S[r][pp].y = (part == 1 && (4 * ib + r) == (16 * jb + 2 * pp + 1)) ? 1.f : 0.f; }
        f32x4 stg[6];
        auto stage_load = [&](int sub) {
#pragma unroll
            for (int i = 0; i < 6; ++i) { const int q = pt + 128 * i, st = q / 96, rem = q - st * 96, vec = rem >> 4, ch = rem & 15;
                const int srcv = vec == 0 ? 4 : vec == 1 ? 1 : vec == 2 ? 5 : vec == 3 ? 2 : vec == 4 ? 0 : 3;
                stg[i] = *(const f32x4*)(SC + (m0 + sub * RA_SUB + st) * 6 * DR + srcv * DR + h * 64 + ch * 4); }
        };
        auto stage_store = [&](int buf) {
#pragma unroll
            for (int i = 0; i < 6; ++i) { const int q = pt + 128 * i, st = q / 96, rem = q - st * 96;
                *(LAS f32x4*)(mybuf + buf * RA_BUF + st * RA_STEP + rem * 16) = stg[i]; }
        };
        stage_load(0); stage_store(0); __syncthreads();
        for (int sub = 0; sub < RCL / RA_SUB; ++sub) {
            const bool more = sub + 1 < RCL / RA_SUB;
            if (more) stage_load(sub + 1);
            const LAS unsigned char* cur = mybuf + (sub & 1) * RA_BUF;
            for (int st = 0; st < RA_SUB; ++st) {
                const LAS f32x4* base = (const LAS f32x4*)(cur + st * RA_STEP);
                const LAS f32x2* b2 = (const LAS f32x2*)base;
                f32x2 sa2[4];
#pragma unroll
                for (int r = 0; r < 4; ++r) sa2[r] = (f32x2){0.f, 0.f};
#pragma unroll
                for (int pp = 0; pp < 8; ++pp) { const f32x2 kq = b2[8 * jb + pp];
#pragma unroll
                    for (int r = 0; r < 4; ++r) sa2[r] += S[r][pp] * kq; }
                float sa[4];
#pragma unroll
                for (int r = 0; r < 4; ++r) { float t = -(sa2[r].x + sa2[r].y); t += dpp_xor1(t); t += dpp_xor2(t); sa[r] = t; }
                f32x4 vv = base[80 + ib]; if (part == 1) vv = (f32x4){0.f, 0.f, 0.f, 0.f};
                f32x2 y2[4];
#pragma unroll
                for (int r = 0; r < 4; ++r) y2[r] = (f32x2){0.f, 0.f};
#pragma unroll
                for (int pp = 0; pp < 8; ++pp) { const f32x2 wq = b2[32 + 8 * jb + pp], bq = b2[64 + 8 * jb + pp], kq = b2[96 + 8 * jb + pp], rq = b2[128 + 8 * jb + pp];
#pragma unroll
                    for (int r = 0; r < 4; ++r) { const f32x2 sar = {sa[r], sa[r]}, vr = {vv[r], vv[r]};
                        S[r][pp] = S[r][pp] * wq + (sar * bq + vr * kq); y2[r] += S[r][pp] * rq; } }
                float y[4];
#pragma unroll
                for (int r = 0; r < 4; ++r) { float t = y2[r].x + y2[r].y; t += dpp_xor1(t); t += dpp_xor2(t); y[r] = t; }
                if (jb == 0) { float* yo = (part == 1 ? YP : YL) + (m0 + sub * RA_SUB + st) * DR + h * 64 + 4 * ib; *(f32x4*)yo = (f32x4){y[0], y[1], y[2], y[3]}; }
            }
            if (more) stage_store((sub + 1) & 1);
            __syncthreads();
        }
        const size_t cb = (((size_t)seq * RNC + c) * 64 + 4 * ib) * 64 + 16 * jb;
        if (part == 0) {
#pragma unroll
            for (int r = 0; r < 4; ++r)
#pragma unroll
                for (int q = 0; q < 4; ++q) *(f32x4*)(QC + cb + r * 64 + 4 * q) = (f32x4){S[r][2 * q].x, S[r][2 * q].y, S[r][2 * q + 1].x, S[r][2 * q + 1].y};
        } else {
#pragma unroll
            for (int r = 0; r < 4; ++r)
#pragma unroll
                for (int q = 0; q < 2; ++q) { v4u w; w.x = pk2(S[r][4 * q].x, S[r][4 * q].y); w.y = pk2(S[r][4 * q + 1].x, S[r][4 * q + 1].y); w.z = pk2(S[r][4 * q + 2].x, S[r][4 * q + 2].y); w.w = pk2(S[r][4 * q + 3].x, S[r][4 * q + 3].y);
                    *(v4u*)(PC + cb + r * 64 + 8 * q) = w; }
        }
    }
}

constexpr int RB_BUF = 24576;
__device__ __forceinline__ void rwkv_chain(const Args& a, int l, LAS unsigned char* lds, int lane, int seq) {
    GAS unsigned char* wsg_ = (GAS unsigned char*)a.ws; asm volatile("" : "+s"(wsg_)); unsigned char* ws = (unsigned char*)wsg_;
    const float* QC = (const float*)(ws + WS_QC); const bf16* PC = (const bf16*)(ws + WS_PC); float* SALL = (float*)(ws + WS_SALL);
    const int r32 = lane & 31, h2 = lane >> 5, g = lane >> 4, li = lane & 15, cg = g & 1, tq = li >> 2, tp = li & 3;
    f32x16 St[2][2];
#pragma unroll
    for (int x = 0; x < 2; ++x)
#pragma unroll
        for (int y = 0; y < 2; ++y)
#pragma unroll
            for (int q = 0; q < 16; ++q) St[x][y][q] = 0.f;
    const unsigned lds0 = (unsigned)(uintptr_t)lds;
    auto dma = [&](int c) {
        const size_t cbase = ((size_t)seq * RNC + c) * 4096; const unsigned bb = lds0 + (c % 3) * RB_BUF;
#pragma unroll
        for (int x = 0; x < 8; ++x) glds16(PC + cbase + (size_t)(lane + 64 * x) * 8, (unsigned)__builtin_amdgcn_readfirstlane(bb + x * 1024));
#pragma unroll
        for (int jt = 0; jt < 2; ++jt)
#pragma unroll
            for (int it = 0; it < 2; ++it)
#pragma unroll
                for (int g4 = 0; g4 < 4; ++g4)
                    glds16(QC + cbase + (size_t)(32 * it + r32) * 64 + 32 * jt + 8 * g4 + 4 * h2, (unsigned)__builtin_amdgcn_readfirstlane(bb + 8192 + ((jt * 2 + it) * 4 + g4) * 1024));
    };
    dma(0); dma(1);
    for (int c = 0; c < RNC; ++c) {
        const size_t cbase = ((size_t)seq * RNC + c) * 4096; const LAS unsigned char* bb = lds + (c % 3) * RB_BUF;
        if (c == 0) asm volatile("s_waitcnt vmcnt(24)" ::: "memory"); else if (c == 1) asm volatile("s_waitcnt vmcnt(40)" ::: "memory");
        else if (c == RNC - 1) asm volatile("s_waitcnt vmcnt(32)" ::: "memory"); else asm volatile("s_waitcnt vmcnt(56)" ::: "memory");
        if (c + 2 < RNC) dma(c + 2);
        asm volatile("" ::: "memory");
        f32x16 D[2][2];
#pragma unroll
        for (int jt = 0; jt < 2; ++jt)
#pragma unroll
            for (int it = 0; it < 2; ++it)
#pragma unroll
                for (int g4 = 0; g4 < 4; ++g4) { const size_t off = cbase + (size_t)(32 * it + r32) * 64 + 32 * jt + 8 * g4 + 4 * h2;
                    *(GAS f32x4*)((GAS float*)SALL + off) = (f32x4){St[jt][it][4 * g4], St[jt][it][4 * g4 + 1], St[jt][it][4 * g4 + 2], St[jt][it][4 * g4 + 3]};
                    const f32x4 qv = *(const LAS f32x4*)(bb + 8192 + ((jt * 2 + it) * 4 + g4) * 1024 + lane * 16);
                    D[jt][it][4 * g4] = qv.x; D[jt][it][4 * g4 + 1] = qv.y; D[jt][it][4 * g4 + 2] = qv.z; D[jt][it][4 * g4 + 3] = qv.w; }
#pragma unroll
        for (int kt = 0; kt < 2; ++kt)
#pragma unroll
            for (int s = 0; s < 2; ++s) {
                const bf16x8 b0 = pack8(St[kt][0], s), b1 = pack8(St[kt][1], s);
                const LAS unsigned char* pp = bb + (32 * kt + 16 * s + 4 * h2 + tq) * 128 + (16 * cg + 4 * tp) * 2;
                const bf16x8 a0 = vt_frag(pp, 8 * 128), a1 = vt_frag(pp + 64, 8 * 128);
                D[0][0] = MFMA32(a0, b0, D[0][0]); D[0][1] = MFMA32(a0, b1, D[0][1]); D[1][0] = MFMA32(a1, b0, D[1][0]); D[1][1] = MFMA32(a1, b1, D[1][1]);
            }
        LDS_WAIT(); asm volatile("" ::: "memory");
#pragma unroll
        for (int x = 0; x < 2; ++x)
#pragma unroll
            for (int y = 0; y < 2; ++y) St[x][y] = D[x][y];
    }
    const int b = seq >> 2, h = seq & 3;
    float* so = a.out + O_RWP + ((((size_t)l * NB_P + b) * RH + h) * RN) * RN;
#pragma unroll
    for (int jt = 0; jt < 2; ++jt)
#pragma unroll
        for (int it = 0; it < 2; ++it)
#pragma unroll
            for (int g4 = 0; g4 < 4; ++g4) *(f32x4*)(so + (size_t)(32 * it + r32) * 64 + 32 * jt + 8 * g4 + 4 * h2) = (f32x4){St[jt][it][4 * g4], St[jt][it][4 * g4 + 1], St[jt][it][4 * g4 + 2], St[jt][it][4 * g4 + 3]};
}

__device__ __forceinline__ void phase_rwkvC(const Args& a, int l, LAS unsigned char* lds, int lane, int wave) {
    GAS unsigned char* wsg_ = (GAS unsigned char*)a.ws; asm volatile("" : "+s"(wsg_)); unsigned char* ws = (unsigned char*)wsg_;
    const float* YL = (const float*)(ws + WS_YL); const float* YP = (const float*)(ws + WS_YP); const float* SALL = (const float*)(ws + WS_SALL);
    const float* BONUS = (const float*)(ws + WS_BONUS); const bf16* PROJ = (const bf16*)(ws + WS_PROJ); bf16* ARW = (bf16*)(ws + WS_A4) + 3 * A4_STRIDE;
    const int r32 = lane & 31, h2 = lane >> 5;
    for (int item = blockIdx.x * NWAVES + wave; item < 2048; item += gridDim.x * NWAVES) {
        const int seq = item >> 6, c = item & 63, b = seq >> 2, h = seq & 3;
        const size_t m = (size_t)b * SEQ + (size_t)c * RCL + r32;
        const float* sc = SALL + ((size_t)seq * RNC + c) * 4096;
        f32x16 D[2];
#pragma unroll
        for (int it = 0; it < 2; ++it)
#pragma unroll
            for (int g4 = 0; g4 < 4; ++g4) { const f32x4 yl = *(const f32x4*)(YL + m * DR + h * 64 + 32 * it + 8 * g4 + 4 * h2);
                D[it][4 * g4] = yl.x; D[it][4 * g4 + 1] = yl.y; D[it][4 * g4 + 2] = yl.z; D[it][4 * g4 + 3] = yl.w; }
#pragma unroll
        for (int ks = 0; ks < 4; ++ks) {
            const f32x4* yp = (const f32x4*)(YP + m * DR + h * 64 + 16 * ks + 8 * h2); const f32x4 y0 = yp[0], y1 = yp[1];
            v4u bw; bw.x = pk2(y0.x, y0.y); bw.y = pk2(y0.z, y0.w); bw.z = pk2(y1.x, y1.y); bw.w = pk2(y1.z, y1.w);
            const bf16x8 bfr = __builtin_bit_cast(bf16x8, bw);
#pragma unroll
            for (int it = 0; it < 2; ++it) { const f32x4* sp = (const f32x4*)(sc + (size_t)(32 * it + r32) * 64 + 16 * ks + 8 * h2); const f32x4 s0 = sp[0], s1 = sp[1];
                v4u aw; aw.x = pk2(s0.x, s0.y); aw.y = pk2(s0.z, s0.w); aw.z = pk2(s1.x, s1.y); aw.w = pk2(s1.z, s1.w);
                D[it] = MFMA32(__builtin_bit_cast(bf16x8, aw), bfr, D[it]); }
        }
        f32x4 gg[2][4], gb[2][4], bo[2][4]; v2u zw[2][4];
#pragma unroll
        for (int it = 0; it < 2; ++it)
#pragma unroll
            for (int g4 = 0; g4 < 4; ++g4) { const int i0 = h * 64 + 32 * it + 8 * g4 + 4 * h2;
                gg[it][g4] = *(const f32x4*)(INF(I_GNG) + l * DR + i0); gb[it][g4] = *(const f32x4*)(INF(I_GNB) + l * DR + i0); bo[it][g4] = *(const f32x4*)(BONUS + m * DR + i0);
                zw[it][g4] = *(const v2u*)(PROJ + m * PW + C_ZR + i0); }
        float s1 = 0.f;
#pragma unroll
        for (int it = 0; it < 2; ++it)
#pragma unroll
            for (int q = 0; q < 16; ++q) s1 += D[it][q];
        const float mu = (s1 + SHX(s1, 32)) * (1.f / 64.f);
        float s2 = 0.f;
#pragma unroll
        for (int it = 0; it < 2; ++it)
#pragma unroll
            for (int q = 0; q < 16; ++q) { const float d = D[it][q] - mu; s2 += d * d; }
        const float rs = frsq((s2 + SHX(s2, 32)) * (1.f / 64.f) + GN_EPS);
#pragma unroll
        for (int it = 0; it < 2; ++it)
#pragma unroll
            for (int g4 = 0; g4 < 4; ++g4) { const int i0 = h * 64 + 32 * it + 8 * g4 + 4 * h2;
                const f32x4 G = gg[it][g4], B = gb[it][g4], O = bo[it][g4]; const v2u z = zw[it][g4];
                const float o0 = ((D[it][4 * g4] - mu) * rs * G.x + B.x + O.x) * silu(bflo(z.x)), o1 = ((D[it][4 * g4 + 1] - mu) * rs * G.y + B.y + O.y) * silu(bfhi(z.x)),
                            o2 = ((D[it][4 * g4 + 2] - mu) * rs * G.z + B.z + O.z) * silu(bflo(z.y)), o3 = ((D[it][4 * g4 + 3] - mu) * rs * G.w + B.w + O.w) * silu(bfhi(z.y));
                v2u ob; ob.x = pk2(o0, o1); ob.y = pk2(o2, o3); *(v2u*)(ARW + m * DR + i0) = ob; }
    }
}

template <int KSTEPS>
__device__ __forceinline__ void thin_acc(const bf16* A, int lda, const bf16* Bt, int ldb, int n0, int lane, int wave, LAS unsigned char* lds, pg8::f32x4& acc) {
    const int fr = lane & 15, fq = lane >> 4; constexpr int kper = KSTEPS * 32;
    const bf16* bp = Bt + (size_t)(n0 + fr) * ldb + wave * kper + 8 * fq; const bf16* ap = A + (size_t)fr * lda + wave * kper + 8 * fq;
    bf16x8 bfr[KSTEPS], af[KSTEPS][8];
#pragma unroll
    for (int ks = 0; ks < KSTEPS; ++ks) { bfr[ks] = *(const bf16x8*)(bp + 32 * ks);
#pragma unroll
        for (int rt = 0; rt < 8; ++rt) af[ks][rt] = *(const bf16x8*)(ap + (size_t)rt * 16 * lda + 32 * ks); }
    pg8::f32x4 part[8];
#pragma unroll
    for (int rt = 0; rt < 8; ++rt) part[rt] = (pg8::f32x4){0.f, 0.f, 0.f, 0.f};
#pragma unroll
    for (int ks = 0; ks < KSTEPS; ++ks)
#pragma unroll
        for (int rt = 0; rt < 8; ++rt) part[rt] = __builtin_amdgcn_mfma_f32_16x16x32_bf16(bfr[ks], af[ks][rt], part[rt], 0, 0, 0);
    LAS pg8::f32x4* red = (LAS pg8::f32x4*)lds;
#pragma unroll
    for (int rt = 0; rt < 8; ++rt) red[(wave * 8 + rt) * 64 + lane] = part[rt];
    __syncthreads();
#pragma unroll
    for (int w2 = 0; w2 < 8; ++w2) acc += red[(w2 * 8 + wave) * 64 + lane];
    __syncthreads();
}
__device__ __forceinline__ void thin_merge_sample(const Args& a, int l, LAS unsigned char* lds, int lane, int wave, int unit) {
    GAS unsigned char* wsg_ = (GAS unsigned char*)a.ws; asm volatile("" : "+s"(wsg_)); unsigned char* ws = (unsigned char*)wsg_;
    const int slice = unit & 63, rh = unit >> 6;
    const bf16* A4 = (const bf16*)(ws + WS_A4) + (size_t)(MP + rh * 128) * 256; const bf16* B4 = (const bf16*)(ws + WS_W + (size_t)l * LW_STRIDE + LW_MLA);
    const bf16* PROJ = (const bf16*)(ws + WS_PROJ); bf16* MERGED = (bf16*)(ws + WS_MERGED);
    const int n0 = 16 * slice, fr = lane & 15, fq = lane >> 4;
    const size_t m = (size_t)MP + rh * 128 + wave * 16 + fr; const int n = n0 + 4 * fq;
    v2u gw[3];
#pragma unroll
    for (int br = 0; br < 3; ++br) gw[br] = *(const v2u*)(PROJ + m * PW + C_GM + br * DM + n);
    pg8::f32x4 acc[3];
#pragma unroll
    for (int br = 0; br < 3; ++br) acc[br] = (pg8::f32x4){0.f, 0.f, 0.f, 0.f};
    thin_acc<1>(A4, 256, B4, 256, n0, lane, wave, lds, acc[0]);
    thin_acc<1>(A4 + A4_STRIDE, 256, B4 + (size_t)DM * 256, 256, n0, lane, wave, lds, acc[0]);
    thin_acc<1>(A4 + 2 * A4_STRIDE, 256, B4 + (size_t)2 * DM * 256, 256, n0, lane, wave, lds, acc[1]);
    thin_acc<1>(A4 + 3 * A4_STRIDE, 256, B4 + (size_t)3 * DM * 256, 256, n0, lane, wave, lds, acc[2]);
    pg8::f32x4 o = {0.f, 0.f, 0.f, 0.f};
#pragma unroll
    for (int br = 0; br < 3; ++br) o += acc[br] * (pg8::f32x4){bflo(gw[br].x), bfhi(gw[br].x), bflo(gw[br].y), bfhi(gw[br].y)};
    v2u ob; ob.x = pk2(o[0], o[1]); ob.y = pk2(o[2], o[3]); *(v2u*)(MERGED + m * DM + n) = ob;
}
__device__ __forceinline__ void thin_out_sample(const Args& a, int l, LAS unsigned char* lds, int lane, int wave, int unit) {
    GAS unsigned char* wsg_ = (GAS unsigned char*)a.ws; asm volatile("" : "+s"(wsg_)); unsigned char* ws = (unsigned char*)wsg_;
    const int slice = unit & 63, rh = unit >> 6;
    const bf16* A = (const bf16*)(ws + WS_MERGED) + (size_t)(MP + rh * 128) * DM; const bf16* Bt = (const bf16*)(ws + WS_W + (size_t)l * LW_STRIDE + LW_OUT);
    const float* xin = INF(I_XS); const bf16* xinb = (const bf16*)(ws + WS_X1) + (size_t)MP * DM; bf16* xo = (bf16*)(ws + (l == 0 ? WS_X1 : WS_X2)) + (size_t)MP * DM;
    const float* modg = (const float*)(ws + WS_MOD) + (size_t)l * NCB * 3072 + 2048; const float* badg = INF(I_BADA) + l * 3072 + 2048;
    const int n0 = 16 * slice, fr = lane & 15, fq = lane >> 4;
    const int mm = rh * 128 + wave * 16 + fr, n = n0 + 4 * fq, cb = NB_P + (mm >> 3);
    const pg8::f32x4 gt = *(const pg8::f32x4*)(modg + (size_t)cb * 3072 + n) + *(const pg8::f32x4*)(badg + n);
    pg8::f32x4 xv;
    if (l == 0) xv = *(const pg8::f32x4*)(xin + (size_t)mm * DM + n); else { const v2u q = *(const v2u*)(xinb + (size_t)mm * DM + n); xv = (pg8::f32x4){bflo(q.x), bfhi(q.x), bflo(q.y), bfhi(q.y)}; }
    pg8::f32x4 acc = {0.f, 0.f, 0.f, 0.f};
    thin_acc<4>(A, DM, Bt, DM, n0, lane, wave, lds, acc);
    { const pg8::f32x4 o = xv + gt * acc; v2u ob; ob.x = pk2(o[0], o[1]); ob.y = pk2(o[2], o[3]); *(v2u*)(xo + (size_t)mm * DM + n) = ob; }
}

constexpr int UT_LDS = 29184;
__device__ __forceinline__ void phase_rwkvA_ut(const Args& a, LAS unsigned char* lds, int lane, int wave) {
    if (wave >= 4) return;
    GAS unsigned char* wsg_ = (GAS unsigned char*)a.ws; asm volatile("" : "+s"(wsg_)); unsigned char* ws = (unsigned char*)wsg_;
    const float* SC = (const float*)(ws + WS_SC); float* YL = (float*)(ws + WS_YL); float* YP = (float*)(ws + WS_YP); float* QC = (float*)(ws + WS_QC); bf16* PC = (bf16*)(ws + WS_PC);
    LAS unsigned char* L = lds + wave * UT_LDS;
    LAS unsigned char* IKa = L, *IB = L + 4096, *IKt = L + 8192, *IR = L + 12288, *IV = L + 16384, *IW = L + 20480, *IU = L + 24576;
    LAS float* MB = (LAS float*)(L + 0); LAS float* MVI = (LAS float*)(L + 20480); LAS float* GC = (LAS float*)(L + 28672);
    const int r32 = lane & 31, h2 = lane >> 5, g = lane >> 4, li = lane & 15, cg = g & 1, tq = li >> 2, tp = li & 3;
    for (int ch = (int)blockIdx.x * 4 + wave; ch < 32 * RNC; ch += (int)gridDim.x * 4) {
        const int seq = ch / RNC, c = ch - seq * RNC, b = seq >> 2, h = seq & 3;
        const size_t m0 = (size_t)b * SEQ + (size_t)c * RCL;
        float ka[32];
        { const float* sp = SC + m0 * 6 * DR + h * 64 + lane; float Gt[32], tmp[32];
#pragma unroll
          for (int t = 0; t < 32; ++t) Gt[t] = sp[(size_t)t * 6 * DR + DR];
#pragma unroll
          for (int t = 0; t < 32; ++t) tmp[t] = sp[(size_t)t * 6 * DR + 4 * DR];
          { float G = 1.f;
#pragma unroll
            for (int t = 0; t < 32; ++t) { ka[t] = tmp[t] * G; G *= Gt[t]; Gt[t] = G; *(LAS bf16*)(IKa + t * 128 + lane * 2) = (bf16)f2bf(ka[t]); } }
#pragma unroll
          for (int t = 0; t < 32; ++t) tmp[t] = sp[(size_t)t * 6 * DR];
#pragma unroll
          for (int t = 0; t < 32; ++t) *(LAS bf16*)(IR + t * 128 + lane * 2) = (bf16)f2bf(tmp[t] * Gt[t]);
#pragma unroll
          for (int t = 0; t < 32; ++t) tmp[t] = sp[(size_t)t * 6 * DR + 3 * DR];
#pragma unroll
          for (int t = 0; t < 32; ++t) *(LAS bf16*)(IV + t * 128 + lane * 2) = (bf16)f2bf(tmp[t]);
          GC[lane] = Gt[31];
#pragma unroll
          for (int t = 0; t < 32; ++t) Gt[t] = frcp(Gt[t]);
#pragma unroll
          for (int t = 0; t < 32; ++t) tmp[t] = sp[(size_t)t * 6 * DR + 5 * DR];
#pragma unroll
          for (int t = 0; t < 32; ++t) *(LAS bf16*)(IB + t * 128 + lane * 2) = (bf16)f2bf(tmp[t] * Gt[t]);
#pragma unroll
          for (int t = 0; t < 32; ++t) tmp[t] = sp[(size_t)t * 6 * DR + 2 * DR];
#pragma unroll
          for (int t = 0; t < 32; ++t) *(LAS bf16*)(IKt + t * 128 + lane * 2) = (bf16)f2bf(tmp[t] * Gt[t]);
        }
        LDS_WAIT(); asm volatile("" ::: "memory");
        f32x16 MbT, MkT, AbT, AkT;
#pragma unroll
        for (int q = 0; q < 16; ++q) { MbT[q] = 0.f; MkT[q] = 0.f; AbT[q] = 0.f; AkT[q] = 0.f; }
#pragma unroll
        for (int ks = 0; ks < 4; ++ks) { const int off = r32 * 128 + (16 * ks + 8 * h2) * 2;
            const bf16x8 fb = *(const LAS bf16x8*)(IB + off), fk = *(const LAS bf16x8*)(IKt + off), fa = *(const LAS bf16x8*)(IKa + off), fr_ = *(const LAS bf16x8*)(IR + off);
            MbT = MFMA32(fb, fa, MbT); MkT = MFMA32(fk, fa, MkT); AbT = MFMA32(fb, fr_, AbT); AkT = MFMA32(fk, fr_, AkT); }
#pragma unroll
        for (int q = 0; q < 16; ++q) { const int s = (q & 3) + 8 * (q >> 2) + 4 * h2;
            if (s >= r32) { MbT[q] = 0.f; MkT[q] = 0.f; } if (s > r32) { AbT[q] = 0.f; AkT[q] = 0.f; } }
        LDS_WAIT(); asm volatile("" ::: "memory");
#pragma unroll
        for (int g4 = 0; g4 < 4; ++g4) *(LAS f32x4*)(MB + r32 * 32 + 8 * g4 + 4 * h2) = (f32x4){MbT[4 * g4], MbT[4 * g4 + 1], MbT[4 * g4 + 2], MbT[4 * g4 + 3]};
        { f32x16 mv[2];
#pragma unroll
          for (int it = 0; it < 2; ++it)
#pragma unroll
              for (int q = 0; q < 16; ++q) mv[it][q] = 0.f;
#pragma unroll
          for (int ks = 0; ks < 2; ++ks) { const bf16x8 pb = pack8(MkT, ks);
#pragma unroll
              for (int it = 0; it < 2; ++it) mv[it] = MFMA32(vt_frag(IV + (16 * ks + 4 * h2 + tq) * 128 + (32 * it + 16 * cg + 4 * tp) * 2, 8 * 128), pb, mv[it]); }
#pragma unroll
          for (int it = 0; it < 2; ++it)
#pragma unroll
              for (int g4 = 0; g4 < 4; ++g4) *(LAS f32x4*)(MVI + r32 * 64 + 32 * it + 8 * g4 + 4 * h2) = (f32x4){mv[it][4 * g4], mv[it][4 * g4 + 1], mv[it][4 * g4 + 2], mv[it][4 * g4 + 3]}; }
        LDS_WAIT(); asm volatile("" ::: "memory");
        { float x1[32], x2[32];
#pragma unroll
          for (int t = 0; t < 32; ++t) x2[t] = -MVI[t * 64 + lane];
          LDS_WAIT(); asm volatile("" ::: "memory");
#pragma unroll
          for (int t = 0; t < 32; ++t) { float a1 = -ka[t], a2 = x2[t];
#pragma unroll
              for (int s4 = 0; s4 < 32; s4 += 4) { if (s4 < t) { const f32x4 mq = *(const LAS f32x4*)(MB + t * 32 + s4);
                  a1 -= mq.x * x1[s4]; a2 -= mq.x * x2[s4];
                  if (s4 + 1 < t) { a1 -= mq.y * x1[s4 + 1]; a2 -= mq.y * x2[s4 + 1]; }
                  if (s4 + 2 < t) { a1 -= mq.z * x1[s4 + 2]; a2 -= mq.z * x2[s4 + 2]; }
                  if (s4 + 3 < t) { a1 -= mq.w * x1[s4 + 3]; a2 -= mq.w * x2[s4 + 3]; } } }
              x1[t] = a1; x2[t] = a2;
              *(LAS bf16*)(IW + t * 128 + lane * 2) = (bf16)f2bf(a1); *(LAS bf16*)(IU + t * 128 + lane * 2) = (bf16)f2bf(a2); } }
        LDS_WAIT(); asm volatile("" ::: "memory");
        const size_t cbase = ((size_t)seq * RNC + c) * 4096;
#pragma unroll
        for (int jt = 0; jt < 2; ++jt) {
            f32x16 pt[2], qt[2];
#pragma unroll
            for (int x = 0; x < 2; ++x)
#pragma unroll
                for (int q = 0; q < 16; ++q) { pt[x][q] = 0.f; qt[x][q] = 0.f; }
#pragma unroll
            for (int ks = 0; ks < 2; ++ks) { const int ro = (16 * ks + 4 * h2 + tq) * 128, co = (16 * cg + 4 * tp) * 2;
                const bf16x8 ab = vt_frag(IB + ro + 64 * jt + co, 8 * 128), ak = vt_frag(IKt + ro + 64 * jt + co, 8 * 128);
#pragma unroll
                for (int x = 0; x < 2; ++x) { const bf16x8 bw = vt_frag(IW + ro + 64 * x + co, 8 * 128), bu = vt_frag(IU + ro + 64 * x + co, 8 * 128), bv = vt_frag(IV + ro + 64 * x + co, 8 * 128);
                    pt[x] = MFMA32(ab, bw, pt[x]); qt[x] = MFMA32(ab, bu, qt[x]); qt[x] = MFMA32(ak, bv, qt[x]); } }
#pragma unroll
            for (int g4 = 0; g4 < 4; ++g4) { const int j0 = 32 * jt + 8 * g4 + 4 * h2; const f32x4 gc = *(const LAS f32x4*)(GC + j0);
#pragma unroll
                for (int x = 0; x < 2; ++x) { const int kcol = 32 * x + r32;
                    f32x4 pv = {pt[x][4 * g4], pt[x][4 * g4 + 1], pt[x][4 * g4 + 2], pt[x][4 * g4 + 3]};
#pragma unroll
                    for (int e = 0; e < 4; ++e) if (j0 + e == kcol) pv[e] += 1.f;
                    pv = pv * gc; v2u pw; pw.x = pk2(pv.x, pv.y); pw.y = pk2(pv.z, pv.w);
                    *(v2u*)(PC + cbase + (size_t)kcol * 64 + j0) = pw;
                    *(f32x4*)(QC + cbase + (size_t)kcol * 64 + j0) = (f32x4){qt[x][4 * g4], qt[x][4 * g4 + 1], qt[x][4 * g4 + 2], qt[x][4 * g4 + 3]} * gc; } }
        }
        { f32x16 yp[2], yl[2];
#pragma unroll
          for (int x = 0; x < 2; ++x)
#pragma unroll
              for (int q = 0; q < 16; ++q) { yp[x][q] = 0.f; yl[x][q] = 0.f; }
#pragma unroll
          for (int ks = 0; ks < 2; ++ks) { const bf16x8 pab = pack8(AbT, ks), pak = pack8(AkT, ks); const int ro = (16 * ks + 4 * h2 + tq) * 128, co = (16 * cg + 4 * tp) * 2;
#pragma unroll
              for (int x = 0; x < 2; ++x) { yp[x] = MFMA32(vt_frag(IW + ro + 64 * x + co, 8 * 128), pab, yp[x]);
                  yl[x] = MFMA32(vt_frag(IU + ro + 64 * x + co, 8 * 128), pab, yl[x]); yl[x] = MFMA32(vt_frag(IV + ro + 64 * x + co, 8 * 128), pak, yl[x]); } }
          const size_t mrow = (m0 + r32) * DR + h * 64;
#pragma unroll
          for (int x = 0; x < 2; ++x)
#pragma unroll
              for (int g4 = 0; g4 < 4; ++g4) { const int j0 = 32 * x + 8 * g4 + 4 * h2; const v2u rw = *(const LAS v2u*)(IR + r32 * 128 + j0 * 2);
                  *(f32x4*)(YP + mrow + j0) = (f32x4){yp[x][4 * g4] + bflo(rw.x), yp[x][4 * g4 + 1] + bfhi(rw.x), yp[x][4 * g4 + 2] + bflo(rw.y), yp[x][4 * g4 + 3] + bfhi(rw.y)};
                  *(f32x4*)(YL + mrow + j0) = (f32x4){yl[x][4 * g4], yl[x][4 * g4 + 1], yl[x][4 * g4 + 2], yl[x][4 * g4 + 3]}; } }
        LDS_WAIT(); asm volatile("" ::: "memory");
    }
}

constexpr int SA_RS = 592;
constexpr int SA_BUF = 64 * SA_RS;
__device__ __forceinline__ void phase_attn_sample(const Args& a, int l, LAS unsigned char* lds, int tid, int lane, int wave, unsigned* sctr, volatile LAS unsigned* qslot) {
    GAS unsigned char* wsg_ = (GAS unsigned char*)a.ws; asm volatile("" : "+s"(wsg_)); unsigned char* ws = (unsigned char*)wsg_;
    const bf16* QLT = (const bf16*)(ws + WS_QLAT); const bf16* CKVn = (const bf16*)(ws + WS_CKV) + (size_t)MP * KVL; const bf16* KPEn = (const bf16*)(ws + WS_KPE) + (size_t)MP * QKR;
    float* PO = (float*)(ws + WS_PO); float* PM = (float*)(ws + WS_PM); float* PL = (float*)(ws + WS_PL);
    const float* cckv = INF(I_CCKV) + (size_t)l * NPOOL * PAGE * KVL; const float* ckpe = INF(I_CKPE) + (size_t)l * NPOOL * PAGE * QKR; const int* pt = (const int*)a.in[I_PT];
    const int r32 = lane & 31, h2 = lane >> 5, rt = wave & 1, ch = (wave >> 1) & 1, kp = wave >> 2;
    const int g = lane >> 4, li = lane & 15, cg = g & 1, tq = li >> 2, tp = li & 3;
    for (;;) {
        if (tid == 0) *qslot = __hip_atomic_fetch_add(sctr, 1u, __ATOMIC_RELAXED, __HIP_MEMORY_SCOPE_AGENT);
        __syncthreads();
        const int unit = (int)*qslot;
        __syncthreads();
        if (unit >= NB_S * 8) break;
        const int b = unit >> 3, split = unit & 7;
        LAS unsigned char* xbuf = lds + 2 * SA_BUF;
        bf16x8 Bq[9];
#pragma unroll
        for (int ks = 0; ks < 9; ++ks) Bq[ks] = *(const bf16x8*)(QLT + ((size_t)b * 64 + rt * 32 + r32) * 288 + 16 * (9 * ch + ks) + 8 * h2);
        f32x16 O[4];
#pragma unroll
        for (int ct = 0; ct < 4; ++ct)
#pragma unroll
            for (int i = 0; i < 16; ++i) O[ct][i] = 0.f;
        float mrun = -INFINITY, lrun = 0.f;
        constexpr int NP = 32;
        const bool has_new = (split == 7);
        const int mypool = pt[b * NPAGES + split * 16 + (lane & 15)];
        const unsigned vo_c = (unsigned)(tid >> 6) * (KVL * 4u) + (unsigned)(tid & 63) * 16u, vo_p = (unsigned)(tid >> 3) * (QKR * 4u) + (unsigned)(tid & 7) * 16u;
        const int so_c = (tid >> 6) * SA_RS + (tid & 63) * 8, so_p = (tid >> 3) * SA_RS + 512 + (tid & 7) * 8;
        f32x4 gA[8], pA, gB[8], pB;
        auto load_tile = [&](int j, f32x4 (&gc)[8], f32x4& gp) {
            const int pool = __builtin_amdgcn_readlane(mypool, j >> 1);
            const char* src = (const char*)(cckv + ((size_t)pool * PAGE + (j & 1) * 64) * KVL); const char* srp = (const char*)(ckpe + ((size_t)pool * PAGE + (j & 1) * 64) * QKR);
#pragma unroll
            for (int i = 0; i < 8; ++i) gc[i] = __builtin_nontemporal_load((const f32x4*)(src + (vo_c + (unsigned)i * (8u * KVL * 4u))));
            gp = __builtin_nontemporal_load((const f32x4*)(srp + vo_p));
        };
        auto store_tile = [&](LAS unsigned char* buf, const f32x4 (&gc)[8], const f32x4& gp) {
            LAS unsigned char* d = buf + so_c;
#pragma unroll
            for (int i = 0; i < 8; ++i) { v2u w; w.x = pk2(gc[i].x, gc[i].y); w.y = pk2(gc[i].z, gc[i].w); *(LAS v2u*)(d + i * (8 * SA_RS)) = w; }
            { v2u w; w.x = pk2(gp.x, gp.y); w.y = pk2(gp.z, gp.w); *(LAS v2u*)(buf + so_p) = w; }
        };
        auto store_new = [&](LAS unsigned char* buf) {
            for (int q = tid; q < 32 * 36; q += NTHR) { const int key = q / 36, c16 = q - key * 36; v4u w = {0u, 0u, 0u, 0u};
                if (key < 8) w = (c16 < 32) ? *(const v4u*)(CKVn + ((size_t)b * 8 + key) * KVL + c16 * 8) : *(const v4u*)(KPEn + ((size_t)b * 8 + key) * QKR + (c16 - 32) * 8);
                *(LAS v4u*)(buf + key * SA_RS + c16 * 16) = w; }
        };
        auto compute = [&](const LAS unsigned char* tb, bool isnew) {
            f32x16 S0;
#pragma unroll
            for (int i = 0; i < 16; ++i) S0[i] = 0.f;
            const LAS unsigned char* kb = tb + r32 * SA_RS + h2 * 16 + ch * (9 * 32);
#pragma unroll
            for (int ks = 0; ks < 9; ++ks) { const bf16x8 k0 = *(const LAS bf16x8*)(kb + ks * 32); S0 = MFMA32(k0, Bq[ks], S0); }
            {   LAS f32x4* xw = (LAS f32x4*)(xbuf + wave * 4096) + lane; const LAS f32x4* xr = (const LAS f32x4*)(xbuf + (wave ^ 2) * 4096) + lane;
#pragma unroll
                for (int q4 = 0; q4 < 4; ++q4) xw[q4 * 64] = (f32x4){S0[4 * q4], S0[4 * q4 + 1], S0[4 * q4 + 2], S0[4 * q4 + 3]};
                LDS_WAIT(); __builtin_amdgcn_s_barrier(); asm volatile("" ::: "memory");
#pragma unroll
                for (int q4 = 0; q4 < 4; ++q4) { const f32x4 o = xr[q4 * 64]; S0[4 * q4] += o.x; S0[4 * q4 + 1] += o.y; S0[4 * q4 + 2] += o.z; S0[4 * q4 + 3] += o.w; }
            }
            if (isnew) {
                const int tq_ = (rt * 32 + r32) >> 3;
#pragma unroll
                for (int i = 0; i < 16; ++i) { const int key = 32 * kp + 4 * h2 + (i & 3) + 8 * (i >> 2); if (key > tq_) S0[i] = -INFINITY; }
            }
            float mx = S0[0];
#pragma unroll
            for (int i = 1; i < 16; ++i) mx = fmaxf(mx, S0[i]);
            mx = fmaxf(mx, SHX(mx, 32));
            const float mnew = fmaxf(mrun, mx);
            if (__builtin_amdgcn_ballot_w64(mnew > mrun)) {
                const float alpha = __builtin_amdgcn_exp2f(mrun - mnew); mrun = mnew; lrun *= alpha;
#pragma unroll
                for (int ct = 0; ct < 4; ++ct)
#pragma unroll
                    for (int i = 0; i < 16; ++i) O[ct][i] *= alpha;
            }
            float ps = 0.f;
#pragma unroll
            for (int i = 0; i < 16; ++i) { S0[i] = __builtin_amdgcn_exp2f(S0[i] - mrun); ps += S0[i]; }
            lrun += ps;
            const LAS unsigned char* vbase = tb + (4 * h2 + tq) * SA_RS + (ch * 128 + 16 * cg + 4 * tp) * 2;
#pragma unroll
            for (int s = 0; s < 2; ++s) {
                const bf16x8 pb = pack8(S0, s);
                const LAS unsigned char* vp = vbase + (16 * s) * SA_RS;
                bf16x8 va = vt_frag(vp, 8 * SA_RS), vb_ = vt_frag(vp + 64, 8 * SA_RS), vc = vt_frag(vp + 128, 8 * SA_RS), vd = vt_frag(vp + 192, 8 * SA_RS);
                asm volatile("" : "+v"(va), "+v"(vb_), "+v"(vc), "+v"(vd));
                O[0] = MFMA32(va, pb, O[0]); O[1] = MFMA32(vb_, pb, O[1]); O[2] = MFMA32(vc, pb, O[2]); O[3] = MFMA32(vd, pb, O[3]);
            }
        };
#define SA_BAR() do { LDS_WAIT(); __builtin_amdgcn_s_barrier(); asm volatile("" ::: "memory"); } while (0)
        load_tile(0, gA, pA); load_tile(1, gB, pB); store_tile(lds, gA, pA); SA_BAR();
        for (int j = 0; j < NP - 2; j += 2) {
            load_tile(j + 2, gA, pA);
            compute(lds + kp * 32 * SA_RS, false);
            store_tile(lds + SA_BUF, gB, pB);
            SA_BAR();
            load_tile(j + 3, gB, pB);
            compute(lds + SA_BUF + kp * 32 * SA_RS, false);
            store_tile(lds, gA, pA);
            SA_BAR();
        }
        compute(lds + kp * 32 * SA_RS, false);
        store_tile(lds + SA_BUF, gB, pB);
        SA_BAR();
        compute(lds + SA_BUF + kp * 32 * SA_RS, false);
        if (has_new) store_new(lds);
        __syncthreads();
        if (has_new) compute(lds + kp * 32 * SA_RS, true);
        __syncthreads();
        const float ltot = lrun + SHX(lrun, 32);
        LAS float* xb = (LAS float*)(lds + (wave & 3) * 17408);
        if (kp == 1) {
#pragma unroll
            for (int ct = 0; ct < 4; ++ct)
#pragma unroll
                for (int i = 0; i < 16; ++i) xb[(ct * 16 + i) * 64 + lane] = O[ct][i];
            xb[4096 + lane] = mrun; xb[4160 + lane] = ltot;
        }
        __syncthreads();
        if (kp == 0) {
            const float m1 = xb[4096 + lane], l1 = xb[4160 + lane];
            const float mm = fmaxf(mrun, m1); const float a0 = __builtin_amdgcn_exp2f(mrun - mm), a1 = __builtin_amdgcn_exp2f(m1 - mm);
            const int row = rt * 32 + r32; const size_t pbase = ((size_t)b * 8 + split) * 64 + row;
#pragma unroll
            for (int ct = 0; ct < 4; ++ct)
#pragma unroll
                for (int g4 = 0; g4 < 4; ++g4) { const int c0 = ch * 128 + ct * 32 + 8 * g4 + 4 * h2;
                    f32x4 o;
#pragma unroll
                    for (int e = 0; e < 4; ++e) o[e] = O[ct][4 * g4 + e] * a0 + xb[(ct * 16 + 4 * g4 + e) * 64 + lane] * a1;
                    *(f32x4*)(PO + pbase * 256 + c0) = o; }
            if (ch == 0 && h2 == 0) { PM[pbase] = mm; PL[pbase] = ltot * a0 + l1 * a1; }
        }
        __syncthreads();
    }
}

__device__ __forceinline__ void phase_combine(const Args& a, int l, LAS unsigned char* lds, int lane, int wave) {
    GAS unsigned char* wsg_ = (GAS unsigned char*)a.ws; asm volatile("" : "+s"(wsg_)); unsigned char* ws = (unsigned char*)wsg_;
    const int gw = blockIdx.x * NWAVES + wave, NGW = gridDim.x * NWAVES;
    const float* PO = (const float*)(ws + WS_PO); const float* PM = (const float*)(ws + WS_PM); const float* PL = (const float*)(ws + WS_PL);
    const float* wuv = INF(I_WUV) + (size_t)l * KVL * 512; const bf16* PROJ = (const bf16*)(ws + WS_PROJ); bf16* AMLA = (bf16*)(ws + WS_A4);
    LAS float* ol = (LAS float*)(lds + 65536 + wave * 1024);
    for (int task = gw; task < MS * NH; task += NGW) {
        const int mm = task >> 3, h = task & 7, b = mm >> 3, t = mm & 7, r = t * 8 + h;
        float ms[8], mmax = -INFINITY;
#pragma unroll
        for (int s = 0; s < 8; ++s) { ms[s] = PM[((size_t)b * 8 + s) * 64 + r]; mmax = fmaxf(mmax, ms[s]); }
        float L = 0.f, wsc[8];
#pragma unroll
        for (int s = 0; s < 8; ++s) { wsc[s] = __builtin_amdgcn_exp2f(ms[s] - mmax); L += wsc[s] * PL[((size_t)b * 8 + s) * 64 + r]; }
        const float invL = frcp(L);
#pragma unroll
        for (int ci = 0; ci < 4; ++ci) { const int c = lane + 64 * ci; float acc = 0.f;
#pragma unroll
            for (int s = 0; s < 8; ++s) acc += wsc[s] * PO[(((size_t)b * 8 + s) * 64 + r) * 256 + c];
            ol[c] = acc * invL; }
        LDS_WAIT(); asm volatile("" ::: "memory");
        float o = 0.f;
#pragma unroll 8
        for (int c = 0; c < 256; ++c) o += ol[c] * wuv[((size_t)c * NH + h) * 64 + lane];
        const size_t m = (size_t)MP + mm;
        const float z = bf1(PROJ[m * PW + C_ZM + h * 64 + lane]);
        AMLA[(size_t)(h >> 2) * A4_STRIDE + m * 256 + (h & 3) * 64 + lane] = (bf16)f2bf(o * silu(z));
        LDS_WAIT(); asm volatile("" ::: "memory");
    }
}

constexpr int SCAN_TS = 32;
__device__ __forceinline__ void scan_sample(const Args& a, int l, LAS unsigned char* lds, int lane, int sidx) {
    GAS unsigned char* wsg_ = (GAS unsigned char*)a.ws; asm volatile("" : "+s"(wsg_)); unsigned char* ws = (unsigned char*)wsg_;
    const float* SC = (const float*)(ws + WS_SC); const float* BONUS = (const float*)(ws + WS_BONUS); const bf16* PROJ = (const bf16*)(ws + WS_PROJ); bf16* ARW = (bf16*)(ws + WS_A4) + 3 * A4_STRIDE;
    LAS float* st = (LAS float*)lds;
    { const int seq = NB_P * RH + sidx;
        const bool samp = seq >= NB_P * RH; const int sb = samp ? seq - NB_P * RH : seq; const int b = sb >> 2, h = sb & 3;
        const int T = samp ? TSMP : SEQ; const size_t m0 = samp ? (size_t)MP + b * TSMP : (size_t)b * SEQ;
        float S[64];
        if (samp) { const f32x4* s0 = (const f32x4*)(INF(I_SRWKV) + ((((size_t)l * NB_S + b) * RH + h) * RN + lane) * RN);
#pragma unroll
            for (int j = 0; j < 16; ++j) { const f32x4 v = s0[j]; S[4 * j] = v.x; S[4 * j + 1] = v.y; S[4 * j + 2] = v.z; S[4 * j + 3] = v.w; } }
        else {
#pragma unroll
            for (int j = 0; j < 64; ++j) S[j] = 0.f; }
        const float gng = INF(I_GNG)[l * DR + h * 64 + lane], gnb = INF(I_GNB)[l * DR + h * 64 + lane];
        for (int t0 = 0; t0 < T; t0 += SCAN_TS) {
            const int nt = (T - t0) < SCAN_TS ? (T - t0) : SCAN_TS;
            for (int tt = 0; tt < nt; ++tt) { const float* sc = SC + (m0 + t0 + tt) * 6 * DR + h * 64 + lane; LAS float* d = st + tt * 320 + lane;
                d[0] = sc[0]; d[64] = sc[DR]; d[128] = sc[2 * DR]; d[192] = sc[4 * DR]; d[256] = sc[5 * DR]; }
            LDS_WAIT(); asm volatile("" ::: "memory");
            float vn = SC[(m0 + t0) * 6 * DR + 3 * DR + h * 64 + lane], bon = BONUS[(m0 + t0) * DR + h * 64 + lane], zn = bf1(PROJ[(m0 + t0) * PW + C_ZR + h * 64 + lane]);
            for (int tt = 0; tt < nt; ++tt) {
                const size_t m = m0 + t0 + tt;
                const float v = vn, bo_c = bon, z_c = zn;
                if (tt + 1 < nt) { vn = SC[(m + 1) * 6 * DR + 3 * DR + h * 64 + lane]; bon = BONUS[(m + 1) * DR + h * 64 + lane]; zn = bf1(PROJ[(m + 1) * PW + C_ZR + h * 64 + lane]); }
                const LAS f32x4* vr = (const LAS f32x4*)(st + tt * 320); const LAS f32x4* vw = vr + 16; const LAS f32x4* vk = vr + 32; const LAS f32x4* vkk = vr + 48; const LAS f32x4* vb = vr + 64;
                float sa = 0.f;
#pragma unroll
                for (int j = 0; j < 16; ++j) { const f32x4 q = vkk[j]; sa -= S[4 * j] * q.x + S[4 * j + 1] * q.y + S[4 * j + 2] * q.z + S[4 * j + 3] * q.w; }
                float y = 0.f;
#pragma unroll
                for (int j = 0; j < 16; ++j) { const f32x4 w = vw[j], bb = vb[j], kq = vk[j], rq = vr[j];
                    S[4 * j] = S[4 * j] * w.x + sa * bb.x + v * kq.x; S[4 * j + 1] = S[4 * j + 1] * w.y + sa * bb.y + v * kq.y;
                    S[4 * j + 2] = S[4 * j + 2] * w.z + sa * bb.z + v * kq.z; S[4 * j + 3] = S[4 * j + 3] * w.w + sa * bb.w + v * kq.w;
                    y += S[4 * j] * rq.x + S[4 * j + 1] * rq.y + S[4 * j + 2] * rq.z + S[4 * j + 3] * rq.w; }
                const float mu = wave_sum(y) * (1.f / 64.f); const float d = y - mu; const float var = wave_sum(d * d) * (1.f / 64.f);
                const float yn = d * (frsq(var + GN_EPS)) * gng + gnb;
                const float o = yn + bo_c;
                const float z = z_c;
                ARW[m * DR + h * 64 + lane] = (bf16)f2bf(o * silu(z));
            }
            LDS_WAIT(); asm volatile("" ::: "memory");
        }
        float* so = samp ? a.out + O_RWS + ((((size_t)l * NB_S + b) * RH + h) * RN + lane) * RN : a.out + O_RWP + ((((size_t)l * NB_P + b) * RH + h) * RN + lane) * RN;
#pragma unroll
        for (int j = 0; j < 16; ++j) *(f32x4*)(so + 4 * j) = (f32x4){S[4 * j], S[4 * j + 1], S[4 * j + 2], S[4 * j + 3]};
    }
}

__device__ __forceinline__ void phase_final(const Args& a, int lane, int wave) {
    GAS unsigned char* wsg_ = (GAS unsigned char*)a.ws; asm volatile("" : "+s"(wsg_)); unsigned char* ws = (unsigned char*)wsg_;
    const int gw = blockIdx.x * NWAVES + wave, NGW = gridDim.x * NWAVES;
    const bf16* X = (const bf16*)(ws + WS_X2); const float* fg = INF(I_FNG);
    f32x4 g[4];
#pragma unroll
    for (int j = 0; j < 4; ++j) g[j] = *(const f32x4*)(fg + 4 * lane + 256 * j);
    for (int grp = gw; grp < MT / 8; grp += NGW) {
        const int mbase = grp * 8;
        v2u nr[4];
        auto load_row = [&](int mr) { const v2u* xr = (const v2u*)(X + (size_t)mr * DM) + lane;
#pragma unroll
            for (int j = 0; j < 4; ++j) nr[j] = xr[64 * j]; };
        load_row(mbase);
        for (int r = 0; r < 8; ++r) {
            const int m = mbase + r;
            f32x4 v[4];
#pragma unroll
            for (int j = 0; j < 4; ++j) v[j] = (f32x4){bflo(nr[j].x), bfhi(nr[j].x), bflo(nr[j].y), bfhi(nr[j].y)};
            if (r + 1 < 8) load_row(m + 1);
            float ss = 0.f;
#pragma unroll
            for (int j = 0; j < 4; ++j) ss += (v[j].x * v[j].x + v[j].y * v[j].y) + (v[j].z * v[j].z + v[j].w * v[j].w);
            const float rs = frsq(wave_sum(ss) * (1.f / DM) + RMS_EPS);
            float* o = (m < MP) ? a.out + O_YP + (size_t)m * DM : a.out + O_YS + (size_t)(m - MP) * DM;
#pragma unroll
            for (int j = 0; j < 4; ++j) *(f32x4*)(o + 4 * lane + 256 * j) = v[j] * rs * g[j];
        }
    }
}

#if defined(ONLY)
#define PH_EN(k) (ONLY == (k))
#elif defined(SKIPA)
#define PH_EN(k) ((k) != SKIPA && (k) != SKIPB && (k) != SKIPC)
#else
#define PH_EN(k) 1
#endif
#ifndef PROBE_DBL
#define PROBE_DBL 0
#endif
#define REP(k) for (int rep_ = 0; rep_ < (((PROBE_DBL >> (k)) & 1) ? 2 : 1); ++rep_)
constexpr int NS_FIRST = 128;
constexpr int PH_PER_LAYER = 8, N_PHASES = 1 + DEPTH * PH_PER_LAYER + 1;
__global__ void __launch_bounds__(NTHR, 2) fwd(Args a) {
    extern __shared__ __attribute__((aligned(16))) unsigned char lds_raw[];
    LAS unsigned char* lds = (LAS unsigned char*)lds_raw;
    const int wave0 = __builtin_amdgcn_readfirstlane(threadIdx.x >> 6);
    int tid = threadIdx.x, lane = tid & 63, wave = wave0;
#define RETID() do { int w_ = wave0, l_; asm volatile("" : "+s"(w_)); asm volatile("v_mbcnt_lo_u32_b32 %0, -1, 0\n\tv_mbcnt_hi_u32_b32 %0, -1, %0" : "=v"(l_)); wave = w_; lane = l_; tid = wave * 64 + lane; } while (0)
    volatile LAS unsigned* MISC = (volatile LAS unsigned*)(lds + MISC_OFF);
    for (int u = tid; u < (LDS_BYTES - LDSCTL_OFF) / 4; u += NTHR) ((LAS unsigned*)(lds + LDSCTL_OFF))[u] = 0u;
    __syncthreads();
    const bool fused = (a.ph_hi - a.ph_lo) > 1;
    XcdBarrier bar; bar.bar = (unsigned*)(a.ws + WS_CTL) + CW_BAR; bar.x = 0; bar.st = nullptr;
    if (fused) bar = xcd_barrier_post((unsigned*)(a.ws + WS_CTL) + CW_BAR, MISC + 8);
    const int lo = a.ph_lo, hi = a.ph_hi;
#define IN(k) (lo <= (k) && (k) < hi)
#define SEAM(k) do { if (IN(k) && IN((k) + 1)) { xcd_barrier(bar); if ((PROBE_DBL >> 20) & 1) xcd_barrier(bar); } } while (0)
    if (IN(0)) {
#if PH_EN(0)
 RETID(); phase_prologue(a, lds, tid, lane, wave);
#endif
 }
    SEAM(0);
    for (int l = 0; l < DEPTH; ++l) {
        const int pb = 1 + l * PH_PER_LAYER;
        if (IN(pb + 0)) {
#if PH_EN(1)
 REP(1) { RETID(); phase_modulate(a, l, lane, wave); }
#endif
 }
        SEAM(pb + 0);
        if (IN(pb + 1) && PH_EN(2)) REP(2) {
            GAS unsigned char* wsg_ = (GAS unsigned char*)a.ws; asm volatile("" : "+s"(wsg_)); unsigned char* ws = (unsigned char*)wsg_;     unsigned char* wl = ws + WS_W + (size_t)l * LW_STRIDE;
            pg8::Gemm g{(const bf16*)(ws + WS_U), (const bf16*)(wl + LW_IN), MT, NPROJ, DM}; pg8::StaticOrder S; S.init(MT, NPROJ, gridDim.x, blockIdx.x);
            if ((PROBE_DBL >> 27) & 1) { pg8::EpiProj E0{(bf16*)(ws + WS_QA), (bf16*)(ws + WS_PROJ), 1}; pg8::gemm_phase<pg8::EpiProj, pg8::StaticOrder, true, true>(lds + RING_OFF, g, S, E0, wave0); }
            pg8::EpiProj E{(bf16*)(ws + WS_QA), (bf16*)(ws + WS_PROJ), 0};
            pg8::gemm_phase<pg8::EpiProj, pg8::StaticOrder, true, true>(lds + RING_OFF, g, S, E, wave0);
            if (l == 0 && blockIdx.x >= 154) { RETID(); convert_weights(a, ws, lds, lane, wave, 1, ((int)blockIdx.x - 154) * NWAVES + wave, ((int)gridDim.x - 154) * NWAVES); }
        }
        SEAM(pb + 1);
        if (IN(pb + 2)) {
#if PH_EN(3)
 REP(3) { RETID(); phase_post(a, l, lds, tid, lane, wave); }
#endif
 }
        SEAM(pb + 2);
        if (IN(pb + 3) && PH_EN(4)) REP(4) {
            GAS unsigned char* wsg_ = (GAS unsigned char*)a.ws; asm volatile("" : "+s"(wsg_)); unsigned char* ws = (unsigned char*)wsg_;     unsigned char* wl = ws + WS_W + (size_t)l * LW_STRIDE;
            { pg8::Gemm g{(const bf16*)(ws + WS_QA), (const bf16*)(wl + LW_Q), MT, 768, QL}; pg8::StaticOrder S; S.init(MT, 768, gridDim.x, blockIdx.x);
              pg8::EpiQ E{(const float*)(ws + WS_RSQ), (const float*)(ws + WS_ROPE), (bf16*)(ws + WS_Q), (float*)(ws + WS_QS)};
              pg8::gemm_phase<pg8::EpiQ, pg8::StaticOrder, true, true>(lds + RING_OFF, g, S, E, wave0); }
            { pg8::Gemm g{(const bf16*)(ws + WS_CKV), (const bf16*)(wl + LW_KV), MP, 1024, KVL}; pg8::StaticOrder S; S.init(MP, 1024, gridDim.x, (blockIdx.x + 195) % gridDim.x);
              pg8::EpiKV E{(bf16*)(ws + WS_KN), (bf16*)(ws + WS_V)};
              pg8::gemm_phase<pg8::EpiKV, pg8::StaticOrder, true, true>(lds + RING_OFF, g, S, E, wave0); }
        }
        if (IN(pb + 3)) { REP(5) { RETID(); phase_rwkvA_ut(a, lds, lane, wave); } }
        SEAM(pb + 3);
        if (IN(pb + 4)) REP(6) {
            unsigned* cw = (unsigned*)(a.ws + WS_CTL) + 64 + 64 * (l * 2 + rep_);
            RETID(); phase_qlat(a, l, lane, wave);
            asm volatile("s_waitcnt vmcnt(0)" ::: "memory");
            __syncthreads();
            if (threadIdx.x == 0) { __builtin_amdgcn_fence(__ATOMIC_RELEASE, "agent"); asm volatile("s_waitcnt vmcnt(0)" ::: "memory"); (void)xb_add(cw + 32, 1u); }
            RETID();
            if (blockIdx.x < 32) {
                if (wave == 0) rwkv_chain(a, l, lds, lane, (int)blockIdx.x);
                else if (wave <= 4) scan_sample(a, l, lds + 73728 + (wave - 1) * 10240, lane, (int)blockIdx.x * 4 + (wave - 1));
                __syncthreads();
            }
            const bool sfirst = (int)blockIdx.x >= NS_FIRST;
            if (wave0 >= 4) __builtin_amdgcn_s_setprio(1);
#pragma nounroll
            for (int pass = 0; pass < 2; ++pass) {
                if ((pass == 0) == sfirst) {
                    if (threadIdx.x == 0) { XB_SPIN(xb_ld(cw + 32) < gridDim.x, bar.bar); __builtin_amdgcn_fence(__ATOMIC_ACQUIRE, "agent"); asm volatile("s_waitcnt vmcnt(0)" ::: "memory"); }
                    __syncthreads();
                    RETID(); phase_attn_sample(a, l, lds, tid, lane, wave, cw + 16, MISC + 16);
                } else { RETID(); phase_attn_prompt(a, lds, tid, lane, wave, cw, MISC + 16); }
            }
            __builtin_amdgcn_s_setprio(0);
        }
        SEAM(pb + 4);
        if (IN(pb + 5)) {
 REP(8) { RETID(); phase_combine(a, l, lds, lane, wave); }
 REP(13) { RETID(); phase_rwkvC(a, l, lds, lane, wave); }
 }
        SEAM(pb + 5);
        if (IN(pb + 6) && PH_EN(9)) REP(9) {
            GAS unsigned char* wsg_ = (GAS unsigned char*)a.ws; asm volatile("" : "+s"(wsg_)); unsigned char* ws = (unsigned char*)wsg_;     unsigned char* wl = ws + WS_W + (size_t)l * LW_STRIDE;
            if (blockIdx.x >= 128) for (int r2_ = 0; r2_ < (((PROBE_DBL >> 26) & 1) ? 2 : 1); ++r2_) { RETID(); thin_merge_sample(a, l, lds, lane, wave, (int)blockIdx.x - 128); }
            pg8::Gemm g{(const bf16*)(ws + WS_A4), (const bf16*)(wl + LW_MLA), 4 * MT, 4 * DM, 256}; pg8::MergeOrder S; S.init(MP, DM, gridDim.x, blockIdx.x);
            if ((PROBE_DBL >> 24) & 1) { pg8::EpiMerge E0{(const bf16*)(ws + WS_PROJ), (bf16*)(ws + WS_MG), (bf16*)(ws + WS_MERGED), 1}; pg8::gemm_phase<pg8::EpiMerge, pg8::MergeOrder, true, true>(lds + RING_OFF, g, S, E0, wave0); }
            pg8::EpiMerge E{(const bf16*)(ws + WS_PROJ), (bf16*)(ws + WS_MG), (bf16*)(ws + WS_MERGED), 0};
            pg8::gemm_phase<pg8::EpiMerge, pg8::MergeOrder, true, true>(lds + RING_OFF, g, S, E, wave0);
        }
        SEAM(pb + 6);
        if (IN(pb + 7) && PH_EN(10)) REP(10) {
            GAS unsigned char* wsg_ = (GAS unsigned char*)a.ws; asm volatile("" : "+s"(wsg_)); unsigned char* ws = (unsigned char*)wsg_;     unsigned char* wl = ws + WS_W + (size_t)l * LW_STRIDE;
            if (blockIdx.x >= 128) for (int r2_ = 0; r2_ < (((PROBE_DBL >> 25) & 1) ? 2 : 1); ++r2_) { RETID(); thin_out_sample(a, l, lds, lane, wave, (int)blockIdx.x - 128); }
            pg8::Gemm g{(const bf16*)(ws + WS_MERGED), (const bf16*)(wl + LW_OUT), MP, DM, DM}; pg8::StaticOrder S; S.init(MP, DM, gridDim.x, blockIdx.x);
            if (l == 0) { pg8::EpiOut<false> E{INF(I_XP), nullptr, (bf16*)(ws + WS_X1), (const float*)(ws + WS_MOD) + 2048, INF(I_BADA) + 2048};
                pg8::gemm_phase<pg8::EpiOut<false>, pg8::StaticOrder, true, true>(lds + RING_OFF, g, S, E, wave0); }
            else { pg8::EpiOut<true> E{nullptr, (const bf16*)(ws + WS_X1), (bf16*)(ws + WS_X2), (const float*)(ws + WS_MOD) + (size_t)NCB * 3072 + 2048, INF(I_BADA) + 3072 + 2048};
                pg8::gemm_phase<pg8::EpiOut<true>, pg8::StaticOrder, true, true>(lds + RING_OFF, g, S, E, wave0); }
        }
        SEAM(pb + 7);
    }
    if (IN(N_PHASES - 1)) {
#if PH_EN(11)
 REP(11) { RETID(); phase_final(a, lane, wave); }
#endif
 }
#undef IN
#undef SEAM
}

#ifndef N_LAUNCH_MODE
#define N_LAUNCH_MODE 1
#endif
extern "C" void kernel_launch(void* const* d_in, const int* in_sizes, int n_in, void* d_out, int out_size, void* d_ws, size_t ws_size, hipStream_t stream) {
    static int grid = 0;
    if (grid == 0) {
        if (n_in != 35 || out_size != (int)O_END || ws_size < WS_END) { fprintf(stderr, "kernel_launch: unexpected sizes n_in %d out %d ws %zu (need %zu)\n", n_in, out_size, ws_size, (size_t)WS_END); grid = -1; return; }
        int dev = 0, cus = 0, per_cu = 0;
        if (hipGetDevice(&dev) != hipSuccess || hipDeviceGetAttribute(&cus, hipDeviceAttributeMultiprocessorCount, dev) != hipSuccess) { grid = -1; return; }
        if (hipFuncSetAttribute((const void*)fwd, hipFuncAttributeMaxDynamicSharedMemorySize, LDS_BYTES) != hipSuccess) { fprintf(stderr, "kernel_launch: hipFuncSetAttribute failed\n"); grid = -1; return; }
        if (hipOccupancyMaxActiveBlocksPerMultiprocessor(&per_cu, (const void*)fwd, NTHR, LDS_BYTES) != hipSuccess || per_cu < 1) fprintf(stderr, "kernel_launch: occupancy query says %d\n", per_cu);
        (void)hipGetLastError();
        grid = cus;
    }
    if (grid < 0) return;
    if (hipMemsetAsync((char*)d_ws + WS_CTL, 0, WS_ZERO_BYTES, stream) != hipSuccess) return;
    Args a{};
    for (int i = 0; i < 35; ++i) a.in[i] = d_in[i];
    a.out = (float*)d_out; a.ws = (unsigned char*)d_ws;
#if N_LAUNCH_MODE == 1
    a.ph_lo = 0; a.ph_hi = N_PHASES;
    hipLaunchKernelGGL(fwd, dim3(grid), dim3(NTHR), LDS_BYTES, stream, a);
#else
    for (int p = 0; p < N_PHASES; ++p) { a.ph_lo = p; a.ph_hi = p + 1; hipLaunchKernelGGL(fwd, dim3(grid), dim3(NTHR), LDS_BYTES, stream, a); }
#endif
}
```

```cpp
#include <hip/hip_runtime.h>
#include <cstdio>
#include <cstdint>
namespace pg8 {
#define PG8_LAS __attribute__((address_space(3)))
typedef unsigned short bf16_t;
typedef short bf16x8 __attribute__((ext_vector_type(8)));
typedef float f32x4 __attribute__((ext_vector_type(4)));
typedef unsigned u32x4 __attribute__((ext_vector_type(4)));
constexpr int BM = 256, BK = 64, HALF = 128, HTB = HALF * BK * 2  , STAGE_BYTES = 8 * HTB, NXCD = 8, WGM = 8;

__host__ __device__ __forceinline__ int lds_byte(int r, int c) { const int st = (r >> 4) * 2 + (c >> 5), rr = r & 15, cc = c & 31, ob = rr * 64 + cc * 2; return st * 1024 + (ob ^ (((ob >> 9) & 1) << 5)); }
__host__ __device__ __forceinline__ void stage_rc(int b, int& R, int& C) { const int st = b / 1024, sb = b % 1024, swz = sb ^ (((sb >> 9) & 1) << 5); R = (st >> 1) * 16 + swz / 64; C = (st & 1) * 32 + (swz % 64) / 2; }
__host__ __device__ __forceinline__ int perm32(int rho) { const int n = rho >> 4, i = rho & 15; return 8 * (i >> 2) + 4 * n + (i & 3); }

struct Unit { int pm, pn; };
struct Gemm { const bf16_t* A; const bf16_t* Bt; int M, N, K; };

struct StaticOrder {
    int nM, nN, nwg, G, c;
    __host__ __device__ void init(int M, int N, int G_, int c_) { nM = M / BM; nN = N / BM; nwg = nM * nN; G = G_; c = c_; }
    __host__ __device__ bool next(int i, Unit& u) const {
        const long L = (long)i * G + c; if (L >= nwg) return false;
        int wgid = (int)L; { const int q = nwg / NXCD, r = nwg % NXCD, xcd = wgid % NXCD, off = wgid / NXCD; wgid = (xcd < r ? xcd * (q + 1) : r * (q + 1) + (xcd - r) * q) + off; }
        const int nig = WGM * nN, gid = wgid / nig, fm = gid * WGM, gsz = (nM - fm) < WGM ? (nM - fm) : WGM;
        u.pm = fm + ((wgid % nig) % gsz); u.pn = (wgid % nig) / gsz; return true;
    }
    __device__ __forceinline__ void a_ready(const Unit&) const {}
    __device__ __forceinline__ void done(const Unit&) const {}
    __device__ __forceinline__ bool keep(const Unit&) const { return false; }
};
__device__ __forceinline__ unsigned cvt_pk_bf16(float lo, float hi) { unsigned r; asm volatile("v_cvt_pk_bf16_f32 %0, %1, %2" : "=v"(r) : "v"(lo), "v"(hi)); return r; }
typedef float f32x2 __attribute__((ext_vector_type(2)));
template <class Epi, class Sched, bool ALIGN_EPI = false, bool SP2 = false>
__device__ __forceinline__ void gemm_phase(PG8_LAS unsigned char* lds, const Gemm g, const Sched& S, const Epi& E, int wave0) {
    int lane_l, wid_l = wave0; asm volatile("v_mbcnt_lo_u32_b32 %0, -1, 0\n\tv_mbcnt_hi_u32_b32 %0, -1, %0" : "=v"(lane_l)); asm volatile("" : "+s"(wid_l)); const int wid = wid_l, lane = lane_l, tid = wid * 64 + lane, wr = wid >> 2, wc = wid & 3, fr = lane & 15, fq = lane >> 4;
    int K_l = g.K; asm volatile("" : "+s"(K_l)); const int K = K_l, nt = K / BK;
    unsigned voffA[2], voffB[2];
#pragma unroll
    for (int i = 0; i < 2; ++i) { int R, C; stage_rc(tid * 16 + i * 8192, R, C); const int Rb = Epi::PERM ? ((R & ~31) + perm32(R & 31)) : R;
        voffA[i] = (unsigned)(R * K + C) * 2u; voffB[i] = (unsigned)(Rb * K + C) * 2u; }
    const size_t kstep = (size_t)(BK * 2);
    const size_t hstep = (size_t)HALF * K * 2;
    const size_t tstep = 2 * hstep;
    const unsigned ldsw = (unsigned)wid * 1024u;
    const int aoff = lds_byte(wr * 64 + fr, fq * 8), boff = lds_byte(wc * 32 + fr, fq * 8);
#define PG8_SA(b, h) (((b) * 2 + (h)) * HTB)
#define PG8_SB(b, h) ((4 + (b) * 2 + (h)) * HTB)
#define PG8_STAGE(bufoff, gbase, voff) do { _Pragma("unroll") for (int _i = 0; _i < 2; ++_i) \
        __builtin_amdgcn_global_load_lds((const unsigned*)((const char*)(gbase) + (voff)[_i]), (PG8_LAS unsigned*)(lds + (bufoff) + ldsw + _i * 8192), 16, 0, 0); } while (0)
#define PG8_LDA(dst, b, h) do { _Pragma("unroll") for (int m = 0; m < 4; ++m) _Pragma("unroll") for (int k = 0; k < 2; ++k) dst[m][k] = *(const PG8_LAS bf16x8*)(lds + PG8_SA(b, h) + aoff + m * 2048 + k * 1024); } while (0)
#define PG8_LDB(dst, b, h) do { _Pragma("unroll") for (int n = 0; n < 2; ++n) _Pragma("unroll") for (int k = 0; k < 2; ++k) dst[n][k] = *(const PG8_LAS bf16x8*)(lds + PG8_SB(b, h) + boff + n * 2048 + k * 1024); } while (0)
#define PG8_MMA(ai, bj, At, Bt) do { __builtin_amdgcn_s_setprio(1); _Pragma("unroll") for (int m = 0; m < 4; ++m) _Pragma("unroll") for (int n = 0; n < 2; ++n) _Pragma("unroll") for (int k = 0; k < 2; ++k) \
        acc[ai][bj][m][n] = __builtin_amdgcn_mfma_f32_16x16x32_bf16(Bt[n][k], At[m][k], acc[ai][bj][m][n], 0, 0, 0); __builtin_amdgcn_s_setprio(0); } while (0)
#define PG8_WAIT_V(n) asm volatile("s_waitcnt vmcnt(" #n ")" ::: "memory")
#define PG8_WAIT_L(n) asm volatile("s_waitcnt lgkmcnt(" #n ")" ::: "memory")
#define PG8_BAR __builtin_amdgcn_s_barrier()
#define PG8_SCHED __builtin_amdgcn_sched_barrier(0)
    Unit cur, nxt; int ui = 0;
    if (!S.next(0, cur)) return;
    f32x4 acc[2][2][4][2];
#pragma unroll
    for (int a = 0; a < 2; ++a)
#pragma unroll
        for (int b = 0; b < 2; ++b)
#pragma unroll
            for (int m = 0; m < 4; ++m)
#pragma unroll
                for (int n = 0; n < 2; ++n) acc[a][b][m][n] = (f32x4){0.f, 0.f, 0.f, 0.f};
    bf16x8 At[4][2], B0[2][2], B1[2][2];
    const char* cA = (const char*)g.A + (size_t)cur.pm * tstep; const char* cB = (const char*)g.Bt + (size_t)cur.pn * tstep;
    S.a_ready(cur);
    if constexpr (SP2) {
        PG8_STAGE(PG8_SB(0, 0), cB, voffB); PG8_STAGE(PG8_SB(0, 1), cB + hstep, voffB); PG8_STAGE(PG8_SA(0, 0), cA, voffA); PG8_STAGE(PG8_SA(0, 1), cA + hstep, voffA);
        if (wr == 1) PG8_BAR;
        PG8_WAIT_V(2); PG8_BAR;
        PG8_STAGE(PG8_SB(1, 0), cB + kstep, voffB); PG8_STAGE(PG8_SA(1, 0), cA + kstep, voffA); PG8_STAGE(PG8_SB(1, 1), cB + hstep + kstep, voffB);
        PG8_WAIT_V(6); PG8_BAR;
    } else {
        PG8_STAGE(PG8_SB(0, 0), cB, voffB); PG8_STAGE(PG8_SA(0, 0), cA, voffA); PG8_STAGE(PG8_SB(0, 1), cB + hstep, voffB); PG8_STAGE(PG8_SA(0, 1), cA + hstep, voffA);
        if (wr == 1) PG8_BAR;
        PG8_WAIT_V(4); PG8_BAR;
        PG8_STAGE(PG8_SB(1, 0), cB + kstep, voffB); PG8_STAGE(PG8_SA(1, 0), cA + kstep, voffA); PG8_STAGE(PG8_SB(1, 1), cB + hstep + kstep, voffB);
        PG8_WAIT_V(6); PG8_BAR;
    }
    for (;;) {
        const bool has_next = S.next(ui + 1, nxt);
        const char* nA = has_next ? (const char*)g.A + (size_t)nxt.pm * tstep : cA; const char* nB = has_next ? (const char*)g.Bt + (size_t)nxt.pn * tstep : cB;
        for (int t = 0; t < nt; t += 2) {
            const bool last = (t == nt - 2);
            const char* a1 = cA + (size_t)(t + 1) * kstep;
            const char* a2 = last ? nA : cA + (size_t)(t + 2) * kstep; const char* b2 = last ? nB : cB + (size_t)(t + 2) * kstep;
            const char* a3 = a2 + kstep; const char* b3 = b2 + kstep;
            if (last && has_next) S.a_ready(nxt);
            if constexpr (SP2) {
            PG8_LDB(B0, 0, 0); PG8_LDB(B1, 0, 1); PG8_SCHED; PG8_LDA(At, 0, 0); PG8_STAGE(PG8_SA(1, 1), a1 + hstep, voffA);
            PG8_WAIT_V(8); PG8_WAIT_L(0); PG8_BAR; PG8_MMA(0, 0, At, B0); PG8_MMA(0, 1, At, B1); PG8_BAR; PG8_SCHED;
            PG8_LDA(At, 0, 1); PG8_STAGE(PG8_SB(0, 0), b2, voffB); PG8_STAGE(PG8_SB(0, 1), b2 + hstep, voffB); PG8_STAGE(PG8_SA(0, 0), a2, voffA);
            PG8_WAIT_V(8); PG8_WAIT_L(0); PG8_BAR; PG8_MMA(1, 0, At, B0); PG8_MMA(1, 1, At, B1); PG8_BAR; PG8_SCHED;
            PG8_LDB(B0, 1, 0); PG8_LDB(B1, 1, 1); PG8_SCHED; PG8_LDA(At, 1, 0); PG8_STAGE(PG8_SA(0, 1), a2 + hstep, voffA);
            PG8_WAIT_V(8); PG8_WAIT_L(0); PG8_BAR; PG8_MMA(0, 0, At, B0); PG8_MMA(0, 1, At, B1); PG8_BAR; PG8_SCHED;
            PG8_LDA(At, 1, 1); PG8_STAGE(PG8_SB(1, 0), b3, voffB); PG8_STAGE(PG8_SB(1, 1), b3 + hstep, voffB); PG8_STAGE(PG8_SA(1, 0), a3, voffA);
            PG8_WAIT_V(8); PG8_WAIT_L(0); PG8_BAR; PG8_MMA(1, 0, At, B0); PG8_MMA(1, 1, At, B1); PG8_BAR; PG8_SCHED;
            } else {
            PG8_LDB(B0, 0, 0); PG8_SCHED; PG8_LDA(At, 0, 0); PG8_STAGE(PG8_SA(1, 1), a1 + hstep, voffA);
            PG8_WAIT_L(8); PG8_BAR; PG8_WAIT_L(0); PG8_MMA(0, 0, At, B0); PG8_BAR; PG8_SCHED;
            PG8_LDB(B1, 0, 1); PG8_STAGE(PG8_SB(0, 0), b2, voffB);
            PG8_BAR; PG8_WAIT_L(0); PG8_MMA(0, 1, At, B1); PG8_BAR;
            PG8_LDA(At, 0, 1); PG8_STAGE(PG8_SA(0, 0), a2, voffA);
            PG8_BAR; PG8_WAIT_L(0); PG8_MMA(1, 0, At, B0); PG8_BAR; PG8_SCHED;
            PG8_STAGE(PG8_SB(0, 1), b2 + hstep, voffB);
            PG8_WAIT_V(6); PG8_BAR; PG8_MMA(1, 1, At, B1); PG8_BAR;
            PG8_LDB(B0, 1, 0); PG8_SCHED; PG8_LDA(At, 1, 0); PG8_STAGE(PG8_SA(0, 1), a2 + hstep, voffA);
            PG8_WAIT_L(8); PG8_BAR; PG8_WAIT_L(0); PG8_MMA(0, 0, At, B0); PG8_BAR; PG8_SCHED;
            PG8_LDB(B1, 1, 1); PG8_STAGE(PG8_SB(1, 0), b3, voffB);
            PG8_BAR; PG8_WAIT_L(0); PG8_MMA(0, 1, At, B1); PG8_BAR;
            PG8_LDA(At, 1, 1); PG8_STAGE(PG8_SA(1, 0), a3, voffA);
            PG8_BAR; PG8_WAIT_L(0); PG8_MMA(1, 0, At, B0); PG8_BAR; PG8_SCHED;
            PG8_STAGE(PG8_SB(1, 1), b3 + hstep, voffB);
            PG8_WAIT_V(6); PG8_BAR; PG8_MMA(1, 1, At, B1); PG8_BAR;
            }
        }
        if constexpr (ALIGN_EPI) { if (wr == 0) PG8_BAR; }
        if constexpr (!Epi::AFTER_DRAIN) { E(acc, cur, wr, wc, fr, fq); S.done(cur); }
        if (!has_next) break;
        if (!S.keep(cur))
#pragma unroll
        for (int a = 0; a < 2; ++a)
#pragma unroll
            for (int b = 0; b < 2; ++b)
#pragma unroll
                for (int m = 0; m < 4; ++m)
#pragma unroll
                    for (int n = 0; n < 2; ++n) acc[a][b][m][n] = (f32x4){0.f, 0.f, 0.f, 0.f};
        cur = nxt; cA = nA; cB = nB; ++ui;
        if constexpr (ALIGN_EPI) { if (wr == 1) PG8_BAR; }
    }
    PG8_WAIT_V(0);
    if constexpr (!ALIGN_EPI) { if (wr == 0) PG8_BAR; }
    PG8_BAR;
    if constexpr (Epi::AFTER_DRAIN) { E.fused(acc, cur, wr, wc, fr, fq, lds, wid, lane); S.done(cur); }
#undef PG8_SA
#undef PG8_SB
#undef PG8_STAGE
#undef PG8_LDA
#undef PG8_LDB
#undef PG8_MMA
#undef PG8_WAIT_V
#undef PG8_WAIT_L
#undef PG8_BAR
#undef PG8_SCHED
}
}

constexpr int NWAVES = 8, NTHR = 512;
constexpr int DM = 1024, NB_P = 8, SEQ = 2048, NB_S = 32, TSMP = 8, DEPTH = 2;
constexpr int MP = NB_P * SEQ, MS = NB_S * TSMP, MT = MP + MS;
constexpr int PAST = 16384, PAGE = 128, NPAGES = 128, NPOOL = 5120;
constexpr int NH = 8, QKN = 64, QKR = 32, DQK = 96, VH = 64, QL = 384, KVL = 256, DMLA = 512;
constexpr int DC = 256, RH = 4, RN = 64, DR = 256, SW = 896, WL = 64;
constexpr int PROJ_SRC = 6432, NPROJ = 6656, PW = 6144;
constexpr int C_KV = 0, C_KR = 256, C_ZM = 384, C_CB = 896, C_CC = 1152, C_CX = 1408, C_ZC = 1664, C_RW = 1920, C_ZR = 2816, C_GM = 3072;
constexpr int NCB = NB_P + NB_S;
constexpr float RMS_EPS = 1e-6f, GN_EPS = 64e-5f;
constexpr float SC2 = 0.10206207261596577f * 1.4426950408889634f;
constexpr int NROPE = SEQ + TSMP;

constexpr size_t O_YP = 0, O_YS = O_YP + (size_t)MP * DM, O_CKVP = O_YS + (size_t)MS * DM, O_KPEP = O_CKVP + (size_t)DEPTH * MP * KVL,
    O_CONVP = O_KPEP + (size_t)DEPTH * MP * QKR, O_SHP = O_CONVP + (size_t)DEPTH * NB_P * 2 * DC, O_RWP = O_SHP + (size_t)DEPTH * NB_P * SW,
    O_CKVS = O_RWP + (size_t)DEPTH * NB_P * RH * RN * RN, O_KPES = O_CKVS + (size_t)DEPTH * MS * KVL, O_CONVS = O_KPES + (size_t)DEPTH * MS * QKR,
    O_SHS = O_CONVS + (size_t)DEPTH * NB_S * 2 * DC, O_RWS = O_SHS + (size_t)DEPTH * NB_S * SW, O_END = O_RWS + (size_t)DEPTH * NB_S * RH * RN * RN;
static_assert(O_END == 28047360, "output size");

constexpr size_t MiB = 1u << 20;
constexpr size_t al256(size_t x) { return (x + 255) & ~(size_t)255; }
constexpr size_t WS_CTL = 0;
constexpr size_t WS_MOD = 1 * MiB;
constexpr size_t WS_ZERO_BYTES = 2 * MiB;
static_assert((size_t)DEPTH * NCB * 3072 * 4 <= MiB, "MOD fits");
constexpr size_t WS_ROPE = 2 * MiB;
constexpr size_t WS_RSQ = WS_ROPE + al256((size_t)NROPE * 32 * 4);
constexpr size_t WS_W = 3 * MiB;
constexpr size_t LW_IN = 0, LW_Q = LW_IN + (size_t)NPROJ * DM * 2, LW_KV = LW_Q + (size_t)768 * QL * 2, LW_MLA = LW_KV + (size_t)1024 * KVL * 2,
    LW_CONV = LW_MLA + (size_t)DM * DMLA * 2, LW_RW = LW_CONV + (size_t)DM * DC * 2, LW_OUT = LW_RW + (size_t)DM * DR * 2, LW_W2T = LW_OUT + (size_t)DM * DM * 2, LW_A2T = LW_W2T + (size_t)DR * WL * 2, LW_STRIDE = LW_A2T + (size_t)DR * WL * 2;
constexpr size_t WS_U = al256(WS_W + 2 * LW_STRIDE);
constexpr size_t WS_QA = WS_U + (size_t)MT * DM * 2;
constexpr size_t WS_PROJ = WS_QA + (size_t)MT * QL * 2;
constexpr size_t WS_CKV = WS_PROJ + (size_t)MT * PW * 2;
constexpr size_t WS_KPE = WS_CKV + (size_t)MT * KVL * 2;
constexpr size_t WS_A4 = WS_KPE + (size_t)MT * QKR * 2;
constexpr size_t A4_STRIDE = (size_t)MT * 256;
constexpr size_t WS_SC = WS_A4 + 4 * A4_STRIDE * 2;
constexpr size_t WS_BONUS = WS_SC + (size_t)MT * 6 * DR * 4;
constexpr size_t WS_Q = WS_BONUS + (size_t)MT * DR * 4;
constexpr size_t WS_QS = WS_Q + (size_t)MP * 768 * 2;
constexpr size_t WS_KN = WS_QS + (size_t)MS * 768 * 4;
constexpr size_t WS_V = WS_KN + (size_t)MP * 512 * 2;
constexpr size_t WS_QLAT = WS_V + (size_t)MP * 512 * 2;
constexpr size_t WS_PO = WS_QLAT + (size_t)NB_S * 64 * 288 * 2;
constexpr size_t WS_PM = WS_PO + (size_t)NB_S * 8 * 64 * 256 * 4;
constexpr size_t WS_PL = WS_PM + (size_t)NB_S * 8 * 64 * 4;
constexpr size_t WS_MG = WS_PL + (size_t)NB_S * 8 * 64 * 4;
constexpr size_t WS_MERGED = WS_MG + (size_t)MT * DM * 2;
constexpr size_t WS_X1 = WS_MERGED + (size_t)MT * DM * 2;
constexpr size_t WS_X2 = WS_X1 + (size_t)MT * DM * 4;
constexpr size_t WS_YL = WS_X2 + (size_t)MT * DM * 4;
constexpr size_t WS_YP = WS_YL + (size_t)MP * DR * 4;
constexpr size_t WS_QC = WS_YP + (size_t)MP * DR * 4;
constexpr int RCL = 32, RNC = SEQ / RCL;
constexpr size_t WS_PC = WS_QC + (size_t)32 * RNC * 4096 * 4;
constexpr size_t WS_SALL = WS_PC + (size_t)32 * RNC * 4096 * 2;
constexpr size_t WS_END = WS_SALL + (size_t)32 * RNC * 4096 * 4;
constexpr int CW_BAR = 4096;

constexpr int RING_OFF = 0, RING_BYTES = 131072;
constexpr int LDSCTL_OFF = RING_BYTES, MISC_OFF = LDSCTL_OFF + 320;
constexpr int LDS_BYTES = 147456;

#define GAS __attribute__((address_space(1)))
#define LAS __attribute__((address_space(3)))
typedef unsigned short bf16;
typedef unsigned v4u __attribute__((ext_vector_type(4)));
typedef unsigned v2u __attribute__((ext_vector_type(2)));
typedef float f32x4 __attribute__((ext_vector_type(4)));
typedef float f32x2 __attribute__((ext_vector_type(2)));
typedef float f32x16 __attribute__((ext_vector_type(16)));
typedef short bf16x8 __attribute__((ext_vector_type(8)));
typedef short s16x4 __attribute__((ext_vector_type(4)));
typedef short v4i16_t __attribute__((ext_vector_type(4)));
#define LDS_WAIT() asm volatile("s_waitcnt lgkmcnt(0)" ::: "memory")
#define VM_WAIT() asm volatile("s_waitcnt vmcnt(0)" ::: "memory")
typedef float f32x2_t __attribute__((ext_vector_type(2)));
typedef __bf16 bf16x2_t __attribute__((ext_vector_type(2)));
__device__ __forceinline__ unsigned pk2(float lo, float hi) { f32x2_t v = {lo, hi}; bf16x2_t b = __builtin_convertvector(v, bf16x2_t); return __builtin_bit_cast(unsigned, b); }
__device__ __forceinline__ unsigned f2bf(float f) { return pk2(f, 0.f) & 0xffffu; }
__device__ __forceinline__ float bflo(unsigned u) { return __builtin_bit_cast(float, u << 16); }
__device__ __forceinline__ float bfhi(unsigned u) { return __builtin_bit_cast(float, u & 0xffff0000u); }
__device__ __forceinline__ float bf1(bf16 b) { return __builtin_bit_cast(float, ((unsigned)b) << 16); }
#define SHX(x, o) __builtin_bit_cast(float, __builtin_amdgcn_ds_bpermute(((lane) ^ (o)) << 2, __builtin_bit_cast(int, (float)(x))))
__device__ __forceinline__ float wave_sum_l(float v, int lane) {
#pragma unroll
    for (int o = 1; o < 64; o <<= 1) v += SHX(v, o);
    return v;
}
__device__ __forceinline__ float grp16_sum_l(float v, int lane) {
#pragma unroll
    for (int o = 1; o < 16; o <<= 1) v += SHX(v, o);
    return v;
}
#define RDL(x, k) __builtin_bit_cast(float, __builtin_amdgcn_readlane(__builtin_bit_cast(int, (float)(x)), (k)))
#define wave_sum(v) wave_sum_l((v), lane)
#define grp16_sum(v) grp16_sum_l((v), lane)
__device__ __forceinline__ float fexp(float x) { return __builtin_amdgcn_exp2f(x * 1.4426950408889634f); }
__device__ __forceinline__ float frcp(float x) { return __builtin_amdgcn_rcpf(x); }
__device__ __forceinline__ float frsq(float x) { return __builtin_amdgcn_rsqf(x); }
__device__ __forceinline__ float sigm(float x) { return frcp(1.f + fexp(-x)); }
__device__ __forceinline__ float silu(float x) { return x * frcp(1.f + fexp(-x)); }
__device__ __forceinline__ void row_info(int m, int& b, int& t, int& T, int& cb, int& pidx) {
    if (m < MP) { b = m >> 11; t = m & 2047; T = SEQ; cb = b; pidx = t; }
    else { const int mm = m - MP; b = mm >> 3; t = mm & 7; T = TSMP; cb = NB_P + b; pidx = SEQ + t; }
}
#define XB_TMO      128
#define XB_XCNT(j)  (256  + 64 * (j))
#define XB_XSUB(j)  (1280 + 64 * (j))
#define XB_XGEN(j)  (2304 + 64 * (j))
#define XB_TOP      3328
#define XB_TOPGEN   3392
#define XCD_BAR_WORDS 3456
#define XB_SPIN_CAP (1u << 18)

__device__ __forceinline__ unsigned xb_ld(unsigned* p)              { return __hip_atomic_load(p, __ATOMIC_RELAXED, __HIP_MEMORY_SCOPE_AGENT); }
__device__ __forceinline__ unsigned xb_add(unsigned* p, unsigned v) { return __hip_atomic_fetch_add(p, v, __ATOMIC_RELAXED, __HIP_MEMORY_SCOPE_AGENT); }
__device__ __forceinline__ unsigned xb_xcc_id() { return (unsigned)__builtin_amdgcn_s_getreg((3 << 11) | 20) & 0xFu; }
#define XB_SPIN(cond, bar) do { unsigned _sp = 0; while (cond) { __builtin_amdgcn_s_sleep(1); \
    if ((++_sp & 255u) == 0u) { if (xb_ld(&(bar)[XB_TMO])) break; if (_sp > XB_SPIN_CAP) { atomicAdd(&(bar)[XB_TMO], 1u); break; } } } } while (0)

struct XcdBarrier {
    unsigned* bar; unsigned x;
    volatile LAS unsigned* st;
};

__device__ __forceinline__ XcdBarrier xcd_barrier_post(unsigned* bar, volatile LAS unsigned* st) {
    XcdBarrier b; b.bar = bar; b.x = xb_xcc_id(); b.st = st;
    if (threadIdx.x == 0) (void)xb_add(&bar[XB_XCNT(b.x)], 1u);
    return b;
}
__device__ __forceinline__ void xcd_barrier_complete(unsigned* bar, unsigned x, unsigned& nloc, unsigned& nx) {
    const unsigned G = gridDim.x * gridDim.y * gridDim.z;
    unsigned sum, cnt, mine, sp = 0u;
    for (;;) {
        sum = 0u; cnt = 0u; mine = 0u;
#pragma unroll
        for (unsigned j = 0; j < 16; ++j) { const unsigned c = xb_ld(&bar[XB_XCNT(j)]); sum += c; cnt += (c > 0u) ? 1u : 0u; mine = (j == x) ? c : mine; }
        if (sum == G) break;
        __builtin_amdgcn_s_sleep(1);
        if ((++sp & 255u) == 0u) { if (xb_ld(&bar[XB_TMO])) break; if (sp > XB_SPIN_CAP) { atomicAdd(&bar[XB_TMO], 1u); break; } }
    }
    nloc = mine > 0u ? mine : 1u; nx = cnt > 0u ? cnt : 1u;
}

__device__ __forceinline__ void xcd_barrier(const XcdBarrier& b) {
    asm volatile("s_waitcnt vmcnt(0)" ::: "memory");
    __syncthreads();
    if (threadIdx.x == 0) {
        unsigned* bar = b.bar;
        __builtin_amdgcn_s_waitcnt(0);
        unsigned nloc = b.st[0], nx = b.st[1];
        if (nloc == 0u) { xcd_barrier_complete(bar, b.x, nloc, nx); b.st[0] = nloc; b.st[1] = nx; }
        const unsigned old = xb_add(&bar[XB_XSUB(b.x)], 1u);
        const unsigned gen = old / nloc;
        if (old + 1u == (gen + 1u) * nloc) {
            __builtin_amdgcn_fence(__ATOMIC_RELEASE, "agent");
            asm volatile("s_waitcnt vmcnt(0)" ::: "memory");
            const unsigned og = xb_add(&bar[XB_TOP], 1u);
            const unsigned tg = og / nx;
            if (og + 1u == (tg + 1u) * nx) xb_add(&bar[XB_TOPGEN], 1u);
            else XB_SPIN(xb_ld(&bar[XB_TOPGEN]) == tg, bar);
            __builtin_amdgcn_fence(__ATOMIC_ACQUIRE, "agent");
            xb_add(&bar[XB_XGEN(b.x)], 1u);
            asm volatile("s_waitcnt vmcnt(0)" ::: "memory");
        } else {
            XB_SPIN(xb_ld(&bar[XB_XGEN(b.x)]) == gen, bar);
            __builtin_amdgcn_fence(__ATOMIC_ACQUIRE, "agent");
            asm volatile("s_waitcnt vmcnt(0)" ::: "memory");
        }
    }
    __syncthreads();
}

#ifndef PROBE_DBL
#define PROBE_DBL 0
#endif
struct Args { const void* in[35]; float* out; unsigned char* ws; int ph_lo, ph_hi; };
enum { I_XP = 0, I_XS, I_CCKV, I_CKPE, I_SCONV, I_SSHIFT, I_SRWKV, I_PT, I_CP, I_CS, I_NORMG, I_WADA, I_BADA, I_WIN, I_QNG, I_WQB, I_KVNG, I_WUK, I_WUV, I_WMLA,
       I_CONVW, I_WCONV, I_MU, I_W0, I_W2, I_A0, I_A2, I_KK, I_KA, I_RK, I_GNG, I_GNB, I_WRW, I_WOUT, I_FNG };
#define INF(i) ((const float*)a.in[i])

struct ColIdent { int off; __device__ __forceinline__ int operator()(int d) const { return d + off; } };
struct ColWin { __device__ __forceinline__ int operator()(int d) const {
    if (d < 384) return d; if (d < 512) return -1; const int pc = d - 512;
    if (pc < 256) return 384 + pc;
    if (pc < 384) return (pc - 256 < 32) ? 640 + pc - 256 : -1;
    if (pc < 896) return 672 + pc - 384;
    if (pc < 1920) return 1184 + pc - 896;
    if (pc < 2816) return 2208 + pc - 1920;
    if (pc < 3072) return 3104 + pc - 2816;
    return 3360 + pc - 3072; } };
struct ColWq { __device__ __forceinline__ int operator()(int d) const { const int h = d / 96, j = d - h * 96; if (j < 64) return d; const int i = (j - 64) >> 1, par = (j - 64) & 1; return h * 96 + 64 + par * 16 + i; } };

template <class SrcCol>
__device__ __forceinline__ void tr_item(const float* __restrict__ W, int K, int Nsrc, bf16* WT, LAS float* scr, int item, int nblk, int lane, SrcCol sc, const float* __restrict__ kscale) {
    const int kb = item / nblk, nb = item - kb * nblk, k0 = 64 * kb, n0 = 32 * nb;
    const int srcc = sc(n0 + (lane & 31));
    float tv[32];
#pragma unroll
    for (int i = 0; i < 32; ++i) { const int kk = 2 * i + (lane >> 5); float v = 0.f; if (srcc >= 0) v = W[(size_t)(k0 + kk) * Nsrc + srcc]; if (kscale) v *= kscale[k0 + kk]; tv[i] = v; }
#pragma unroll
    for (int i = 0; i < 32; ++i) { const int kk = 2 * i + (lane >> 5); scr[kk * 33 + (lane & 31)] = tv[i]; }
    LDS_WAIT(); asm volatile("" ::: "memory");
    const int c = lane & 7;
#pragma unroll
    for (int j = 0; j < 4; ++j) { const int n = (lane >> 3) + 8 * j; const LAS float* s = scr + (8 * c) * 33 + n;
        v4u o; o.x = pk2(s[0], s[33]); o.y = pk2(s[66], s[99]); o.z = pk2(s[132], s[165]); o.w = pk2(s[198], s[231]);
        *(GAS v4u*)(WT + (size_t)(n0 + n) * K + k0 + 8 * c) = o; }
    LDS_WAIT(); asm volatile("" ::: "memory");
}

__device__ __forceinline__ void convert_weights(const Args& a, unsigned char* ws, LAS unsigned char* lds, int lane, int wave, int l, int gw, int NGW) {
    LAS float* scr = (LAS float*)(lds + wave * 16384);
    constexpr int I_IN = (DM / 64) * (NPROJ / 32), I_Q = (QL / 64) * (768 / 32), I_K = (KVL / 64) * (512 / 32), I_MLA = (DMLA / 64) * (DM / 32), I_C = (DC / 64) * (DM / 32), I_O = (DM / 64) * (DM / 32);
    constexpr int I_L = (WL / 64) * (DR / 32);
    constexpr int PER_L = I_IN + I_Q + 2 * I_K + I_MLA + 2 * I_C + I_O + 2 * I_L;
    unsigned char* wl = ws + WS_W + (size_t)l * LW_STRIDE;
    for (int rep_ = 0; rep_ < (((PROBE_DBL >> 21) & 1) ? 2 : 1); ++rep_)
    for (int it = gw; it < PER_L; it += NGW) {
        int r = it;
        if (r < I_IN) { tr_item(INF(I_WIN) + (size_t)l * DM * PROJ_SRC, DM, PROJ_SRC, (bf16*)(wl + LW_IN), scr, r, NPROJ / 32, lane, ColWin{}, nullptr); continue; } r -= I_IN;
        if (r < I_Q) { tr_item(INF(I_WQB) + (size_t)l * QL * 768, QL, 768, (bf16*)(wl + LW_Q), scr, r, 768 / 32, lane, ColWq{}, INF(I_QNG) + l * QL); continue; } r -= I_Q;
        if (r < I_K) { tr_item(INF(I_WUK) + (size_t)l * KVL * 512, KVL, 512, (bf16*)(wl + LW_KV), scr, r, 512 / 32, lane, ColIdent{0}, nullptr); continue; } r -= I_K;
        if (r < I_K) { tr_item(INF(I_WUV) + (size_t)l * KVL * 512, KVL, 512, (bf16*)(wl + LW_KV) + (size_t)512 * KVL, scr, r, 512 / 32, lane, ColIdent{0}, nullptr); continue; } r -= I_K;
        if (r < I_MLA) { const int hfm = r >= I_MLA / 2;
            tr_item(INF(I_WMLA) + (size_t)l * DMLA * DM + (size_t)hfm * 256 * DM, 256, DM, (bf16*)(wl + LW_MLA) + (size_t)hfm * DM * 256, scr, r - hfm * (I_MLA / 2), DM / 32, lane, ColIdent{0}, nullptr); continue; } r -= I_MLA;
        if (r < I_C) { tr_item(INF(I_WCONV) + (size_t)l * DC * DM, DC, DM, (bf16*)(wl + LW_CONV), scr, r, DM / 32, lane, ColIdent{0}, nullptr); continue; } r -= I_C;
        if (r < I_C) { tr_item(INF(I_WRW) + (size_t)l * DR * DM, DR, DM, (bf16*)(wl + LW_RW), scr, r, DM / 32, lane, ColIdent{0}, nullptr); continue; } r -= I_C;
        if (r < I_O) { tr_item(INF(I_WOUT) + (size_t)l * DM * DM, DM, DM, (bf16*)(wl + LW_OUT), scr, r, DM / 32, lane, ColIdent{0}, nullptr); continue; } r -= I_O;
        if (r < I_L) { tr_item(INF(I_W2) + (size_t)l * WL * DR, WL, DR, (bf16*)(wl + LW_W2T), scr, r, DR / 32, lane, ColIdent{0}, nullptr); continue; } r -= I_L;
        tr_item(INF(I_A2) + (size_t)l * WL * DR, WL, DR, (bf16*)(wl + LW_A2T), scr, r, DR / 32, lane, ColIdent{0}, nullptr);
    }
}

__device__ __forceinline__ void phase_prologue(const Args& a, LAS unsigned char* lds, int tid, int lane, int wave) {
    GAS unsigned char* wsg_ = (GAS unsigned char*)a.ws; asm volatile("" : "+s"(wsg_)); unsigned char* ws = (unsigned char*)wsg_;
    for (int arep_ = 0; arep_ < (((PROBE_DBL >> 22) & 1) ? 2 : 1); ++arep_)
    if (blockIdx.x < 192) {
        const int task = blockIdx.x, l = task / 96, rem = task - l * 96, kc = rem / 12, cc = rem - kc * 12;
        LAS float* tab = (LAS float*)lds;
        for (int i = 0; i < 10; ++i) { const int idx = tid + 512 * i, k = idx / 40, b = idx - k * 40;
            const float cv = (b < NB_P) ? INF(I_CP)[b * DM + kc * 128 + k] : INF(I_CS)[(b - NB_P) * DM + kc * 128 + k]; tab[idx] = silu(cv); }
        __syncthreads();
        const int j = cc * 256 + (tid & 255), half = tid >> 8;
        float acc[20];
#pragma unroll
        for (int q = 0; q < 20; ++q) acc[q] = 0.f;
        const float* wp = INF(I_WADA) + ((size_t)l * DM + kc * 128) * 3072 + j;
        for (int kb = 0; kb < 128; kb += 32) {
            float wv[32];
#pragma unroll
            for (int k = 0; k < 32; ++k) wv[k] = wp[(size_t)(kb + k) * 3072];
#pragma unroll
            for (int k = 0; k < 32; ++k) { const float w = wv[k]; const LAS f32x4* tr = (const LAS f32x4*)(tab + (kb + k) * 40 + half * 20);
#pragma unroll
                for (int q = 0; q < 5; ++q) { const f32x4 t4 = tr[q]; acc[4 * q] += t4.x * w; acc[4 * q + 1] += t4.y * w; acc[4 * q + 2] += t4.z * w; acc[4 * q + 3] += t4.w * w; } }
        }
        float* mod = (float*)(ws + WS_MOD) + ((size_t)l * NCB + half * 20) * 3072 + j;
#pragma unroll
        for (int q = 0; q < 20; ++q) unsafeAtomicAdd(mod + (size_t)q * 3072, ((PROBE_DBL >> 22) & 1) ? 0.5f * acc[q] : acc[q]);
        __syncthreads();
    }
    { const int gid = blockIdx.x * NTHR + tid;
      if (gid < NROPE * 16) { const int pidx = gid >> 4, i = gid & 15; const int pos = pidx < SEQ ? pidx : PAST + (pidx - SEQ);
        const double invd[16] = {1.0, 0.5623413251903491, 0.31622776601683794, 0.1778279410038923, 0.1, 0.05623413251903491, 0.03162277660168379, 0.01778279410038923,
                                 0.01, 0.005623413251903491, 0.0031622776601683794, 0.0017782794100389228, 0.001, 0.0005623413251903491, 0.00031622776601683794, 0.00017782794100389227};
        double iv = 1.0;
#pragma unroll
        for (int q = 0; q < 16; ++q) iv = (i == q) ? invd[q] : iv;
        const float ang = (float)pos * (float)iv;
        const double rev = (double)ang * 0.15915494309189535; double fr = rev - floor(rev); if (fr > 0.5) fr -= 1.0;
        const float r = (float)(fr * 6.283185307179586);
        float* rp = (float*)(ws + WS_ROPE) + (size_t)gid * 2; rp[0] = __cosf(r); rp[1] = __sinf(r); } }
    convert_weights(a, ws, lds, lane, wave, 0, blockIdx.x * NWAVES + wave, gridDim.x * NWAVES);
}

__device__ __forceinline__ const float* xrow_ptr(const Args& a, unsigned char* ws, int l, int m) {
    if (l == 0) return (m < MP) ? INF(I_XP) + (size_t)m * DM : INF(I_XS) + (size_t)(m - MP) * DM;
    return (const float*)(ws + WS_X1) + (size_t)m * DM;
}
__device__ __forceinline__ void phase_modulate(const Args& a, int l, int lane, int wave) {
    GAS unsigned char* wsg_ = (GAS unsigned char*)a.ws; asm volatile("" : "+s"(wsg_)); unsigned char* ws = (unsigned char*)wsg_;
    const int gw = blockIdx.x * NWAVES + wave, NGW = gridDim.x * NWAVES;
    const float* mod = (const float*)(ws + WS_MOD) + (size_t)l * NCB * 3072; const float* bada = INF(I_BADA) + l * 3072; const float* ng = INF(I_NORMG) + l * DM;
    bf16* U = (bf16*)(ws + WS_U);
    for (int grp = gw; grp < MT / 8; grp += NGW) {
        const int mbase = grp * 8; int b, t, T, cb, pidx; row_info(mbase, b, t, T, cb, pidx);
        const float* mrow = mod + (size_t)cb * 3072;
        f32x4 g[4], sh[4], sc[4];
#pragma unroll
        for (int j = 0; j < 4; ++j) { const int col = 4 * lane + 256 * j; g[j] = *(const f32x4*)(ng + col); sh[j] = *(const f32x4*)(mrow + col) + *(const f32x4*)(bada + col);
            sc[j] = *(const f32x4*)(mrow + DM + col) + *(const f32x4*)(bada + DM + col) + 1.0f; }
        f32x4 nx[4]; v2u nr[4];
        auto load_row = [&](int mr) {
            if (l == 0) { const f32x4* xr = (const f32x4*)xrow_ptr(a, ws, 0, mr) + lane;
#pragma unroll
                for (int j = 0; j < 4; ++j) nx[j] = xr[64 * j]; }
            else { const v2u* xr = (const v2u*)((const bf16*)(ws + WS_X1) + (size_t)mr * DM) + lane;
#pragma unroll
                for (int j = 0; j < 4; ++j) nr[j] = xr[64 * j]; } };
        load_row(mbase);
        for (int r = 0; r < 8; ++r) {
            const int m = mbase + r;
            f32x4 v[4];
            if (l == 0) {
#pragma unroll
                for (int j = 0; j < 4; ++j) v[j] = nx[j]; }
            else {
#pragma unroll
                for (int j = 0; j < 4; ++j) v[j] = (f32x4){bflo(nr[j].x), bfhi(nr[j].x), bflo(nr[j].y), bfhi(nr[j].y)}; }
            if (r + 1 < 8) load_row(m + 1);
            float ss = 0.f;
#pragma unroll
            for (int j = 0; j < 4; ++j) ss += (v[j].x * v[j].x + v[j].y * v[j].y) + (v[j].z * v[j].z + v[j].w * v[j].w);
            const float rs = frsq(wave_sum(ss) * (1.f / DM) + RMS_EPS);
#pragma unroll
            for (int j = 0; j < 4; ++j) { const int col = 4 * lane + 256 * j;
                const f32x4 u = v[j] * rs * g[j] * sc[j] + sh[j];
                v2u o; o.x = pk2(u.x, u.y); o.y = pk2(u.z, u.w); *(v2u*)(U + (size_t)m * DM + col) = o; }
        }
    }
}

namespace pg8 {
struct EpiProj {
    static constexpr bool PERM = true, AFTER_DRAIN = false;
    bf16_t* QA; bf16_t* PROJ; int noepi;
    __device__ __forceinline__ void operator()(const f32x4 (&acc)[2][2][4][2], const Unit& u, int wr, int wc, int fr, int fq) const {
        if (noepi) return;
        const int row0 = u.pm * BM + wr * 64 + fr;
#pragma unroll
        for (int bj = 0; bj < 2; ++bj) {
            const int blk = u.pn * 2 + bj; if (blk == 3) continue;
            bf16_t* base; int ld, c0; if (blk < 3) { base = QA; ld = QL; c0 = blk * 128; } else { base = PROJ; ld = PW; c0 = blk * 128 - 512; }
            const int col = c0 + wc * 32 + 8 * fq;
#pragma unroll
            for (int ai = 0; ai < 2; ++ai)
#pragma unroll
                for (int m = 0; m < 4; ++m) { f32x4 v0 = acc[ai][bj][m][0], v1 = acc[ai][bj][m][1];
                    if (blk >= 28) {
#pragma unroll
                        for (int e = 0; e < 4; ++e) { v0[e] = sigm(v0[e]); v1[e] = sigm(v1[e]); } }
                    u32x4 w; w.x = cvt_pk_bf16(v0[0], v0[1]); w.y = cvt_pk_bf16(v0[2], v0[3]); w.z = cvt_pk_bf16(v1[0], v1[1]); w.w = cvt_pk_bf16(v1[2], v1[3]);
                    *(u32x4*)(base + (size_t)(row0 + ai * HALF + m * 16) * ld + col) = w; }
        }
    }
};
struct EpiQ {
    static constexpr bool PERM = true, AFTER_DRAIN = false;
    const float* RSQ; const float* ROPE; bf16_t* Q; float* QS;
    __device__ __forceinline__ void operator()(const f32x4 (&acc)[2][2][4][2], const Unit& u, int wr, int wc, int fr, int fq) const {
        const int row0 = u.pm * BM + wr * 64 + fr;
#pragma unroll
        for (int aim = 0; aim < 4; ++aim) { const int ai = aim >> 1, mb = (aim & 1) * 2;
        float rsv[4]; f32x4 csa[4][2], csb[4][2];
#pragma unroll
            for (int m = mb; m < mb + 2; ++m) { const int row = row0 + ai * HALF + m * 16; rsv[m] = RSQ[row]; const int pidx = row >= MP ? SEQ + ((row - MP) & 7) : (row & 2047);
#pragma unroll
                for (int bj = 0; bj < 2; ++bj) { const int col = u.pn * BM + bj * HALF + wc * 32 + 8 * fq; const int h = col / 96, j = col - h * 96;
                    const int i0 = j < 64 ? 0 : (j - 64) >> 1; const float* rp = ROPE + ((size_t)pidx * 16 + i0) * 2; csa[m][bj] = *(const f32x4*)rp; csb[m][bj] = *(const f32x4*)(rp + 4); } }
#pragma unroll
            for (int m = mb; m < mb + 2; ++m) {
                const int row = row0 + ai * HALF + m * 16; const float rs = rsv[m];
                const bool samp = row >= MP;
#pragma unroll
                for (int bj = 0; bj < 2; ++bj) {
                    const int col = u.pn * BM + bj * HALF + wc * 32 + 8 * fq; const int h = col / 96, j = col - h * 96;
                    float v[8];
#pragma unroll
                    for (int e = 0; e < 4; ++e) { v[e] = acc[ai][bj][m][0][e] * rs; v[4 + e] = acc[ai][bj][m][1][e] * rs; }
                    if (j < 64) {
                        if (!samp) { u32x4 w; w.x = cvt_pk_bf16(v[0] * SC2, v[1] * SC2); w.y = cvt_pk_bf16(v[2] * SC2, v[3] * SC2); w.z = cvt_pk_bf16(v[4] * SC2, v[5] * SC2); w.w = cvt_pk_bf16(v[6] * SC2, v[7] * SC2);
                            *(u32x4*)(Q + (size_t)row * 768 + col) = w; }
                        else { float* d = QS + (size_t)(row - MP) * 768 + col; *(f32x4*)d = (f32x4){v[0], v[1], v[2], v[3]}; *(f32x4*)(d + 4) = (f32x4){v[4], v[5], v[6], v[7]}; }
                    } else {
                        const int i0 = (j - 64) >> 1;
                        const f32x4 cs0 = csa[m][bj], cs1 = csb[m][bj];
                        float o1[4], o2[4];
                        o1[0] = v[0] * cs0.x - v[1] * cs0.y; o2[0] = v[1] * cs0.x + v[0] * cs0.y;
                        o1[1] = v[2] * cs0.z - v[3] * cs0.w; o2[1] = v[3] * cs0.z + v[2] * cs0.w;
                        o1[2] = v[4] * cs1.x - v[5] * cs1.y; o2[2] = v[5] * cs1.x + v[4] * cs1.y;
                        o1[3] = v[6] * cs1.z - v[7] * cs1.w; o2[3] = v[7] * cs1.z + v[6] * cs1.w;
                        const int cb = h * 96 + 64 + i0;
                        if (!samp) { unsigned* d = (unsigned*)(Q + (size_t)row * 768 + cb);
                            d[0] = cvt_pk_bf16(o1[0] * SC2, o1[1] * SC2); d[1] = cvt_pk_bf16(o1[2] * SC2, o1[3] * SC2);
                            d[8] = cvt_pk_bf16(o2[0] * SC2, o2[1] * SC2); d[9] = cvt_pk_bf16(o2[2] * SC2, o2[3] * SC2); }
                        else { float* d = QS + (size_t)(row - MP) * 768 + cb; *(f32x4*)d = (f32x4){o1[0], o1[1], o1[2], o1[3]}; *(f32x4*)(d + 16) = (f32x4){o2[0], o2[1], o2[2], o2[3]}; }
                    }
                }
            }
        }
    }
};
struct EpiKV {
    static constexpr bool PERM = true, AFTER_DRAIN = false;
    bf16_t* KN; bf16_t* V;
    __device__ __forceinline__ void operator()(const f32x4 (&acc)[2][2][4][2], const Unit& u, int wr, int wc, int fr, int fq) const {
        const int row0 = u.pm * BM + wr * 64 + fr; bf16_t* base = (u.pn < 2) ? KN : V; const int colt = (u.pn & 1) * BM + wc * 32 + 8 * fq;
#pragma unroll
        for (int ai = 0; ai < 2; ++ai)
#pragma unroll
            for (int m = 0; m < 4; ++m)
#pragma unroll
                for (int bj = 0; bj < 2; ++bj) { const f32x4 v0 = acc[ai][bj][m][0], v1 = acc[ai][bj][m][1];
                    u32x4 w; w.x = cvt_pk_bf16(v0[0], v0[1]); w.y = cvt_pk_bf16(v0[2], v0[3]); w.z = cvt_pk_bf16(v1[0], v1[1]); w.w = cvt_pk_bf16(v1[2], v1[3]);
                    *(u32x4*)(base + (size_t)(row0 + ai * HALF + m * 16) * 512 + colt + bj * HALF) = w; }
    }
};
struct MergeOrder : StaticOrder {
    __device__ __forceinline__ bool next(int i, Unit& u) const { Unit t; if (!StaticOrder::next(i >> 2, t)) return false; const int sub = i & 3; u.pm = sub * 65 + t.pm; u.pn = sub * 4 + t.pn; return true; }
    __device__ __forceinline__ bool keep(const Unit& u) const { return u.pn < 4; }
};
struct EpiMerge {
    static constexpr bool PERM = true, AFTER_DRAIN = false;
    const bf16_t* PROJ; bf16_t* MG; bf16_t* MERGED; int noepi;
    __device__ __forceinline__ void operator()(const f32x4 (&acc)[2][2][4][2], const Unit& u, int wr, int wc, int fr, int fq) const {
        const int sub = u.pn >> 2; if (sub == 0 || noepi) return;
        const int pm = u.pm - sub * 65, pn = u.pn & 3, br = sub - 1;
        const int row0 = pm * BM + wr * 64 + fr, col0 = pn * BM + wc * 32 + 8 * fq;
#pragma unroll
        for (int ai = 0; ai < 2; ++ai) {
            u32x4 gw[4][2], pw[4][2];
#pragma unroll
            for (int m = 0; m < 4; ++m)
#pragma unroll
                for (int bj = 0; bj < 2; ++bj) { const size_t row = row0 + ai * HALF + m * 16; const int col = col0 + bj * HALF;
                    gw[m][bj] = *(const u32x4*)(PROJ + row * PW + C_GM + br * DM + col);
                    if (br > 0) pw[m][bj] = *(const u32x4*)(MG + row * DM + col); }
#pragma unroll
            for (int m = 0; m < 4; ++m)
#pragma unroll
                for (int bj = 0; bj < 2; ++bj) { const size_t row = row0 + ai * HALF + m * 16; const int col = col0 + bj * HALF;
                    const u32x4 g = gw[m][bj];
                    f32x4 v0 = acc[ai][bj][m][0] * (f32x4){bflo(g.x), bfhi(g.x), bflo(g.y), bfhi(g.y)}, v1 = acc[ai][bj][m][1] * (f32x4){bflo(g.z), bfhi(g.z), bflo(g.w), bfhi(g.w)};
                    if (br > 0) { const u32x4 q = pw[m][bj]; v0 = v0 + (f32x4){bflo(q.x), bfhi(q.x), bflo(q.y), bfhi(q.y)}; v1 = v1 + (f32x4){bflo(q.z), bfhi(q.z), bflo(q.w), bfhi(q.w)}; }
                    u32x4 w; w.x = cvt_pk_bf16(v0[0], v0[1]); w.y = cvt_pk_bf16(v0[2], v0[3]); w.z = cvt_pk_bf16(v1[0], v1[1]); w.w = cvt_pk_bf16(v1[2], v1[3]);
                    *(u32x4*)((br < 2 ? MG : MERGED) + row * DM + col) = w; }
        }
    }
};
template <bool XBF> struct EpiOut {
    static constexpr bool PERM = false, AFTER_DRAIN = false;
    const float* XPf; const bf16_t* XPb; bf16_t* XO; const float* MODG; const float* BADG;
    __device__ __forceinline__ void operator()(const f32x4 (&acc)[2][2][4][2], const Unit& u, int wr, int wc, int fr, int fq) const {
        const int row0 = u.pm * BM + wr * 64 + fr, col0 = u.pn * BM + wc * 32 + 4 * fq;
        const int cb = (u.pm * BM) >> 11; const float* gr = MODG + (size_t)cb * 3072;
        f32x4 gt[2][2];
#pragma unroll
        for (int bj = 0; bj < 2; ++bj)
#pragma unroll
            for (int n = 0; n < 2; ++n) { const int col = col0 + bj * HALF + n * 16; gt[bj][n] = *(const f32x4*)(gr + col) + *(const f32x4*)(BADG + col); }
#pragma unroll
        for (int aim = 0; aim < 4; ++aim) { const int ai = aim >> 1, mb = (aim & 1) * 2;
            f32x4 xv[4][2][2];
            if constexpr (!XBF) {
#pragma unroll
                for (int m = mb; m < mb + 2; ++m)
#pragma unroll
                    for (int bj = 0; bj < 2; ++bj)
#pragma unroll
                        for (int n = 0; n < 2; ++n) xv[m][bj][n] = *(const f32x4*)(XPf + (size_t)(row0 + ai * HALF + m * 16) * DM + col0 + bj * HALF + n * 16);
            } else {
#pragma unroll
                for (int m = mb; m < mb + 2; ++m)
#pragma unroll
                    for (int bj = 0; bj < 2; ++bj)
#pragma unroll
                        for (int n = 0; n < 2; ++n) { const unsigned long long q = *(const unsigned long long*)(XPb + (size_t)(row0 + ai * HALF + m * 16) * DM + col0 + bj * HALF + n * 16); const unsigned lo = (unsigned)q, hi = (unsigned)(q >> 32);
                            xv[m][bj][n] = (f32x4){__builtin_bit_cast(float, lo << 16), __builtin_bit_cast(float, lo & 0xffff0000u), __builtin_bit_cast(float, hi << 16), __builtin_bit_cast(float, hi & 0xffff0000u)}; }
            }
#pragma unroll
            for (int m = mb; m < mb + 2; ++m)
#pragma unroll
                for (int bj = 0; bj < 2; ++bj)
#pragma unroll
                    for (int n = 0; n < 2; ++n) { const f32x4 o = xv[m][bj][n] + gt[bj][n] * acc[ai][bj][m][n];
                        unsigned long long w = (unsigned long long)cvt_pk_bf16(o[0], o[1]) | ((unsigned long long)cvt_pk_bf16(o[2], o[3]) << 32);
                        *(unsigned long long*)(XO + (size_t)(row0 + ai * HALF + m * 16) * DM + col0 + bj * HALF + n * 16) = w; }
        }
    }
};
}

__device__ __forceinline__ float out_dummy() { return 0.f; }
__device__ __forceinline__ void phase_post(const Args& a, int l, LAS unsigned char* lds, int tid, int lane, int wave) {
    GAS unsigned char* wsg_ = (GAS unsigned char*)a.ws; asm volatile("" : "+s"(wsg_)); unsigned char* ws = (unsigned char*)wsg_;     float* out = a.out;
    const bf16* PROJ = (const bf16*)(ws + WS_PROJ); const bf16* QA = (const bf16*)(ws + WS_QA);
    float* RSQ = (float*)(ws + WS_RSQ); const float* ROPE = (const float*)(ws + WS_ROPE);
    bf16* CKV = (bf16*)(ws + WS_CKV); bf16* KPE = (bf16*)(ws + WS_KPE); bf16* ACONV = (bf16*)(ws + WS_A4) + 2 * A4_STRIDE;
    float* SC = (float*)(ws + WS_SC); float* BONUS = (float*)(ws + WS_BONUS);
    const int c4 = 4 * lane;
    const f32x4 gkv = *(const f32x4*)(INF(I_KVNG) + l * KVL + c4);
    const f32x4 cw0 = *(const f32x4*)(INF(I_CONVW) + (l * 3 + 0) * DC + c4), cw1 = *(const f32x4*)(INF(I_CONVW) + (l * 3 + 1) * DC + c4), cw2 = *(const f32x4*)(INF(I_CONVW) + (l * 3 + 2) * DC + c4);
    const float* mu = INF(I_MU) + l * SW;
    const f32x4 mu_r = *(const f32x4*)(mu + c4), mu_k = *(const f32x4*)(mu + 256 + c4), mu_v = *(const f32x4*)(mu + 512 + c4);
    const float mu_w = mu[768 + lane], mu_a = mu[832 + lane];
    const f32x4 w0v = *(const f32x4*)(INF(I_W0) + l * DR + c4), a0v = *(const f32x4*)(INF(I_A0) + l * DR + c4), kkv = *(const f32x4*)(INF(I_KK) + l * DR + c4),
                kav = *(const f32x4*)(INF(I_KA) + l * DR + c4), rkv = *(const f32x4*)(INF(I_RK) + l * DR + c4);
    constexpr int XS = 144, XB_OFF = 80 * XS, RL_OFF = 2 * 80 * XS, RL_MAT = 65 * 512;
    const unsigned char* wl = ws + WS_W + (size_t)l * LW_STRIDE;
    for (int bk = blockIdx.x; bk < MT / 65; bk += gridDim.x) {
    const int m0 = bk * 65;
    for (int r = wave; r < 80; r += NWAVES) {
        float tw = 0.f, ai = 0.f;
        if (r < 65) { const int m = m0 + r; int b, t, T, cb, pidx; row_info(m, b, t, T, cb, pidx); const bool samp = m >= MP;
            const bf16* R = PROJ + (size_t)m * PW + C_RW; const float* sprev = INF(I_SSHIFT) + (size_t)(l * NB_S + b) * SW;
            const float cwi = bf1(R[768 + lane]), cai = bf1(R[832 + lane]); float pwi = 0.f, pai = 0.f;
            if (t >= 1) { pwi = bf1(R[768 + lane - PW]); pai = bf1(R[832 + lane - PW]); } else if (samp) { pwi = sprev[768 + lane]; pai = sprev[832 + lane]; }
            const float wi = cwi + mu_w * (pwi - cwi); ai = cai + mu_a * (pai - cai); tw = 1.0f - 2.0f * frcp(fexp(2.0f * wi) + 1.0f); }
        *(LAS bf16*)(lds + r * XS + lane * 2) = (bf16)f2bf(tw); *(LAS bf16*)(lds + XB_OFF + r * XS + lane * 2) = (bf16)f2bf(ai);
    }
    __syncthreads();
    { const int fr = lane & 15, fq = lane >> 4;
      bf16x8 wf[2][2][2];
#pragma unroll
      for (int lo = 0; lo < 2; ++lo)
#pragma unroll
          for (int q = 0; q < 2; ++q)
#pragma unroll
              for (int ks = 0; ks < 2; ++ks) wf[lo][q][ks] = *(const bf16x8*)((const bf16*)(wl + (lo ? LW_A2T : LW_W2T)) + (size_t)(16 * (2 * wave + q) + fr) * WL + 32 * ks + 8 * fq);
      for (int rt = 0; rt < 5; ++rt) {
          pg8::f32x4 acc[2][2];
#pragma unroll
          for (int lo = 0; lo < 2; ++lo)
#pragma unroll
              for (int q = 0; q < 2; ++q) acc[lo][q] = (pg8::f32x4){0.f, 0.f, 0.f, 0.f};
#pragma unroll
          for (int ks = 0; ks < 2; ++ks) {
              const bf16x8 xa = *(const LAS bf16x8*)(lds + (16 * rt + fr) * XS + (32 * ks + 8 * fq) * 2), xb = *(const LAS bf16x8*)(lds + XB_OFF + (16 * rt + fr) * XS + (32 * ks + 8 * fq) * 2);
#pragma unroll
              for (int q = 0; q < 2; ++q) { acc[0][q] = __builtin_amdgcn_mfma_f32_16x16x32_bf16(wf[0][q][ks], xa, acc[0][q], 0, 0, 0); acc[1][q] = __builtin_amdgcn_mfma_f32_16x16x32_bf16(wf[1][q][ks], xb, acc[1][q], 0, 0, 0); } }
          const int row = 16 * rt + fr;
          if (row < 65) {
#pragma unroll
              for (int lo = 0; lo < 2; ++lo)
#pragma unroll
                  for (int q = 0; q < 2; ++q) { v2u o; o.x = pk2(acc[lo][q][0], acc[lo][q][1]); o.y = pk2(acc[lo][q][2], acc[lo][q][3]);
                      *(LAS v2u*)(lds + RL_OFF + lo * RL_MAT + row * 512 + (16 * (2 * wave + q) + 4 * fq) * 2) = o; } }
      } }
    __syncthreads();
    struct PostRaw { unsigned qa[3]; v2u kv, cc0, cx0, cc1, cx1, cc2, cx2, cb, zc, r0, k0, v0, r1, k1, v1; float kr1, kr2, cwi, cai, cs, sn; };
    auto load_row = [&](int rowi, PostRaw& w) {
        const int m = m0 + rowi; int b, t, T, cb_, pidx; row_info(m, b, t, T, cb_, pidx);
        const bf16* P = PROJ + (size_t)m * PW; const unsigned* q = (const unsigned*)(QA + (size_t)m * QL);
#pragma unroll
        for (int i = 0; i < 3; ++i) w.qa[i] = q[lane + 64 * i];
        w.kv = *(const v2u*)(P + C_KV + c4);
        w.kr1 = bf1(P[C_KR + (lane & 15)]); w.kr2 = bf1(P[C_KR + 16 + (lane & 15)]); w.cs = ROPE[((size_t)pidx * 16 + (lane & 15)) * 2]; w.sn = ROPE[((size_t)pidx * 16 + (lane & 15)) * 2 + 1];
        w.cc0 = *(const v2u*)(P + C_CC + c4); w.cx0 = *(const v2u*)(P + C_CX + c4); w.cb = *(const v2u*)(P + C_CB + c4); w.zc = *(const v2u*)(P + C_ZC + c4);
        const v2u z2 = {0u, 0u};
        w.cc1 = z2; w.cx1 = z2; w.cc2 = z2; w.cx2 = z2; w.r1 = z2; w.k1 = z2; w.v1 = z2;
        if (t >= 1) { w.cc1 = *(const v2u*)(P - PW + C_CC + c4); w.cx1 = *(const v2u*)(P - PW + C_CX + c4);
            w.r1 = *(const v2u*)(P - PW + C_RW + c4); w.k1 = *(const v2u*)(P - PW + C_RW + 256 + c4); w.v1 = *(const v2u*)(P - PW + C_RW + 512 + c4); }
        if (t >= 2) { w.cc2 = *(const v2u*)(P - 2 * PW + C_CC + c4); w.cx2 = *(const v2u*)(P - 2 * PW + C_CX + c4); }
        w.r0 = *(const v2u*)(P + C_RW + c4); w.k0 = *(const v2u*)(P + C_RW + 256 + c4); w.v0 = *(const v2u*)(P + C_RW + 512 + c4);
        w.cwi = bf1(P[C_RW + 768 + lane]); w.cai = bf1(P[C_RW + 832 + lane]);
    };
#define UNPK(w_) ((f32x4){bflo((w_).x), bfhi((w_).x), bflo((w_).y), bfhi((w_).y)})
    PostRaw nxt; load_row(wave, nxt);
    for (int rowi = wave; rowi < 65; rowi += NWAVES) {
        const PostRaw w = nxt;
        if (rowi + NWAVES < 65) load_row(rowi + NWAVES, nxt);
        const int m = m0 + rowi;
        int b, t, T, cb, pidx; row_info(m, b, t, T, cb, pidx); const bool samp = m >= MP;
        { float ss = 0.f;
#pragma unroll
          for (int i = 0; i < 3; ++i) { const float x = bflo(w.qa[i]), y = bfhi(w.qa[i]); ss += x * x + y * y; }
          ss = wave_sum(ss); if (lane == 0) RSQ[m] = frsq(ss * (1.f / QL) + RMS_EPS); }
        { f32x4 x = UNPK(w.kv);
          const float ss = wave_sum((x.x * x.x + x.y * x.y) + (x.z * x.z + x.w * x.w)); const float rs = frsq(ss * (1.f / KVL) + RMS_EPS);
          x = x * rs * gkv;
          float* o = samp ? out + O_CKVS + ((size_t)l * MS + (m - MP)) * KVL : out + O_CKVP + ((size_t)l * MP + m) * KVL;
          *(f32x4*)(o + c4) = x; v2u ob; ob.x = pk2(x.x, x.y); ob.y = pk2(x.z, x.w); *(v2u*)(CKV + (size_t)m * KVL + c4) = ob; }
        if (lane < 16) { const float o1 = w.kr1 * w.cs - w.kr2 * w.sn, o2 = w.kr2 * w.cs + w.kr1 * w.sn;
          float* o = samp ? out + O_KPES + ((size_t)l * MS + (m - MP)) * QKR : out + O_KPEP + ((size_t)l * MP + m) * QKR;
          o[lane] = o1; o[16 + lane] = o2; KPE[(size_t)m * QKR + lane] = (bf16)f2bf(o1); KPE[(size_t)m * QKR + 16 + lane] = (bf16)f2bf(o2); }
        { const f32x4 p0 = UNPK(w.cc0) * UNPK(w.cx0);
          f32x4 p1 = UNPK(w.cc1) * UNPK(w.cx1), p2 = UNPK(w.cc2) * UNPK(w.cx2);
          if (samp && t < 2) { const float* sconv = INF(I_SCONV) + ((size_t)(l * NB_S + b) * 2) * DC + c4;
              if (t == 0) { p1 = *(const f32x4*)(sconv + DC); p2 = *(const f32x4*)(sconv); } else p2 = *(const f32x4*)(sconv + DC); }
          const f32x4 cv = p2 * cw0 + p1 * cw1 + p0 * cw2;
          const v2u wz = w.zc;
          const f32x4 o = (f32x4){silu(bflo(wz.x)), silu(bfhi(wz.x)), silu(bflo(wz.y)), silu(bfhi(wz.y))} * UNPK(w.cb) * cv;
          v2u ob; ob.x = pk2(o.x, o.y); ob.y = pk2(o.z, o.w); *(v2u*)(ACONV + (size_t)m * DC + c4) = ob;
          if (t >= T - 2) { float* so = samp ? out + O_CONVS + (((size_t)l * NB_S + b) * 2 + (t - (T - 2))) * DC : out + O_CONVP + (((size_t)l * NB_P + b) * 2 + (t - (T - 2))) * DC;
              *(f32x4*)(so + c4) = p0; } }
        { const f32x4 cr = UNPK(w.r0), ck = UNPK(w.k0), cv_ = UNPK(w.v0); const float cwi = w.cwi, cai = w.cai;
          f32x4 pr = UNPK(w.r1), pk = UNPK(w.k1), pv = UNPK(w.v1);
          if (samp && t == 0) { const float* sprev = INF(I_SSHIFT) + (size_t)(l * NB_S + b) * SW; pr = *(const f32x4*)(sprev + c4); pk = *(const f32x4*)(sprev + 256 + c4); pv = *(const f32x4*)(sprev + 512 + c4); }
          if (t == T - 1) { float* so = samp ? out + O_SHS + ((size_t)l * NB_S + b) * SW : out + O_SHP + ((size_t)l * NB_P + b) * SW;
              *(f32x4*)(so + c4) = cr; *(f32x4*)(so + 256 + c4) = ck; *(f32x4*)(so + 512 + c4) = cv_; so[768 + lane] = cwi; so[832 + lane] = cai; }
          const f32x4 r = cr + mu_r * (pr - cr), k = ck + mu_k * (pk - ck), v = cv_ + mu_v * (pv - cv_);
          f32x4 accw = w0v, acca = a0v;
          { const v2u lw = *(const LAS v2u*)(lds + RL_OFF + rowi * 512 + c4 * 2), la = *(const LAS v2u*)(lds + RL_OFF + RL_MAT + rowi * 512 + c4 * 2);
            accw += UNPK(lw); acca += UNPK(la); }
          f32x4 dec, av;
#pragma unroll
          for (int e = 0; e < 4; ++e) { const float x = -accw[e];
              const float sp = fmaxf(x, 0.f) + __logf(1.0f + fexp(-fabsf(x))); const float wlog = -sp - 0.5f; dec[e] = fexp(-fexp(wlog)); av[e] = sigm(acca[e]); }
          f32x4 kk = k * kkv; const float ssq = grp16_sum((kk.x * kk.x + kk.y * kk.y) + (kk.z * kk.z + kk.w * kk.w)); kk = kk * frcp(fmaxf(sqrtf(ssq), 1e-12f));
          const f32x4 k2 = k * ((av - 1.0f) * kav + 1.0f);
          const f32x4 rkk = r * k2 * rkv; const float bon = grp16_sum((rkk.x + rkk.y) + (rkk.z + rkk.w));
          float* sc = SC + (size_t)m * 6 * DR + c4;
          *(f32x4*)(sc) = r; *(f32x4*)(sc + DR) = dec; *(f32x4*)(sc + 2 * DR) = k2; *(f32x4*)(sc + 3 * DR) = v; *(f32x4*)(sc + 4 * DR) = kk; *(f32x4*)(sc + 5 * DR) = kk * av;
          *(f32x4*)(BONUS + (size_t)m * DR + c4) = v * bon; }
    }
#undef UNPK
    __syncthreads();
    }
}

__device__ __forceinline__ void phase_qlat(const Args& a, int l, int lane, int wave) {
    GAS unsigned char* wsg_ = (GAS unsigned char*)a.ws; asm volatile("" : "+s"(wsg_)); unsigned char* ws = (unsigned char*)wsg_;
    const int gw = blockIdx.x * NWAVES + wave, NGW = gridDim.x * NWAVES;
    const float* QS = (const float*)(ws + WS_QS); bf16* QLT = (bf16*)(ws + WS_QLAT); const float* wuk = INF(I_WUK) + (size_t)l * KVL * 512;
    for (int task = gw; task < MS * NH; task += NGW) {
        const int mm = task >> 3, h = task & 7, b = mm >> 3, t = mm & 7, r = t * 8 + h;
        const float* q = QS + (size_t)mm * 768 + h * 96;
        const float qn = q[lane];
        bf16* dst = QLT + ((size_t)b * 64 + r) * 288;
#pragma unroll
        for (int ci = 0; ci < 4; ++ci) { const int c = lane + 64 * ci; const f32x4* wr = (const f32x4*)(wuk + ((size_t)c * NH + h) * 64); float acc = 0.f;
#pragma unroll
            for (int n4 = 0; n4 < 16; ++n4) { const f32x4 w = wr[n4]; acc += w.x * RDL(qn, 4 * n4) + w.y * RDL(qn, 4 * n4 + 1) + w.z * RDL(qn, 4 * n4 + 2) + w.w * RDL(qn, 4 * n4 + 3); }
            dst[c] = (bf16)f2bf(acc * SC2); }
        if (lane < 32) dst[256 + lane] = (bf16)f2bf(q[64 + lane] * SC2);
    }
}

__device__ __forceinline__ void glds16(const void* gsrc, unsigned lds_dst) { unsigned keep;
    asm volatile("s_mov_b32 %0, m0\n\ts_mov_b32 m0, %2\n\ts_nop 0\n\tglobal_load_lds_dwordx4 %1, off\n\ts_mov_b32 m0, %0" : "=&s"(keep) : "v"(gsrc), "s"(lds_dst) : "memory"); }
#define MFMA32(a_, b_, c_) __builtin_amdgcn_mfma_f32_32x32x16_bf16((a_), (b_), (c_), 0, 0, 0)
__device__ __forceinline__ bf16x8 pack8(const f32x16& x, int s) {
    v4u p; p.x = pk2(x[8 * s], x[8 * s + 1]); p.y = pk2(x[8 * s + 2], x[8 * s + 3]); p.z = pk2(x[8 * s + 4], x[8 * s + 5]); p.w = pk2(x[8 * s + 6], x[8 * s + 7]);
    return __builtin_bit_cast(bf16x8, p);
}
__device__ __forceinline__ bf16x8 vt_frag(const LAS unsigned char* p0, int rowstride8) {
    const s16x4 lo = __builtin_bit_cast(s16x4, __builtin_amdgcn_ds_read_tr16_b64_v4i16((LAS v4i16_t*)p0));
    const s16x4 hi = __builtin_bit_cast(s16x4, __builtin_amdgcn_ds_read_tr16_b64_v4i16((LAS v4i16_t*)(p0 + rowstride8)));
    bf16x8 r; r[0] = lo[0]; r[1] = lo[1]; r[2] = lo[2]; r[3] = lo[3]; r[4] = hi[0]; r[5] = hi[1]; r[6] = hi[2]; r[7] = hi[3]; return r;
}

constexpr int PA_KS = 208, PA_VS = 144;
constexpr int PA_KBYTES = 64 * PA_KS, PA_VBYTES = 64 * PA_VS, PA_BUF = PA_KBYTES + PA_VBYTES;
__device__ __forceinline__ void phase_attn_prompt(const Args& a, LAS unsigned char* lds, int tid, int lane, int wave, unsigned* qctr, volatile LAS unsigned* qslot) {
    GAS unsigned char* wsg_ = (GAS unsigned char*)a.ws; asm volatile("" : "+s"(wsg_)); unsigned char* ws = (unsigned char*)wsg_;
    const bf16* Q = (const bf16*)(ws + WS_Q); const bf16* KN = (const bf16*)(ws + WS_KN); const bf16* KPE = (const bf16*)(ws + WS_KPE); const bf16* V = (const bf16*)(ws + WS_V);
    const bf16* PROJ = (const bf16*)(ws + WS_PROJ); bf16* AMLA = (bf16*)(ws + WS_A4);
    const int r32 = lane & 31, h2 = lane >> 5;
    for (;;) {
        {
            if (tid == 0) *qslot = __hip_atomic_fetch_add(qctr, 1u, __ATOMIC_RELAXED, __HIP_MEMORY_SCOPE_AGENT);
            __syncthreads();
            const int u = (int)*qslot;
            __syncthreads();
            if (u >= 512) break;
            const int qb = 7 - (u >> 6), bh = u & 63, b = bh >> 3, h = bh & 7;
            const int q0w = qb * 256 + wave * 32;
            const size_t tok0 = (size_t)b * SEQ;
            bf16x8 Bq[6];
#pragma unroll
            for (int ks = 0; ks < 6; ++ks) Bq[ks] = *(const bf16x8*)(Q + (tok0 + q0w + r32) * 768 + h * 96 + 16 * ks + 8 * h2);
            f32x16 O0, O1;
#pragma unroll
            for (int i = 0; i < 16; ++i) { O0[i] = 0.f; O1[i] = 0.f; }
            float mrun = -INFINITY, lrun = 0.f;
            const int ntile = 4 * qb + 4;
            const int krow = tid >> 3, kch = tid & 7, prow = (tid & 255) >> 2, pch = tid & 3;
            v4u gkA, gpA, gvA, gkB, gpB, gvB;
            auto issue = [&](int kt, v4u& gk, v4u& gp, v4u& gv) { const size_t tk = tok0 + (size_t)kt * 64 + krow;
                gk = *(const v4u*)(KN + tk * 512 + h * 64 + kch * 8); gv = *(const v4u*)(V + tk * 512 + h * 64 + kch * 8); gp = *(const v4u*)(KPE + (tok0 + (size_t)kt * 64 + prow) * QKR + pch * 8); };
            auto stash = [&](int bufi, const v4u& gk, const v4u& gp, const v4u& gv) { LAS unsigned char* kn = lds + bufi * PA_BUF; LAS unsigned char* vn = kn + PA_KBYTES;
                *(LAS v4u*)(kn + krow * PA_KS + kch * 16) = gk; *(LAS v4u*)(vn + krow * PA_VS + kch * 16) = gv; if (tid < 256) *(LAS v4u*)(kn + prow * PA_KS + 128 + pch * 16) = gp; };
#define PA_BAR() do { LDS_WAIT(); __builtin_amdgcn_s_barrier(); asm volatile("" ::: "memory"); } while (0)
            auto compute = [&](int kt, int bufi) {
                const LAS unsigned char* kb = lds + bufi * PA_BUF; const LAS unsigned char* vb = kb + PA_KBYTES;
                if (kt * 64 <= q0w + 31) {
                    const float coff = (mrun == -INFINITY) ? 0.f : mrun;
                    f32x16 S0, S1;
#pragma unroll
                    for (int i = 0; i < 16; ++i) { S0[i] = -coff; S1[i] = -coff; }
#pragma unroll
                    for (int kh = 0; kh < 2; ++kh) {
                        bf16x8 kf0[3], kf1[3];
#pragma unroll
                        for (int k3 = 0; k3 < 3; ++k3) { const int ks = 3 * kh + k3;
                            kf0[k3] = *(const LAS bf16x8*)(kb + r32 * PA_KS + ks * 32 + h2 * 16); kf1[k3] = *(const LAS bf16x8*)(kb + (32 + r32) * PA_KS + ks * 32 + h2 * 16); }
                        asm volatile("" : "+v"(kf0[0]), "+v"(kf0[1]), "+v"(kf0[2]), "+v"(kf1[0]), "+v"(kf1[1]), "+v"(kf1[2]));
#pragma unroll
                        for (int k3 = 0; k3 < 3; ++k3) { S0 = MFMA32(kf0[k3], Bq[3 * kh + k3], S0); S1 = MFMA32(kf1[k3], Bq[3 * kh + k3], S1); }
                    }
                    if (kt * 64 + 63 > q0w) {
                        const int qq = q0w + r32, kbase = kt * 64 + 4 * h2;
#pragma unroll
                        for (int i = 0; i < 16; ++i) { const int key = kbase + (i & 3) + 8 * (i >> 2); if (key > qq) S0[i] = -INFINITY; if (key + 32 > qq) S1[i] = -INFINITY; }
                    }
                    float mx = S0[0];
#pragma unroll
                    for (int i = 1; i < 16; ++i) mx = fmaxf(mx, S0[i]);
#pragma unroll
                    for (int i = 0; i < 16; ++i) mx = fmaxf(mx, S1[i]);
                    mx = fmaxf(mx, SHX(mx, 32));
                    const float mnew = fmaxf(mrun, coff + mx);
                    if (__builtin_amdgcn_ballot_w64(mnew > mrun)) {
                        const float alpha = __builtin_amdgcn_exp2f(mrun - mnew), delta = mnew - coff; mrun = mnew; lrun *= alpha;
#pragma unroll
                        for (int i = 0; i < 16; ++i) { O0[i] *= alpha; O1[i] *= alpha; S0[i] -= delta; S1[i] -= delta; }
                    }
                    float ps = 0.f;
#pragma unroll
                    for (int i = 0; i < 16; ++i) { S0[i] = __builtin_amdgcn_exp2f(S0[i]); S1[i] = __builtin_amdgcn_exp2f(S1[i]); ps += S0[i] + S1[i]; }
                    lrun += ps;
                    const int g = lane >> 4, li = lane & 15, cg = g & 1, tq = li >> 2, tp = li & 3;
                    const LAS unsigned char* vbase = vb + (4 * h2 + tq) * PA_VS + (16 * cg + 4 * tp) * 2;
#pragma unroll
                    for (int sub = 0; sub < 2; ++sub)
                    {   const LAS unsigned char* vp0 = vbase + (32 * sub) * PA_VS; const LAS unsigned char* vp1 = vp0 + 16 * PA_VS;
                        bf16x8 va = vt_frag(vp0, 8 * PA_VS), vb_ = vt_frag(vp0 + 64, 8 * PA_VS), vc = vt_frag(vp1, 8 * PA_VS), vd = vt_frag(vp1 + 64, 8 * PA_VS);
                        const bf16x8 pb0 = pack8(sub == 0 ? S0 : S1, 0), pb1 = pack8(sub == 0 ? S0 : S1, 1);
                        asm volatile("" : "+v"(va), "+v"(vb_), "+v"(vc), "+v"(vd));
                        O0 = MFMA32(va, pb0, O0); O1 = MFMA32(vb_, pb0, O1); O0 = MFMA32(vc, pb1, O0); O1 = MFMA32(vd, pb1, O1);
                    }
                }
            };
            issue(0, gkA, gpA, gvA); issue(1, gkB, gpB, gvB); stash(0, gkA, gpA, gvA); PA_BAR();
            for (int kt = 0; kt < ntile - 2; kt += 2) {
                issue(kt + 2, gkA, gpA, gvA); compute(kt, 0); stash(1, gkB, gpB, gvB); PA_BAR();
                issue(kt + 3, gkB, gpB, gvB); compute(kt + 1, 1); stash(0, gkA, gpA, gvA); PA_BAR();
            }
            compute(ntile - 2, 0); stash(1, gkB, gpB, gvB); PA_BAR();
            compute(ntile - 1, 1);
            const float ltot = lrun + SHX(lrun, 32); const float inv = frcp(ltot);
            const size_t row = tok0 + q0w + r32;
            v2u zz[2][4];
#pragma unroll
            for (int dt = 0; dt < 2; ++dt)
#pragma unroll
                for (int g4 = 0; g4 < 4; ++g4) zz[dt][g4] = *(const v2u*)(PROJ + row * PW + C_ZM + h * 64 + dt * 32 + 8 * g4 + 4 * h2);
#pragma unroll
            for (int dt = 0; dt < 2; ++dt)
#pragma unroll
                for (int g4 = 0; g4 < 4; ++g4) { const int d0 = dt * 32 + 8 * g4 + 4 * h2;
                    const v2u zw = zz[dt][g4];
                    const f32x16& O = dt == 0 ? O0 : O1;
                    const float o0 = O[4 * g4] * inv * silu(bflo(zw.x)), o1 = O[4 * g4 + 1] * inv * silu(bfhi(zw.x)), o2 = O[4 * g4 + 2] * inv * silu(bflo(zw.y)), o3 = O[4 * g4 + 3] * inv * silu(bfhi(zw.y));
                    v2u ob; ob.x = pk2(o0, o1); ob.y = pk2(o2, o3); *(v2u*)(AMLA + (size_t)(h >> 2) * A4_STRIDE + row * 256 + (h & 3) * 64 + d0) = ob; }
        }
    }
}

constexpr int RA_SUB = 8, RA_STEP = 6 * 256, RA_BUF = RA_SUB * RA_STEP;
__device__ __forceinline__ float dpp_xor1(float x) { return __builtin_bit_cast(float, __builtin_amdgcn_update_dpp(0, __builtin_bit_cast(int, x), 0xB1, 0xF, 0xF, true)); }
__device__ __forceinline__ float dpp_xor2(float x) { return __builtin_bit_cast(float, __builtin_amdgcn_update_dpp(0, __builtin_bit_cast(int, x), 0x4E, 0xF, 0xF, true)); }

__device__ __forceinline__ void phase_rwkvA(const Args& a, LAS unsigned char* lds, int tid, int lane, int wave) {
    GAS unsigned char* wsg_ = (GAS unsigned char*)a.ws; asm volatile("" : "+s"(wsg_)); unsigned char* ws = (unsigned char*)wsg_;
    const float* SC = (const float*)(ws + WS_SC); float* YL = (float*)(ws + WS_YL); float* YP = (float*)(ws + WS_YP); float* QC = (float*)(ws + WS_QC); bf16* PC = (bf16*)(ws + WS_PC);
    const int pr = wave >> 1, part = wave & 1;
    const int ib = lane >> 2, jb = lane & 3;
    const int pt = part * 64 + lane;
    LAS unsigned char* mybuf = lds + pr * (2 * RA_BUF);
    for (int bk = blockIdx.x; bk < 8 * RNC; bk += gridDim.x) {
        const int seq = bk / (RNC / 4), c = (bk % (RNC / 4)) * 4 + pr, b = seq >> 2, h = seq & 3;
        const size_t m0 = (size_t)b * SEQ + (size_t)c * RCL;
        f32x2 S[4][8];
#pragma unroll
        for (int r = 0; r < 4; ++r)
#pragma unroll
            for (int pp = 0; pp < 8; ++pp) { S[r][pp].x = (part == 1 && (4 * ib + r) == (16 * jb + 2 * pp)) ? 1.f : 0.f; S[r][pp].y = (part == 1 && (4 * ib + r) == (16 * jb + 2 * pp + 1)) ? 1.f : 0.f; }
        f32x4 stg[6];
        auto stage_load = [&](int sub) {
#pragma unroll
            for (int i = 0; i < 6; ++i) { const int q = pt + 128 * i, st = q / 96, rem = q - st * 96, vec = rem >> 4, ch = rem & 15;
                const int srcv = vec == 0 ? 4 : vec == 1 ? 1 : vec == 2 ? 5 : vec == 3 ? 2 : vec == 4 ? 0 : 3;
                stg[i] = *(const f32x4*)(SC + (m0 + sub * RA_SUB + st) * 6 * DR + srcv * DR + h * 64 + ch * 4); }
        };
        auto stage_store = [&](int buf) {
#pragma unroll
            for (int i = 0; i < 6; ++i) { const int q = pt + 128 * i, st = q / 96, rem = q - st * 96;
                *(LAS f32x4*)(mybuf + buf * RA_BUF + st * RA_STEP + rem * 16) = stg[i]; }
        };
        stage_load(0); stage_store(0); __syncthreads();
        for (int sub = 0; sub < RCL / RA_SUB; ++sub) {
            const bool more = sub + 1 < RCL / RA_SUB;
            if (more) stage_load(sub + 1);
            const LAS unsigned char* cur = mybuf + (sub & 1) * RA_BUF;
            for (int st = 0; st < RA_SUB; ++st) {
                const LAS f32x4* base = (const LAS f32x4*)(cur + st * RA_STEP);
                const LAS f32x2* b2 = (const LAS f32x2*)base;
                f32x2 sa2[4];
#pragma unroll
                for (int r = 0; r < 4; ++r) sa2[r] = (f32x2){0.f, 0.f};
#pragma unroll
                for (int pp = 0; pp < 8; ++pp) { const f32x2 kq = b2[8 * jb + pp];
#pragma unroll
                    for (int r = 0; r < 4; ++r) sa2[r] += S[r][pp] * kq; }
                float sa[4];
#pragma unroll
                for (int r = 0; r < 4; ++r) { float t = -(sa2[r].x + sa2[r].y); t += dpp_xor1(t); t += dpp_xor2(t); sa[r] = t; }
                f32x4 vv = base[80 + ib]; if (part == 1) vv = (f32x4){0.f, 0.f, 0.f, 0.f};
                f32x2 y2[4];
#pragma unroll
                for (int r = 0; r < 4; ++r) y2[r] = (f32x2){0.f, 0.f};
#pragma unroll
                for (int pp = 0; pp < 8; ++pp) { const f32x2 wq = b2[32 + 8 * jb + pp], bq = b2[64 + 8 * jb + pp], kq = b2[96 + 8 * jb + pp], rq = b2[128 + 8 * jb + pp];
#pragma unroll
                    for (int r = 0; r < 4; ++r) { const f32x2 sar = {sa[r], sa[r]}, vr = {vv[r], vv[r]};
                        S[r][pp] = S[r][pp] * wq + (sar * bq + vr * kq); y2[r] += S[r][pp] * rq; } }
                float y[4];
#pragma unroll
                for (int r = 0; r < 4; ++r) { float t = y2[r].x + y2[r].y; t += dpp_xor1(t); t += dpp_xor2(t); y[r] = t; }
                if (jb == 0) { float* yo = (part == 1 ? YP : YL) + (m0 + sub * RA_SUB + st) * DR + h * 64 + 4 * ib; *(f32x4*)yo = (f32x4){y[0], y[1], y[2], y[3]}; }
            }
            if (more) stage_store((sub + 1) & 1);
            __syncthreads();
        }
        const size_t cb = (((size_t)seq * RNC + c) * 64 + 4 * ib) * 64 + 16 * jb;
        if (part == 0) {
#pragma unroll
            for (int r = 0; r < 4; ++r)
#pragma unroll
                for (int q = 0; q < 4; ++q) *(f32x4*)(QC + cb + r * 64 + 4 * q) = (f32x4){S[r][2 * q].x, S[r][2 * q].y, S[r][2 * q + 1].x, S[r][2 * q + 1].y};
        } else {
#pragma unroll
            for (int r = 0; r < 4; ++r)
#pragma unroll
                for (int q = 0; q < 2; ++q) { v4u w; w.x = pk2(S[r][4 * q].x, S[r][4 * q].y); w.y = pk2(S[r][4 * q + 1].x, S[r][4 * q + 1].y); w.z = pk2(S[r][4 * q + 2].x, S[r][4 * q + 2].y); w.w = pk2(S[r][4 * q + 3].x, S[r][4 * q + 3].y);
                    *(v4u*)(PC + cb + r * 64 + 8 * q) = w; }
        }
    }
}

constexpr int RB_BUF = 24576;
__device__ __forceinline__ void rwkv_chain(const Args& a, int l, LAS unsigned char* lds, int lane, int seq) {
    GAS unsigned char* wsg_ = (GAS unsigned char*)a.ws; asm volatile("" : "+s"(wsg_)); unsigned char* ws = (unsigned char*)wsg_;
    const float* QC = (const float*)(ws + WS_QC); const bf16* PC = (const bf16*)(ws + WS_PC); float* SALL = (float*)(ws + WS_SALL);
    const int r32 = lane & 31, h2 = lane >> 5, g = lane >> 4, li = lane & 15, cg = g & 1, tq = li >> 2, tp = li & 3;
    f32x16 St[2][2];
#pragma unroll
    for (int x = 0; x < 2; ++x)
#pragma unroll
        for (int y = 0; y < 2; ++y)
#pragma unroll
            for (int q = 0; q < 16; ++q) St[x][y][q] = 0.f;
    const unsigned lds0 = (unsigned)(uintptr_t)lds;
    auto dma = [&](int c) {
        const size_t cbase = ((size_t)seq * RNC + c) * 4096; const unsigned bb = lds0 + (c % 3) * RB_BUF;
#pragma unroll
        for (int x = 0; x < 8; ++x) glds16(PC + cbase + (size_t)(lane + 64 * x) * 8, (unsigned)__builtin_amdgcn_readfirstlane(bb + x * 1024));
#pragma unroll
        for (int jt = 0; jt < 2; ++jt)
#pragma unroll
            for (int it = 0; it < 2; ++it)
#pragma unroll
                for (int g4 = 0; g4 < 4; ++g4)
                    glds16(QC + cbase + (size_t)(32 * it + r32) * 64 + 32 * jt + 8 * g4 + 4 * h2, (unsigned)__builtin_amdgcn_readfirstlane(bb + 8192 + ((jt * 2 + it) * 4 + g4) * 1024));
    };
    dma(0); dma(1);
    for (int c = 0; c < RNC; ++c) {
        const size_t cbase = ((size_t)seq * RNC + c) * 4096; const LAS unsigned char* bb = lds + (c % 3) * RB_BUF;
        if (c == 0) asm volatile("s_waitcnt vmcnt(24)" ::: "memory"); else if (c == 1) asm volatile("s_waitcnt vmcnt(40)" ::: "memory");
        else if (c == RNC - 1) asm volatile("s_waitcnt vmcnt(32)" ::: "memory"); else asm volatile("s_waitcnt vmcnt(56)" ::: "memory");
        if (c + 2 < RNC) dma(c + 2);
        asm volatile("" ::: "memory");
        f32x16 D[2][2];
#pragma unroll
        for (int jt = 0; jt < 2; ++jt)
#pragma unroll
            for (int it = 0; it < 2; ++it)
#pragma unroll
                for (int g4 = 0; g4 < 4; ++g4) { const size_t off = cbase + (size_t)(32 * it + r32) * 64 + 32 * jt + 8 * g4 + 4 * h2;
                    *(GAS f32x4*)((GAS float*)SALL + off) = (f32x4){St[jt][it][4 * g4], St[jt][it][4 * g4 + 1], St[jt][it][4 * g4 + 2], St[jt][it][4 * g4 + 3]};
                    const f32x4 qv = *(const LAS f32x4*)(bb + 8192 + ((jt * 2 + it) * 4 + g4) * 1024 + lane * 16);
                    D[jt][it][4 * g4] = qv.x; D[jt][it][4 * g4 + 1] = qv.y; D[jt][it][4 * g4 + 2] = qv.z; D[jt][it][4 * g4 + 3] = qv.w; }
#pragma unroll
        for (int kt = 0; kt < 2; ++kt)
#pragma unroll
            for (int s = 0; s < 2; ++s) {
                const bf16x8 b0 = pack8(St[kt][0], s), b1 = pack8(St[kt][1], s);
                const LAS unsigned char* pp = bb + (32 * kt + 16 * s + 4 * h2 + tq) * 128 + (16 * cg + 4 * tp) * 2;
                const bf16x8 a0 = vt_frag(pp, 8 * 128), a1 = vt_frag(pp + 64, 8 * 128);
                D[0][0] = MFMA32(a0, b0, D[0][0]); D[0][1] = MFMA32(a0, b1, D[0][1]); D[1][0] = MFMA32(a1, b0, D[1][0]); D[1][1] = MFMA32(a1, b1, D[1][1]);
            }
        LDS_WAIT(); asm volatile("" ::: "memory");
#pragma unroll
        for (int x = 0; x < 2; ++x)
#pragma unroll
            for (int y = 0; y < 2; ++y) St[x][y] = D[x][y];
    }
    const int b = seq >> 2, h = seq & 3;
    float* so = a.out + O_RWP + ((((size_t)l * NB_P + b) * RH + h) * RN) * RN;
#pragma unroll
    for (int jt = 0; jt < 2; ++jt)
#pragma unroll
        for (int it = 0; it < 2; ++it)
#pragma unroll
            for (int g4 = 0; g4 < 4; ++g4) *(f32x4*)(so + (size_t)(32 * it + r32) * 64 + 32 * jt + 8 * g4 + 4 * h2) = (f32x4){St[jt][it][4 * g4], St[jt][it][4 * g4 + 1], St[jt][it][4 * g4 + 2], St[jt][it][4 * g4 + 3]};
}

__device__ __forceinline__ void phase_rwkvC(const Args& a, int l, LAS unsigned char* lds, int lane, int wave) {
    GAS unsigned char* wsg_ = (GAS unsigned char*)a.ws; asm volatile("" : "+s"(wsg_)); unsigned char* ws = (unsigned char*)wsg_;
    const float* YL = (const float*)(ws + WS_YL); const float* YP = (const float*)(ws + WS_YP); const float* SALL = (const float*)(ws + WS_SALL);
    const float* BONUS = (const float*)(ws + WS_BONUS); const bf16* PROJ = (const bf16*)(ws + WS_PROJ); bf16* ARW = (bf16*)(ws + WS_A4) + 3 * A4_STRIDE;
    const int r32 = lane & 31, h2 = lane >> 5;
    for (int item = blockIdx.x * NWAVES + wave; item < 2048; item += gridDim.x * NWAVES) {
        const int seq = item >> 6, c = item & 63, b = seq >> 2, h = seq & 3;
        const size_t m = (size_t)b * SEQ + (size_t)c * RCL + r32;
        const float* sc = SALL + ((size_t)seq * RNC + c) * 4096;
        f32x16 D[2];
#pragma unroll
        for (int it = 0; it < 2; ++it)
#pragma unroll
            for (int g4 = 0; g4 < 4; ++g4) { const f32x4 yl = *(const f32x4*)(YL + m * DR + h * 64 + 32 * it + 8 * g4 + 4 * h2);
                D[it][4 * g4] = yl.x; D[it][4 * g4 + 1] = yl.y; D[it][4 * g4 + 2] = yl.z; D[it][4 * g4 + 3] = yl.w; }
#pragma unroll
        for (int ks = 0; ks < 4; ++ks) {
            const f32x4* yp = (const f32x4*)(YP + m * DR + h * 64 + 16 * ks + 8 * h2); const f32x4 y0 = yp[0], y1 = yp[1];
            v4u bw; bw.x = pk2(y0.x, y0.y); bw.y = pk2(y0.z, y0.w); bw.z = pk2(y1.x, y1.y); bw.w = pk2(y1.z, y1.w);
            const bf16x8 bfr = __builtin_bit_cast(bf16x8, bw);
#pragma unroll
            for (int it = 0; it < 2; ++it) { const f32x4* sp = (const f32x4*)(sc + (size_t)(32 * it + r32) * 64 + 16 * ks + 8 * h2); const f32x4 s0 = sp[0], s1 = sp[1];
                v4u aw; aw.x = pk2(s0.x, s0.y); aw.y = pk2(s0.z, s0.w); aw.z = pk2(s1.x, s1.y); aw.w = pk2(s1.z, s1.w);
                D[it] = MFMA32(__builtin_bit_cast(bf16x8, aw), bfr, D[it]); }
        }
        f32x4 gg[2][4], gb[2][4], bo[2][4]; v2u zw[2][4];
#pragma unroll
        for (int it = 0; it < 2; ++it)
#pragma unroll
            for (int g4 = 0; g4 < 4; ++g4) { const int i0 = h * 64 + 32 * it + 8 * g4 + 4 * h2;
                gg[it][g4] = *(const f32x4*)(INF(I_GNG) + l * DR + i0); gb[it][g4] = *(const f32x4*)(INF(I_GNB) + l * DR + i0); bo[it][g4] = *(const f32x4*)(BONUS + m * DR + i0);
                zw[it][g4] = *(const v2u*)(PROJ + m * PW + C_ZR + i0); }
        float s1 = 0.f;
#pragma unroll
        for (int it = 0; it < 2; ++it)
#pragma unroll
            for (int q = 0; q < 16; ++q) s1 += D[it][q];
        const float mu = (s1 + SHX(s1, 32)) * (1.f / 64.f);
        float s2 = 0.f;
#pragma unroll
        for (int it = 0; it < 2; ++it)
#pragma unroll
            for (int q = 0; q < 16; ++q) { const float d = D[it][q] - mu; s2 += d * d; }
        const float rs = frsq((s2 + SHX(s2, 32)) * (1.f / 64.f) + GN_EPS);
#pragma unroll
        for (int it = 0; it < 2; ++it)
#pragma unroll
            for (int g4 = 0; g4 < 4; ++g4) { const int i0 = h * 64 + 32 * it + 8 * g4 + 4 * h2;
                const f32x4 G = gg[it][g4], B = gb[it][g4], O = bo[it][g4]; const v2u z = zw[it][g4];
                const float o0 = ((D[it][4 * g4] - mu) * rs * G.x + B.x + O.x) * silu(bflo(z.x)), o1 = ((D[it][4 * g4 + 1] - mu) * rs * G.y + B.y + O.y) * silu(bfhi(z.x)),
                            o2 = ((D[it][4 * g4 + 2] - mu) * rs * G.z + B.z + O.z) * silu(bflo(z.y)), o3 = ((D[it][4 * g4 + 3] - mu) * rs * G.w + B.w + O.w) * silu(bfhi(z.y));
                v2u ob; ob.x = pk2(o0, o1); ob.y = pk2(o2, o3); *(v2u*)(ARW + m * DR + i0) = ob; }
    }
}

template <int KSTEPS>
__device__ __forceinline__ void thin_acc(const bf16* A, int lda, const bf16* Bt, int ldb, int n0, int lane, int wave, LAS unsigned char* lds, pg8::f32x4& acc) {
    const int fr = lane & 15, fq = lane >> 4; constexpr int kper = KSTEPS * 32;
    const bf16* bp = Bt + (size_t)(n0 + fr) * ldb + wave * kper + 8 * fq; const bf16* ap = A + (size_t)fr * lda + wave * kper + 8 * fq;
    bf16x8 bfr[KSTEPS], af[KSTEPS][8];
#pragma unroll
    for (int ks = 0; ks < KSTEPS; ++ks) { bfr[ks] = *(const bf16x8*)(bp + 32 * ks);
#pragma unroll
        for (int rt = 0; rt < 8; ++rt) af[ks][rt] = *(const bf16x8*)(ap + (size_t)rt * 16 * lda + 32 * ks); }
    pg8::f32x4 part[8];
#pragma unroll
    for (int rt = 0; rt < 8; ++rt) part[rt] = (pg8::f32x4){0.f, 0.f, 0.f, 0.f};
#pragma unroll
    for (int ks = 0; ks < KSTEPS; ++ks)
#pragma unroll
        for (int rt = 0; rt < 8; ++rt) part[rt] = __builtin_amdgcn_mfma_f32_16x16x32_bf16(bfr[ks], af[ks][rt], part[rt], 0, 0, 0);
    LAS pg8::f32x4* red = (LAS pg8::f32x4*)lds;
#pragma unroll
    for (int rt = 0; rt < 8; ++rt) red[(wave * 8 + rt) * 64 + lane] = part[rt];
    __syncthreads();
#pragma unroll
    for (int w2 = 0; w2 < 8; ++w2) acc += red[(w2 * 8 + wave) * 64 + lane];
    __syncthreads();
}
__device__ __forceinline__ void thin_merge_sample(const Args& a, int l, LAS unsigned char* lds, int lane, int wave, int unit) {
    GAS unsigned char* wsg_ = (GAS unsigned char*)a.ws; asm volatile("" : "+s"(wsg_)); unsigned char* ws = (unsigned char*)wsg_;
    const int slice = unit & 63, rh = unit >> 6;
    const bf16* A4 = (const bf16*)(ws + WS_A4) + (size_t)(MP + rh * 128) * 256; const bf16* B4 = (const bf16*)(ws + WS_W + (size_t)l * LW_STRIDE + LW_MLA);
    const bf16* PROJ = (const bf16*)(ws + WS_PROJ); bf16* MERGED = (bf16*)(ws + WS_MERGED);
    const int n0 = 16 * slice, fr = lane & 15, fq = lane >> 4;
    const size_t m = (size_t)MP + rh * 128 + wave * 16 + fr; const int n = n0 + 4 * fq;
    v2u gw[3];
#pragma unroll
    for (int br = 0; br < 3; ++br) gw[br] = *(const v2u*)(PROJ + m * PW + C_GM + br * DM + n);
    pg8::f32x4 acc[3];
#pragma unroll
    for (int br = 0; br < 3; ++br) acc[br] = (pg8::f32x4){0.f, 0.f, 0.f, 0.f};
    thin_acc<1>(A4, 256, B4, 256, n0, lane, wave, lds, acc[0]);
    thin_acc<1>(A4 + A4_STRIDE, 256, B4 + (size_t)DM * 256, 256, n0, lane, wave, lds, acc[0]);
    thin_acc<1>(A4 + 2 * A4_STRIDE, 256, B4 + (size_t)2 * DM * 256, 256, n0, lane, wave, lds, acc[1]);
    thin_acc<1>(A4 + 3 * A4_STRIDE, 256, B4 + (size_t)3 * DM * 256, 256, n0, lane, wave, lds, acc[2]);
    pg8::f32x4 o = {0.f, 0.f, 0.f, 0.f};
#pragma unroll
    for (int br = 0; br < 3; ++br) o += acc[br] * (pg8::f32x4){bflo(gw[br].x), bfhi(gw[br].x), bflo(gw[br].y), bfhi(gw[br].y)};
    v2u ob; ob.x = pk2(o[0], o[1]); ob.y = pk2(o[2], o[3]); *(v2u*)(MERGED + m * DM + n) = ob;
}
__device__ __forceinline__ void thin_out_sample(const Args& a, int l, LAS unsigned char* lds, int lane, int wave, int unit) {
    GAS unsigned char* wsg_ = (GAS unsigned char*)a.ws; asm volatile("" : "+s"(wsg_)); unsigned char* ws = (unsigned char*)wsg_;
    const int slice = unit & 63, rh = unit >> 6;
    const bf16* A = (const bf16*)(ws + WS_MERGED) + (size_t)(MP + rh * 128) * DM; const bf16* Bt = (const bf16*)(ws + WS_W + (size_t)l * LW_STRIDE + LW_OUT);
    const float* xin = INF(I_XS); const bf16* xinb = (const bf16*)(ws + WS_X1) + (size_t)MP * DM; bf16* xo = (bf16*)(ws + (l == 0 ? WS_X1 : WS_X2)) + (size_t)MP * DM;
    const float* modg = (const float*)(ws + WS_MOD) + (size_t)l * NCB * 3072 + 2048; const float* badg = INF(I_BADA) + l * 3072 + 2048;
    const int n0 = 16 * slice, fr = lane & 15, fq = lane >> 4;
    const int mm = rh * 128 + wave * 16 + fr, n = n0 + 4 * fq, cb = NB_P + (mm >> 3);
    const pg8::f32x4 gt = *(const pg8::f32x4*)(modg + (size_t)cb * 3072 + n) + *(const pg8::f32x4*)(badg + n);
    pg8::f32x4 xv;
    if (l == 0) xv = *(const pg8::f32x4*)(xin + (size_t)mm * DM + n); else { const v2u q = *(const v2u*)(xinb + (size_t)mm * DM + n); xv = (pg8::f32x4){bflo(q.x), bfhi(q.x), bflo(q.y), bfhi(q.y)}; }
    pg8::f32x4 acc = {0.f, 0.f, 0.f, 0.f};
    thin_acc<4>(A, DM, Bt, DM, n0, lane, wave, lds, acc);
    { const pg8::f32x4 o = xv + gt * acc; v2u ob; ob.x = pk2(o[0], o[1]); ob.y = pk2(o[2], o[3]); *(v2u*)(xo + (size_t)mm * DM + n) = ob; }
}

constexpr int UT_LDS = 29184;
__device__ __forceinline__ void phase_rwkvA_ut(const Args& a, LAS unsigned char* lds, int lane, int wave) {
    if (wave >= 4) return;
    GAS unsigned char* wsg_ = (GAS unsigned char*)a.ws; asm volatile("" : "+s"(wsg_)); unsigned char* ws = (unsigned char*)wsg_;
    const float* SC = (const float*)(ws + WS_SC); float* YL = (float*)(ws + WS_YL); float* YP = (float*)(ws + WS_YP); float* QC = (float*)(ws + WS_QC); bf16* PC = (bf16*)(ws + WS_PC);
    LAS unsigned char* L = lds + wave * UT_LDS;
    LAS unsigned char* IKa = L, *IB = L + 4096, *IKt = L + 8192, *IR = L + 12288, *IV = L + 16384, *IW = L + 20480, *IU = L + 24576;
    LAS float* MB = (LAS float*)(L + 0); LAS float* MVI = (LAS float*)(L + 20480); LAS float* GC = (LAS float*)(L + 28672);
    const int r32 = lane & 31, h2 = lane >> 5, g = lane >> 4, li = lane & 15, cg = g & 1, tq = li >> 2, tp = li & 3;
    for (int ch = (int)blockIdx.x * 4 + wave; ch < 32 * RNC; ch += (int)gridDim.x * 4) {
        const int seq = ch / RNC, c = ch - seq * RNC, b = seq >> 2, h = seq & 3;
        const size_t m0 = (size_t)b * SEQ + (size_t)c * RCL;
        float ka[32];
        { const float* sp = SC + m0 * 6 * DR + h * 64 + lane; float Gt[32], tmp[32];
#pragma unroll
          for (int t = 0; t < 32; ++t) Gt[t] = sp[(size_t)t * 6 * DR + DR];
#pragma unroll
          for (int t = 0; t < 32; ++t) tmp[t] = sp[(size_t)t * 6 * DR + 4 * DR];
          { float G = 1.f;
#pragma unroll
            for (int t = 0; t < 32; ++t) { ka[t] = tmp[t] * G; G *= Gt[t]; Gt[t] = G; *(LAS bf16*)(IKa + t * 128 + lane * 2) = (bf16)f2bf(ka[t]); } }
#pragma unroll
          for (int t = 0; t < 32; ++t) tmp[t] = sp[(size_t)t * 6 * DR];
#pragma unroll
          for (int t = 0; t < 32; ++t) *(LAS bf16*)(IR + t * 128 + lane * 2) = (bf16)f2bf(tmp[t] * Gt[t]);
#pragma unroll
          for (int t = 0; t < 32; ++t) tmp[t] = sp[(size_t)t * 6 * DR + 3 * DR];
#pragma unroll
          for (int t = 0; t < 32; ++t) *(LAS bf16*)(IV + t * 128 + lane * 2) = (bf16)f2bf(tmp[t]);
          GC[lane] = Gt[31];
#pragma unroll
          for (int t = 0; t < 32; ++t) Gt[t] = frcp(Gt[t]);
#pragma unroll
          for (int t = 0; t < 32; ++t) tmp[t] = sp[(size_t)t * 6 * DR + 5 * DR];
#pragma unroll
          for (int t = 0; t < 32; ++t) *(LAS bf16*)(IB + t * 128 + lane * 2) = (bf16)f2bf(tmp[t] * Gt[t]);
#pragma unroll
          for (int t = 0; t < 32; ++t) tmp[t] = sp[(size_t)t * 6 * DR + 2 * DR];
#pragma unroll
          for (int t = 0; t < 32; ++t) *(LAS bf16*)(IKt + t * 128 + lane * 2) = (bf16)f2bf(tmp[t] * Gt[t]);
        }
        LDS_WAIT(); asm volatile("" ::: "memory");
        f32x16 MbT, MkT, AbT, AkT;
#pragma unroll
        for (int q = 0; q < 16; ++q) { MbT[q] = 0.f; MkT[q] = 0.f; AbT[q] = 0.f; AkT[q] = 0.f; }
#pragma unroll
        for (int ks = 0; ks < 4; ++ks) { const int off = r32 * 128 + (16 * ks + 8 * h2) * 2;
            const bf16x8 fb = *(const LAS bf16x8*)(IB + off), fk = *(const LAS bf16x8*)(IKt + off), fa = *(const LAS bf16x8*)(IKa + off), fr_ = *(const LAS bf16x8*)(IR + off);
            MbT = MFMA32(fb, fa, MbT); MkT = MFMA32(fk, fa, MkT); AbT = MFMA32(fb, fr_, AbT); AkT = MFMA32(fk, fr_, AkT); }
#pragma unroll
        for (int q = 0; q < 16; ++q) { const int s = (q & 3) + 8 * (q >> 2) + 4 * h2;
            if (s >= r32) { MbT[q] = 0.f; MkT[q] = 0.f; } if (s > r32) { AbT[q] = 0.f; AkT[q] = 0.f; } }
        LDS_WAIT(); asm volatile("" ::: "memory");
#pragma unroll
        for (int g4 = 0; g4 < 4; ++g4) *(LAS f32x4*)(MB + r32 * 32 + 8 * g4 + 4 * h2) = (f32x4){MbT[4 * g4], MbT[4 * g4 + 1], MbT[4 * g4 + 2], MbT[4 * g4 + 3]};
        { f32x16 mv[2];
#pragma unroll
          for (int it = 0; it < 2; ++it)
#pragma unroll
              for (int q = 0; q < 16; ++q) mv[it][q] = 0.f;
#pragma unroll
          for (int ks = 0; ks < 2; ++ks) { const bf16x8 pb = pack8(MkT, ks);
#pragma unroll
              for (int it = 0; it < 2; ++it) mv[it] = MFMA32(vt_frag(IV + (16 * ks + 4 * h2 + tq) * 128 + (32 * it + 16 * cg + 4 * tp) * 2, 8 * 128), pb, mv[it]); }
#pragma unroll
          for (int it = 0; it < 2; ++it)
#pragma unroll
              for (int g4 = 0; g4 < 4; ++g4) *(LAS f32x4*)(MVI + r32 * 64 + 32 * it + 8 * g4 + 4 * h2) = (f32x4){mv[it][4 * g4], mv[it][4 * g4 + 1], mv[it][4 * g4 + 2], mv[it][4 * g4 + 3]}; }
        LDS_WAIT(); asm volatile("" ::: "memory");
        { float x1[32], x2[32];
#pragma unroll
          for (int t = 0; t < 32; ++t) x2[t] = -MVI[t * 64 + lane];
          LDS_WAIT(); asm volatile("" ::: "memory");
#pragma unroll
          for (int t = 0; t < 32; ++t) { float a1 = -ka[t], a2 = x2[t];
#pragma unroll
              for (int s4 = 0; s4 < 32; s4 += 4) { if (s4 < t) { const f32x4 mq = *(const LAS f32x4*)(MB + t * 32 + s4);
                  a1 -= mq.x * x1[s4]; a2 -= mq.x * x2[s4];
                  if (s4 + 1 < t) { a1 -= mq.y * x1[s4 + 1]; a2 -= mq.y * x2[s4 + 1]; }
                  if (s4 + 2 < t) { a1 -= mq.z * x1[s4 + 2]; a2 -= mq.z * x2[s4 + 2]; }
                  if (s4 + 3 < t) { a1 -= mq.w * x1[s4 + 3]; a2 -= mq.w * x2[s4 + 3]; } } }
              x1[t] = a1; x2[t] = a2;
              *(LAS bf16*)(IW + t * 128 + lane * 2) = (bf16)f2bf(a1); *(LAS bf16*)(IU + t * 128 + lane * 2) = (bf16)f2bf(a2); } }
        LDS_WAIT(); asm volatile("" ::: "memory");
        const size_t cbase = ((size_t)seq * RNC + c) * 4096;
#pragma unroll
        for (int jt = 0; jt < 2; ++jt) {
            f32x16 pt[2], qt[2];
#pragma unroll
            for (int x = 0; x < 2; ++x)
#pragma unroll
                for (int q = 0; q < 16; ++q) { pt[x][q] = 0.f; qt[x][q] = 0.f; }
#pragma unroll
            for (int ks = 0; ks < 2; ++ks) { const int ro = (16 * ks + 4 * h2 + tq) * 128, co = (16 * cg + 4 * tp) * 2;
                const bf16x8 ab = vt_frag(IB + ro + 64 * jt + co, 8 * 128), ak = vt_frag(IKt + ro + 64 * jt + co, 8 * 128);
#pragma unroll
                for (int x = 0; x < 2; ++x) { const bf16x8 bw = vt_frag(IW + ro + 64 * x + co, 8 * 128), bu = vt_frag(IU + ro + 64 * x + co, 8 * 128), bv = vt_frag(IV + ro + 64 * x + co, 8 * 128);
                    pt[x] = MFMA32(ab, bw, pt[x]); qt[x] = MFMA32(ab, bu, qt[x]); qt[x] = MFMA32(ak, bv, qt[x]); } }
#pragma unroll
            for (int g4 = 0; g4 < 4; ++g4) { const int j0 = 32 * jt + 8 * g4 + 4 * h2; const f32x4 gc = *(const LAS f32x4*)(GC + j0);
#pragma unroll
                for (int x = 0; x < 2; ++x) { const int kcol = 32 * x + r32;
                    f32x4 pv = {pt[x][4 * g4], pt[x][4 * g4 + 1], pt[x][4 * g4 + 2], pt[x][4 * g4 + 3]};
#pragma unroll
                    for (int e = 0; e < 4; ++e) if (j0 + e == kcol) pv[e] += 1.f;
                    pv = pv * gc; v2u pw; pw.x = pk2(pv.x, pv.y); pw.y = pk2(pv.z, pv.w);
                    *(v2u*)(PC + cbase + (size_t)kcol * 64 + j0) = pw;
                    *(f32x4*)(QC + cbase + (size_t)kcol * 64 + j0) = (f32x4){qt[x][4 * g4], qt[x][4 * g4 + 1], qt[x][4 * g4 + 2], qt[x][4 * g4 + 3]} * gc; } }
        }
        { f32x16 yp[2], yl[2];
#pragma unroll
          for (int x = 0; x < 2; ++x)
#pragma unroll
              for (int q = 0; q < 16; ++q) { yp[x][q] = 0.f; yl[x][q] = 0.f; }
#pragma unroll
          for (int ks = 0; ks < 2; ++ks) { const bf16x8 pab = pack8(AbT, ks), pak = pack8(AkT, ks); const int ro = (16 * ks + 4 * h2 + tq) * 128, co = (16 * cg + 4 * tp) * 2;
#pragma unroll
              for (int x = 0; x < 2; ++x) { yp[x] = MFMA32(vt_frag(IW + ro + 64 * x + co, 8 * 128), pab, yp[x]);
                  yl[x] = MFMA32(vt_frag(IU + ro + 64 * x + co, 8 * 128), pab, yl[x]); yl[x] = MFMA32(vt_frag(IV + ro + 64 * x + co, 8 * 128), pak, yl[x]); } }
          const size_t mrow = (m0 + r32) * DR + h * 64;
#pragma unroll
          for (int x = 0; x < 2; ++x)
#pragma unroll
              for (int g4 = 0; g4 < 4; ++g4) { const int j0 = 32 * x + 8 * g4 + 4 * h2; const v2u rw = *(const LAS v2u*)(IR + r32 * 128 + j0 * 2);
                  *(f32x4*)(YP + mrow + j0) = (f32x4){yp[x][4 * g4] + bflo(rw.x), yp[x][4 * g4 + 1] + bfhi(rw.x), yp[x][4 * g4 + 2] + bflo(rw.y), yp[x][4 * g4 + 3] + bfhi(rw.y)};
                  *(f32x4*)(YL + mrow + j0) = (f32x4){yl[x][4 * g4], yl[x][4 * g4 + 1], yl[x][4 * g4 + 2], yl[x][4 * g4 + 3]}; } }
        LDS_WAIT(); asm volatile("" ::: "memory");
    }
}

constexpr int SA_RS = 592;
constexpr int SA_BUF = 64 * SA_RS;
__device__ __forceinline__ void phase_attn_sample(const Args& a, int l, LAS unsigned char* lds, int tid, int lane, int wave, unsigned* sctr, volatile LAS unsigned* qslot) {
    GAS unsigned char* wsg_ = (GAS unsigned char*)a.ws; asm volatile("" : "+s"(wsg_)); unsigned char* ws = (unsigned char*)wsg_;
    const bf16* QLT = (const bf16*)(ws + WS_QLAT); const bf16* CKVn = (const bf16*)(ws + WS_CKV) + (size_t)MP * KVL; const bf16* KPEn = (const bf16*)(ws + WS_KPE) + (size_t)MP * QKR;
    float* PO = (float*)(ws + WS_PO); float* PM = (float*)(ws + WS_PM); float* PL = (float*)(ws + WS_PL);
    const float* cckv = INF(I_CCKV) + (size_t)l * NPOOL * PAGE * KVL; const float* ckpe = INF(I_CKPE) + (size_t)l * NPOOL * PAGE * QKR; const int* pt = (const int*)a.in[I_PT];
    const int r32 = lane & 31, h2 = lane >> 5, rt = wave & 1, ch = (wave >> 1) & 1, kp = wave >> 2;
    const int g = lane >> 4, li = lane & 15, cg = g & 1, tq = li >> 2, tp = li & 3;
    for (;;) {
        if (tid == 0) *qslot = __hip_atomic_fetch_add(sctr, 1u, __ATOMIC_RELAXED, __HIP_MEMORY_SCOPE_AGENT);
        __syncthreads();
        const int unit = (int)*qslot;
        __syncthreads();
        if (unit >= NB_S * 8) break;
        const int b = unit >> 3, split = unit & 7;
        LAS unsigned char* xbuf = lds + 2 * SA_BUF;
        bf16x8 Bq[9];
#pragma unroll
        for (int ks = 0; ks < 9; ++ks) Bq[ks] = *(const bf16x8*)(QLT + ((size_t)b * 64 + rt * 32 + r32) * 288 + 16 * (9 * ch + ks) + 8 * h2);
        f32x16 O[4];
#pragma unroll
        for (int ct = 0; ct < 4; ++ct)
#pragma unroll
            for (int i = 0; i < 16; ++i) O[ct][i] = 0.f;
        float mrun = -INFINITY, lrun = 0.f;
        constexpr int NP = 32;
        const bool has_new = (split == 7);
        const int mypool = pt[b * NPAGES + split * 16 + (lane & 15)];
        const unsigned vo_c = (unsigned)(tid >> 6) * (KVL * 4u) + (unsigned)(tid & 63) * 16u, vo_p = (unsigned)(tid >> 3) * (QKR * 4u) + (unsigned)(tid & 7) * 16u;
        const int so_c = (tid >> 6) * SA_RS + (tid & 63) * 8, so_p = (tid >> 3) * SA_RS + 512 + (tid & 7) * 8;
        f32x4 gA[8], pA, gB[8], pB;
        auto load_tile = [&](int j, f32x4 (&gc)[8], f32x4& gp) {
            const int pool = __builtin_amdgcn_readlane(mypool, j >> 1);
            const char* src = (const char*)(cckv + ((size_t)pool * PAGE + (j & 1) * 64) * KVL); const char* srp = (const char*)(ckpe + ((size_t)pool * PAGE + (j & 1) * 64) * QKR);
#pragma unroll
            for (int i = 0; i < 8; ++i) gc[i] = __builtin_nontemporal_load((const f32x4*)(src + (vo_c + (unsigned)i * (8u * KVL * 4u))));
            gp = __builtin_nontemporal_load((const f32x4*)(srp + vo_p));
        };
        auto store_tile = [&](LAS unsigned char* buf, const f32x4 (&gc)[8], const f32x4& gp) {
            LAS unsigned char* d = buf + so_c;
#pragma unroll
            for (int i = 0; i < 8; ++i) { v2u w; w.x = pk2(gc[i].x, gc[i].y); w.y = pk2(gc[i].z, gc[i].w); *(LAS v2u*)(d + i * (8 * SA_RS)) = w; }
            { v2u w; w.x = pk2(gp.x, gp.y); w.y = pk2(gp.z, gp.w); *(LAS v2u*)(buf + so_p) = w; }
        };
        auto store_new = [&](LAS unsigned char* buf) {
            for (int q = tid; q < 32 * 36; q += NTHR) { const int key = q / 36, c16 = q - key * 36; v4u w = {0u, 0u, 0u, 0u};
                if (key < 8) w = (c16 < 32) ? *(const v4u*)(CKVn + ((size_t)b * 8 + key) * KVL + c16 * 8) : *(const v4u*)(KPEn + ((size_t)b * 8 + key) * QKR + (c16 - 32) * 8);
                *(LAS v4u*)(buf + key * SA_RS + c16 * 16) = w; }
        };
        auto compute = [&](const LAS unsigned char* tb, bool isnew) {
            f32x16 S0;
#pragma unroll
            for (int i = 0; i < 16; ++i) S0[i] = 0.f;
            const LAS unsigned char* kb = tb + r32 * SA_RS + h2 * 16 + ch * (9 * 32);
#pragma unroll
            for (int ks = 0; ks < 9; ++ks) { const bf16x8 k0 = *(const LAS bf16x8*)(kb + ks * 32); S0 = MFMA32(k0, Bq[ks], S0); }
            {   LAS f32x4* xw = (LAS f32x4*)(xbuf + wave * 4096) + lane; const LAS f32x4* xr = (const LAS f32x4*)(xbuf + (wave ^ 2) * 4096) + lane;
#pragma unroll
                for (int q4 = 0; q4 < 4; ++q4) xw[q4 * 64] = (f32x4){S0[4 * q4], S0[4 * q4 + 1], S0[4 * q4 + 2], S0[4 * q4 + 3]};
                LDS_WAIT(); __builtin_amdgcn_s_barrier(); asm volatile("" ::: "memory");
#pragma unroll
                for (int q4 = 0; q4 < 4; ++q4) { const f32x4 o = xr[q4 * 64]; S0[4 * q4] += o.x; S0[4 * q4 + 1] += o.y; S0[4 * q4 + 2] += o.z; S0[4 * q4 + 3] += o.w; }
            }
            if (isnew) {
                const int tq_ = (rt * 32 + r32) >> 3;
#pragma unroll
                for (int i = 0; i < 16; ++i) { const int key = 32 * kp + 4 * h2 + (i & 3) + 8 * (i >> 2); if (key > tq_) S0[i] = -INFINITY; }
            }
            float mx = S0[0];
#pragma unroll
            for (int i = 1; i < 16; ++i) mx = fmaxf(mx, S0[i]);
            mx = fmaxf(mx, SHX(mx, 32));
            const float mnew = fmaxf(mrun, mx);
            if (__builtin_amdgcn_ballot_w64(mnew > mrun)) {
                const float alpha = __builtin_amdgcn_exp2f(mrun - mnew); mrun = mnew; lrun *= alpha;
#pragma unroll
                for (int ct = 0; ct < 4; ++ct)
#pragma unroll
                    for (int i = 0; i < 16; ++i) O[ct][i] *= alpha;
            }
            float ps = 0.f;
#pragma unroll
            for (int i = 0; i < 16; ++i) { S0[i] = __builtin_amdgcn_exp2f(S0[i] - mrun); ps += S0[i]; }
            lrun += ps;
            const LAS unsigned char* vbase = tb + (4 * h2 + tq) * SA_RS + (ch * 128 + 16 * cg + 4 * tp) * 2;
#pragma unroll
            for (int s = 0; s < 2; ++s) {
                const bf16x8 pb = pack8(S0, s);
                const LAS unsigned char* vp = vbase + (16 * s) * SA_RS;
                bf16x8 va = vt_frag(vp, 8 * SA_RS), vb_ = vt_frag(vp + 64, 8 * SA_RS), vc = vt_frag(vp + 128, 8 * SA_RS), vd = vt_frag(vp + 192, 8 * SA_RS);
                asm volatile("" : "+v"(va), "+v"(vb_), "+v"(vc), "+v"(vd));
                O[0] = MFMA32(va, pb, O[0]); O[1] = MFMA32(vb_, pb, O[1]); O[2] = MFMA32(vc, pb, O[2]); O[3] = MFMA32(vd, pb, O[3]);
            }
        };
#define SA_BAR() do { LDS_WAIT(); __builtin_amdgcn_s_barrier(); asm volatile("" ::: "memory"); } while (0)
        load_tile(0, gA, pA); load_tile(1, gB, pB); store_tile(lds, gA, pA); SA_BAR();
        for (int j = 0; j < NP - 2; j += 2) {
            load_tile(j + 2, gA, pA);
            compute(lds + kp * 32 * SA_RS, false);
            store_tile(lds + SA_BUF, gB, pB);
            SA_BAR();
            load_tile(j + 3, gB, pB);
            compute(lds + SA_BUF + kp * 32 * SA_RS, false);
            store_tile(lds, gA, pA);
            SA_BAR();
        }
        compute(lds + kp * 32 * SA_RS, false);
        store_tile(lds + SA_BUF, gB, pB);
        SA_BAR();
        compute(lds + SA_BUF + kp * 32 * SA_RS, false);
        if (has_new) store_new(lds);
        __syncthreads();
        if (has_new) compute(lds + kp * 32 * SA_RS, true);
        __syncthreads();
        const float ltot = lrun + SHX(lrun, 32);
        LAS float* xb = (LAS float*)(lds + (wave & 3) * 17408);
        if (kp == 1) {
#pragma unroll
            for (int ct = 0; ct < 4; ++ct)
#pragma unroll
                for (int i = 0; i < 16; ++i) xb[(ct * 16 + i) * 64 + lane] = O[ct][i];
            xb[4096 + lane] = mrun; xb[4160 + lane] = ltot;
        }
        __syncthreads();
        if (kp == 0) {
            const float m1 = xb[4096 + lane], l1 = xb[4160 + lane];
            const float mm = fmaxf(mrun, m1); const float a0 = __builtin_amdgcn_exp2f(mrun - mm), a1 = __builtin_amdgcn_exp2f(m1 - mm);
            const int row = rt * 32 + r32; const size_t pbase = ((size_t)b * 8 + split) * 64 + row;
#pragma unroll
            for (int ct = 0; ct < 4; ++ct)
#pragma unroll
                for (int g4 = 0; g4 < 4; ++g4) { const int c0 = ch * 128 + ct * 32 + 8 * g4 + 4 * h2;
                    f32x4 o;
#pragma unroll
                    for (int e = 0; e < 4; ++e) o[e] = O[ct][4 * g4 + e] * a0 + xb[(ct * 16 + 4 * g4 + e) * 64 + lane] * a1;
                    *(f32x4*)(PO + pbase * 256 + c0) = o; }
            if (ch == 0 && h2 == 0) { PM[pbase] = mm; PL[pbase] = ltot * a0 + l1 * a1; }
        }
        __syncthreads();
    }
}

__device__ __forceinline__ void phase_combine(const Args& a, int l, LAS unsigned char* lds, int lane, int wave) {
    GAS unsigned char* wsg_ = (GAS unsigned char*)a.ws; asm volatile("" : "+s"(wsg_)); unsigned char* ws = (unsigned char*)wsg_;
    const int gw = blockIdx.x * NWAVES + wave, NGW = gridDim.x * NWAVES;
    const float* PO = (const float*)(ws + WS_PO); const float* PM = (const float*)(ws + WS_PM); const float* PL = (const float*)(ws + WS_PL);
    const float* wuv = INF(I_WUV) + (size_t)l * KVL * 512; const bf16* PROJ = (const bf16*)(ws + WS_PROJ); bf16* AMLA = (bf16*)(ws + WS_A4);
    LAS float* ol = (LAS float*)(lds + 65536 + wave * 1024);
    for (int task = gw; task < MS * NH; task += NGW) {
        const int mm = task >> 3, h = task & 7, b = mm >> 3, t = mm & 7, r = t * 8 + h;
        float ms[8], mmax = -INFINITY;
#pragma unroll
        for (int s = 0; s < 8; ++s) { ms[s] = PM[((size_t)b * 8 + s) * 64 + r]; mmax = fmaxf(mmax, ms[s]); }
        float L = 0.f, wsc[8];
#pragma unroll
        for (int s = 0; s < 8; ++s) { wsc[s] = __builtin_amdgcn_exp2f(ms[s] - mmax); L += wsc[s] * PL[((size_t)b * 8 + s) * 64 + r]; }
        const float invL = frcp(L);
#pragma unroll
        for (int ci = 0; ci < 4; ++ci) { const int c = lane + 64 * ci; float acc = 0.f;
#pragma unroll
            for (int s = 0; s < 8; ++s) acc += wsc[s] * PO[(((size_t)b * 8 + s) * 64 + r) * 256 + c];
            ol[c] = acc * invL; }
        LDS_WAIT(); asm volatile("" ::: "memory");
        float o = 0.f;
#pragma unroll 8
        for (int c = 0; c < 256; ++c) o += ol[c] * wuv[((size_t)c * NH + h) * 64 + lane];
        const size_t m = (size_t)MP + mm;
        const float z = bf1(PROJ[m * PW + C_ZM + h * 64 + lane]);
        AMLA[(size_t)(h >> 2) * A4_STRIDE + m * 256 + (h & 3) * 64 + lane] = (bf16)f2bf(o * silu(z));
        LDS_WAIT(); asm volatile("" ::: "memory");
    }
}

constexpr int SCAN_TS = 32;
__device__ __forceinline__ void scan_sample(const Args& a, int l, LAS unsigned char* lds, int lane, int sidx) {
    GAS unsigned char* wsg_ = (GAS unsigned char*)a.ws; asm volatile("" : "+s"(wsg_)); unsigned char* ws = (unsigned char*)wsg_;
    const float* SC = (const float*)(ws + WS_SC); const float* BONUS = (const float*)(ws + WS_BONUS); const bf16* PROJ = (const bf16*)(ws + WS_PROJ); bf16* ARW = (bf16*)(ws + WS_A4) + 3 * A4_STRIDE;
    LAS float* st = (LAS float*)lds;
    { const int seq = NB_P * RH + sidx;
        const bool samp = seq >= NB_P * RH; const int sb = samp ? seq - NB_P * RH : seq; const int b = sb >> 2, h = sb & 3;
        const int T = samp ? TSMP : SEQ; const size_t m0 = samp ? (size_t)MP + b * TSMP : (size_t)b * SEQ;
        float S[64];
        if (samp) { const f32x4* s0 = (const f32x4*)(INF(I_SRWKV) + ((((size_t)l * NB_S + b) * RH + h) * RN + lane) * RN);
#pragma unroll
            for (int j = 0; j < 16; ++j) { const f32x4 v = s0[j]; S[4 * j] = v.x; S[4 * j + 1] = v.y; S[4 * j + 2] = v.z; S[4 * j + 3] = v.w; } }
        else {
#pragma unroll
            for (int j = 0; j < 64; ++j) S[j] = 0.f; }
        const float gng = INF(I_GNG)[l * DR + h * 64 + lane], gnb = INF(I_GNB)[l * DR + h * 64 + lane];
        for (int t0 = 0; t0 < T; t0 += SCAN_TS) {
            const int nt = (T - t0) < SCAN_TS ? (T - t0) : SCAN_TS;
            for (int tt = 0; tt < nt; ++tt) { const float* sc = SC + (m0 + t0 + tt) * 6 * DR + h * 64 + lane; LAS float* d = st + tt * 320 + lane;
                d[0] = sc[0]; d[64] = sc[DR]; d[128] = sc[2 * DR]; d[192] = sc[4 * DR]; d[256] = sc[5 * DR]; }
            LDS_WAIT(); asm volatile("" ::: "memory");
            float vn = SC[(m0 + t0) * 6 * DR + 3 * DR + h * 64 + lane], bon = BONUS[(m0 + t0) * DR + h * 64 + lane], zn = bf1(PROJ[(m0 + t0) * PW + C_ZR + h * 64 + lane]);
            for (int tt = 0; tt < nt; ++tt) {
                const size_t m = m0 + t0 + tt;
                const float v = vn, bo_c = bon, z_c = zn;
                if (tt + 1 < nt) { vn = SC[(m + 1) * 6 * DR + 3 * DR + h * 64 + lane]; bon = BONUS[(m + 1) * DR + h * 64 + lane]; zn = bf1(PROJ[(m + 1) * PW + C_ZR + h * 64 + lane]); }
                const LAS f32x4* vr = (const LAS f32x4*)(st + tt * 320); const LAS f32x4* vw = vr + 16; const LAS f32x4* vk = vr + 32; const LAS f32x4* vkk = vr + 48; const LAS f32x4* vb = vr + 64;
                float sa = 0.f;
#pragma unroll
                for (int j = 0; j < 16; ++j) { const f32x4 q = vkk[j]; sa -= S[4 * j] * q.x + S[4 * j + 1] * q.y + S[4 * j + 2] * q.z + S[4 * j + 3] * q.w; }
                float y = 0.f;
#pragma unroll
                for (int j = 0; j < 16; ++j) { const f32x4 w = vw[j], bb = vb[j], kq = vk[j], rq = vr[j];
                    S[4 * j] = S[4 * j] * w.x + sa * bb.x + v * kq.x; S[4 * j + 1] = S[4 * j + 1] * w.y + sa * bb.y + v * kq.y;
                    S[4 * j + 2] = S[4 * j + 2] * w.z + sa * bb.z + v * kq.z; S[4 * j + 3] = S[4 * j + 3] * w.w + sa * bb.w + v * kq.w;
                    y += S[4 * j] * rq.x + S[4 * j + 1] * rq.y + S[4 * j + 2] * rq.z + S[4 * j + 3] * rq.w; }
                const float mu = wave_sum(y) * (1.f / 64.f); const float d = y - mu; const float var = wave_sum(d * d) * (1.f / 64.f);
                const float yn = d * (frsq(var + GN_EPS)) * gng + gnb;
                const float o = yn + bo_c;
                const float z = z_c;
                ARW[m * DR + h * 64 + lane] = (bf16)f2bf(o * silu(z));
            }
            LDS_WAIT(); asm volatile("" ::: "memory");
        }
        float* so = samp ? a.out + O_RWS + ((((size_t)l * NB_S + b) * RH + h) * RN + lane) * RN : a.out + O_RWP + ((((size_t)l * NB_P + b) * RH + h) * RN + lane) * RN;
#pragma unroll
        for (int j = 0; j < 16; ++j) *(f32x4*)(so + 4 * j) = (f32x4){S[4 * j], S[4 * j + 1], S[4 * j + 2], S[4 * j + 3]};
    }
}

__device__ __forceinline__ void phase_final(const Args& a, int lane, int wave) {
    GAS unsigned char* wsg_ = (GAS unsigned char*)a.ws; asm volatile("" : "+s"(wsg_)); unsigned char* ws = (unsigned char*)wsg_;
    const int gw = blockIdx.x * NWAVES + wave, NGW = gridDim.x * NWAVES;
    const bf16* X = (const bf16*)(ws + WS_X2); const float* fg = INF(I_FNG);
    f32x4 g[4];
#pragma unroll
    for (int j = 0; j < 4; ++j) g[j] = *(const f32x4*)(fg + 4 * lane + 256 * j);
    for (int grp = gw; grp < MT / 8; grp += NGW) {
        const int mbase = grp * 8;
        v2u nr[4];
        auto load_row = [&](int mr) { const v2u* xr = (const v2u*)(X + (size_t)mr * DM) + lane;
#pragma unroll
            for (int j = 0; j < 4; ++j) nr[j] = xr[64 * j]; };
        load_row(mbase);
        for (int r = 0; r < 8; ++r) {
            const int m = mbase + r;
            f32x4 v[4];
#pragma unroll
            for (int j = 0; j < 4; ++j) v[j] = (f32x4){bflo(nr[j].x), bfhi(nr[j].x), bflo(nr[j].y), bfhi(nr[j].y)};
            if (r + 1 < 8) load_row(m + 1);
            float ss = 0.f;
#pragma unroll
            for (int j = 0; j < 4; ++j) ss += (v[j].x * v[j].x + v[j].y * v[j].y) + (v[j].z * v[j].z + v[j].w * v[j].w);
            const float rs = frsq(wave_sum(ss) * (1.f / DM) + RMS_EPS);
            float* o = (m < MP) ? a.out + O_YP + (size_t)m * DM : a.out + O_YS + (size_t)(m - MP) * DM;
#pragma unroll
            for (int j = 0; j < 4; ++j) *(f32x4*)(o + 4 * lane + 256 * j) = v[j] * rs * g[j];
        }
    }
}

#if defined(ONLY)
#define PH_EN(k) (ONLY == (k))
#elif defined(SKIPA)
#define PH_EN(k) ((k) != SKIPA && (k) != SKIPB && (k) != SKIPC)
#else
#define PH_EN(k) 1
#endif
#ifndef PROBE_DBL
#define PROBE_DBL 0
#endif
#define REP(k) for (int rep_ = 0; rep_ < (((PROBE_DBL >> (k)) & 1) ? 2 : 1); ++rep_)
constexpr int NS_FIRST = 128;
constexpr int PH_PER_LAYER = 8, N_PHASES = 1 + DEPTH * PH_PER_LAYER + 1;
__global__ void __launch_bounds__(NTHR, 2) fwd(Args a) {
    extern __shared__ __attribute__((aligned(16))) unsigned char lds_raw[];
    LAS unsigned char* lds = (LAS unsigned char*)lds_raw;
    const int wave0 = __builtin_amdgcn_readfirstlane(threadIdx.x >> 6);
    int tid = threadIdx.x, lane = tid & 63, wave = wave0;
#define RETID() do { int w_ = wave0, l_; asm volatile("" : "+s"(w_)); asm volatile("v_mbcnt_lo_u32_b32 %0, -1, 0\n\tv_mbcnt_hi_u32_b32 %0, -1, %0" : "=v"(l_)); wave = w_; lane = l_; tid = wave * 64 + lane; } while (0)
    volatile LAS unsigned* MISC = (volatile LAS unsigned*)(lds + MISC_OFF);
    for (int u = tid; u < (LDS_BYTES - LDSCTL_OFF) / 4; u += NTHR) ((LAS unsigned*)(lds + LDSCTL_OFF))[u] = 0u;
    __syncthreads();
    const bool fused = (a.ph_hi - a.ph_lo) > 1;
    XcdBarrier bar; bar.bar = (unsigned*)(a.ws + WS_CTL) + CW_BAR; bar.x = 0; bar.st = nullptr;
    if (fused) bar = xcd_barrier_post((unsigned*)(a.ws + WS_CTL) + CW_BAR, MISC + 8);
    const int lo = a.ph_lo, hi = a.ph_hi;
#define IN(k) (lo <= (k) && (k) < hi)
#define SEAM(k) do { if (IN(k) && IN((k) + 1)) { xcd_barrier(bar); if ((PROBE_DBL >> 20) & 1) xcd_barrier(bar); } } while (0)
    if (IN(0)) {
#if PH_EN(0)
 RETID(); phase_prologue(a, lds, tid, lane, wave);
#endif
 }
    SEAM(0);
    for (int l = 0; l < DEPTH; ++l) {
        const int pb = 1 + l * PH_PER_LAYER;
        if (IN(pb + 0)) {
#if PH_EN(1)
 REP(1) { RETID(); phase_modulate(a, l, lane, wave); }
#endif
 }
        SEAM(pb + 0);
        if (IN(pb + 1) && PH_EN(2)) REP(2) {
            GAS unsigned char* wsg_ = (GAS unsigned char*)a.ws; asm volatile("" : "+s"(wsg_)); unsigned char* ws = (unsigned char*)wsg_;     unsigned char* wl = ws + WS_W + (size_t)l * LW_STRIDE;
            pg8::Gemm g{(const bf16*)(ws + WS_U), (const bf16*)(wl + LW_IN), MT, NPROJ, DM}; pg8::StaticOrder S; S.init(MT, NPROJ, gridDim.x, blockIdx.x);
            if ((PROBE_DBL >> 27) & 1) { pg8::EpiProj E0{(bf16*)(ws + WS_QA), (bf16*)(ws + WS_PROJ), 1}; pg8::gemm_phase<pg8::EpiProj, pg8::StaticOrder, true, true>(lds + RING_OFF, g, S, E0, wave0); }
            pg8::EpiProj E{(bf16*)(ws + WS_QA), (bf16*)(ws + WS_PROJ), 0};
            pg8::gemm_phase<pg8::EpiProj, pg8::StaticOrder, true, true>(lds + RING_OFF, g, S, E, wave0);
            if (l == 0 && blockIdx.x >= 154) { RETID(); convert_weights(a, ws, lds, lane, wave, 1, ((int)blockIdx.x - 154) * NWAVES + wave, ((int)gridDim.x - 154) * NWAVES); }
        }
        SEAM(pb + 1);
        if (IN(pb + 2)) {
#if PH_EN(3)
 REP(3) { RETID(); phase_post(a, l, lds, tid, lane, wave); }
#endif
 }
        SEAM(pb + 2);
        if (IN(pb + 3) && PH_EN(4)) REP(4) {
            GAS unsigned char* wsg_ = (GAS unsigned char*)a.ws; asm volatile("" : "+s"(wsg_)); unsigned char* ws = (unsigned char*)wsg_;     unsigned char* wl = ws + WS_W + (size_t)l * LW_STRIDE;
            { pg8::Gemm g{(const bf16*)(ws + WS_QA), (const bf16*)(wl + LW_Q), MT, 768, QL}; pg8::StaticOrder S; S.init(MT, 768, gridDim.x, blockIdx.x);
              pg8::EpiQ E{(const float*)(ws + WS_RSQ), (const float*)(ws + WS_ROPE), (bf16*)(ws + WS_Q), (float*)(ws + WS_QS)};
              pg8::gemm_phase<pg8::EpiQ, pg8::StaticOrder, true, true>(lds + RING_OFF, g, S, E, wave0); }
            { pg8::Gemm g{(const bf16*)(ws + WS_CKV), (const bf16*)(wl + LW_KV), MP, 1024, KVL}; pg8::StaticOrder S; S.init(MP, 1024, gridDim.x, (blockIdx.x + 195) % gridDim.x);
              pg8::EpiKV E{(bf16*)(ws + WS_KN), (bf16*)(ws + WS_V)};
              pg8::gemm_phase<pg8::EpiKV, pg8::StaticOrder, true, true>(lds + RING_OFF, g, S, E, wave0); }
        }
        if (IN(pb + 3)) { REP(5) { RETID(); phase_rwkvA_ut(a, lds, lane, wave); } }
        SEAM(pb + 3);
        if (IN(pb + 4)) REP(6) {
            unsigned* cw = (unsigned*)(a.ws + WS_CTL) + 64 + 64 * (l * 2 + rep_);
            RETID(); phase_qlat(a, l, lane, wave);
            asm volatile("s_waitcnt vmcnt(0)" ::: "memory");
            __syncthreads();
            if (threadIdx.x == 0) { __builtin_amdgcn_fence(__ATOMIC_RELEASE, "agent"); asm volatile("s_waitcnt vmcnt(0)" ::: "memory"); (void)xb_add(cw + 32, 1u); }
            RETID();
            if (blockIdx.x < 32) {
                if (wave == 0) rwkv_chain(a, l, lds, lane, (int)blockIdx.x);
                else if (wave <= 4) scan_sample(a, l, lds + 73728 + (wave - 1) * 10240, lane, (int)blockIdx.x * 4 + (wave - 1));
                __syncthreads();
            }
            const bool sfirst = (int)blockIdx.x >= NS_FIRST;
            if (wave0 >= 4) __builtin_amdgcn_s_setprio(1);
#pragma nounroll
            for (int pass = 0; pass < 2; ++pass) {
                if ((pass == 0) == sfirst) {
                    if (threadIdx.x == 0) { XB_SPIN(xb_ld(cw + 32) < gridDim.x, bar.bar); __builtin_amdgcn_fence(__ATOMIC_ACQUIRE, "agent"); asm volatile("s_waitcnt vmcnt(0)" ::: "memory"); }
                    __syncthreads();
                    RETID(); phase_attn_sample(a, l, lds, tid, lane, wave, cw + 16, MISC + 16);
                } else { RETID(); phase_attn_prompt(a, lds, tid, lane, wave, cw, MISC + 16); }
            }
            __builtin_amdgcn_s_setprio(0);
        }
        SEAM(pb + 4);
        if (IN(pb + 5)) {
 REP(8) { RETID(); phase_combine(a, l, lds, lane, wave); }
 REP(13) { RETID(); phase_rwkvC(a, l, lds, lane, wave); }
 }
        SEAM(pb + 5);
        if (IN(pb + 6) && PH_EN(9)) REP(9) {
            GAS unsigned char* wsg_ = (GAS unsigned char*)a.ws; asm volatile("" : "+s"(wsg_)); unsigned char* ws = (unsigned char*)wsg_;     unsigned char* wl = ws + WS_W + (size_t)l * LW_STRIDE;
            if (blockIdx.x >= 128) for (int r2_ = 0; r2_ < (((PROBE_DBL >> 26) & 1) ? 2 : 1); ++r2_) { RETID(); thin_merge_sample(a, l, lds, lane, wave, (int)blockIdx.x - 128); }
            pg8::Gemm g{(const bf16*)(ws + WS_A4), (const bf16*)(wl + LW_MLA), 4 * MT, 4 * DM, 256}; pg8::MergeOrder S; S.init(MP, DM, gridDim.x, blockIdx.x);
            if ((PROBE_DBL >> 24) & 1) { pg8::EpiMerge E0{(const bf16*)(ws + WS_PROJ), (bf16*)(ws + WS_MG), (bf16*)(ws + WS_MERGED), 1}; pg8::gemm_phase<pg8::EpiMerge, pg8::MergeOrder, true, true>(lds + RING_OFF, g, S, E0, wave0); }
            pg8::EpiMerge E{(const bf16*)(ws + WS_PROJ), (bf16*)(ws + WS_MG), (bf16*)(ws + WS_MERGED), 0};
            pg8::gemm_phase<pg8::EpiMerge, pg8::MergeOrder, true, true>(lds + RING_OFF, g, S, E, wave0);
        }
        SEAM(pb + 6);
        if (IN(pb + 7) && PH_EN(10)) REP(10) {
            GAS unsigned char* wsg_ = (GAS unsigned char*)a.ws; asm volatile("" : "+s"(wsg_)); unsigned char* ws = (unsigned char*)wsg_;     unsigned char* wl = ws + WS_W + (size_t)l * LW_STRIDE;
            if (blockIdx.x >= 128) for (int r2_ = 0; r2_ < (((PROBE_DBL >> 25) & 1) ? 2 : 1); ++r2_) { RETID(); thin_out_sample(a, l, lds, lane, wave, (int)blockIdx.x - 128); }
            pg8::Gemm g{(const bf16*)(ws + WS_MERGED), (const bf16*)(wl + LW_OUT), MP, DM, DM}; pg8::StaticOrder S; S.init(MP, DM, gridDim.x, blockIdx.x);
            if (l == 0) { pg8::EpiOut<false> E{INF(I_XP), nullptr, (bf16*)(ws + WS_X1), (const float*)(ws + WS_MOD) + 2048, INF(I_BADA) + 2048};
                pg8::gemm_phase<pg8::EpiOut<false>, pg8::StaticOrder, true, true>(lds + RING_OFF, g, S, E, wave0); }
            else { pg8::EpiOut<true> E{nullptr, (const bf16*)(ws + WS_X1), (bf16*)(ws + WS_X2), (const float*)(ws + WS_MOD) + (size_t)NCB * 3072 + 2048, INF(I_BADA) + 3072 + 2048};
                pg8::gemm_phase<pg8::EpiOut<true>, pg8::StaticOrder, true, true>(lds + RING_OFF, g, S, E, wave0); }
        }
        SEAM(pb + 7);
    }
    if (IN(N_PHASES - 1)) {
#if PH_EN(11)
 REP(11) { RETID(); phase_final(a, lane, wave); }
#endif
 }
#undef IN
#undef SEAM
}

#ifndef N_LAUNCH_MODE
#define N_LAUNCH_MODE 1
#endif
extern "C" void kernel_launch(void* const* d_in, const int* in_sizes, int n_in, void* d_out, int out_size, void* d_ws, size_t ws_size, hipStream_t stream) {
    static int grid = 0;
    if (grid == 0) {
        if (n_in != 35 || out_size != (int)O_END || ws_size < WS_END) { fprintf(stderr, "kernel_launch: unexpected sizes n_in %d out %d ws %zu (need %zu)\n", n_in, out_size, ws_size, (size_t)WS_END); grid = -1; return; }
        int dev = 0, cus = 0, per_cu = 0;
        if (hipGetDevice(&dev) != hipSuccess || hipDeviceGetAttribute(&cus, hipDeviceAttributeMultiprocessorCount, dev) != hipSuccess) { grid = -1; return; }
        if (hipFuncSetAttribute((const void*)fwd, hipFuncAttributeMaxDynamicSharedMemorySize, LDS_BYTES) != hipSuccess) { fprintf(stderr, "kernel_launch: hipFuncSetAttribute failed\n"); grid = -1; return; }
        if (hipOccupancyMaxActiveBlocksPerMultiprocessor(&per_cu, (const void*)fwd, NTHR, LDS_BYTES) != hipSuccess || per_cu < 1) fprintf(stderr, "kernel_launch: occupancy query says %d\n", per_cu);
        (void)hipGetLastError();
        grid = cus;
    }
    if (grid < 0) return;
    if (hipMemsetAsync((char*)d_ws + WS_CTL, 0, WS_ZERO_BYTES, stream) != hipSuccess) return;
    Args a{};
    for (int i = 0; i < 35; ++i) a.in[i] = d_in[i];
    a.out = (float*)d_out; a.ws = (unsigned char*)d_ws;
#if N_LAUNCH_MODE == 1
    a.ph_lo = 0; a.ph_hi = N_PHASES;
    hipLaunchKernelGGL(fwd, dim3(grid), dim3(NTHR), LDS_BYTES, stream, a);
#else
    for (int p = 0; p < N_PHASES; ++p) { a.ph_lo = p; a.ph_hi = p + 1; hipLaunchKernelGGL(fwd, dim3(grid), dim3(NTHR), LDS_BYTES, stream, a); }
#endif
}
```
